# Optimizing an MI355X kernel written in HIP

```python
import math
import jax
import jax.numpy as jnp
from jax import lax
import numpy as np

D_MODEL = 2048
BATCH = 8
SEQ = 2048
DEPTH = 4

ATT_HEADS = 8
KV_RANK = 256
IDX_HEADS = 8
IDX_DIM = 64
TOPK_MAX = 256
Q_BLOCK = 128
REL_BUCKETS = 32
REL_MAX_DIST = 128
M_HEADS = 4
M_QK_DIM = 128
M_V_DIM = 256
M_CHUNK = 64
CONV_WIDTH = 4
D_FF = 5504
EPS = 1e-6

COL_WIDTHS = (
    ATT_HEADS * KV_RANK,
    KV_RANK,
    IDX_HEADS * IDX_DIM,
    IDX_DIM,
    IDX_HEADS,
    2 * M_HEADS * M_QK_DIM,
    M_HEADS * M_V_DIM,
    M_HEADS * M_V_DIM,
    M_HEADS,
    M_HEADS,
    D_MODEL,
    D_MODEL,
)
D_IN = sum(COL_WIDTHS)
SPLIT_POINTS = tuple(int(v) for v in np.cumsum(COL_WIDTHS)[:-1])

kernel_name = 'hybrid_dsa_mlstm_macaron_trunk'


def rms_norm(x, g):
    xf = x.astype(jnp.float32)
    y = xf * lax.rsqrt(jnp.mean(xf * xf, axis=-1, keepdims=True) + EPS)
    return (y * g.astype(jnp.float32)).astype(x.dtype)


def swiglu(x, w_gu, w_down):
    gate, up = jnp.split(x @ w_gu, 2, axis=-1)
    return (jax.nn.silu(gate) * up) @ w_down


def t5_bucket(rel):
    n = jnp.maximum(rel, 0)
    max_exact = REL_BUCKETS // 2
    n_large = jnp.maximum(n, max_exact).astype(jnp.float32)
    large = max_exact + (jnp.log(n_large / max_exact) / math.log(REL_MAX_DIST / max_exact)
                         * (REL_BUCKETS - max_exact)).astype(jnp.int32)
    large = jnp.minimum(large, REL_BUCKETS - 1)
    return jnp.where(n < max_exact, n, large)


def causal_conv(x, w, b):
    c = x.shape[-1]
    y = lax.conv_general_dilated(x, w[:, None, :], window_strides=(1,),
                                 padding=((CONV_WIDTH - 1, 0),),
                                 dimension_numbers=('NWC', 'WIO', 'NWC'),
                                 feature_group_count=c)
    return y + b


def dsa_attention(q, c_kv, q_idx, k_idx, w_idx, rel_bias, topk):
    b, s = q.shape[:2]
    n_blocks = s // Q_BLOCK
    scale = KV_RANK ** -0.5
    s_pos = jnp.arange(s)

    def block(t0):
        qb = lax.dynamic_slice_in_dim(q, t0, Q_BLOCK, axis=1)
        qib = lax.dynamic_slice_in_dim(q_idx, t0, Q_BLOCK, axis=1)
        wib = lax.dynamic_slice_in_dim(w_idx, t0, Q_BLOCK, axis=1)
        t_pos = t0 + jnp.arange(Q_BLOCK)
        causal = s_pos[None, :] <= t_pos[:, None]
        dots = jnp.einsum('bthd,bsd->bths', qib, k_idx).astype(jnp.float32)
        score = jnp.einsum('bths,bth->bts', jax.nn.relu(dots), wib.astype(jnp.float32))
        score = jnp.where(causal[None], score, -jnp.inf)
        _, idx = lax.top_k(score, topk)
        valid = idx <= t_pos[None, :, None]
        kv_sel = jax.vmap(lambda c, i: c[i])(c_kv, idx)
        logits = jnp.einsum('bthr,btkr->bthk', qb, kv_sel).astype(jnp.float32) * scale
        bias = rel_bias[t5_bucket(t_pos[None, :, None] - idx)]
        logits = logits + jnp.transpose(bias, (0, 1, 3, 2)).astype(jnp.float32)
        logits = jnp.where(valid[:, :, None, :], logits, -jnp.inf)
        p = jax.nn.softmax(logits, axis=-1).astype(q.dtype)
        return jnp.einsum('bthk,btkr->bthr', p, kv_sel)

    out = lax.map(block, jnp.arange(n_blocks) * Q_BLOCK)
    return jnp.transpose(out, (1, 0, 2, 3, 4)).reshape(b, s, ATT_HEADS, KV_RANK)


def mlstm(q, k, v, i_pre, f_pre):
    out_dtype = v.dtype
    b, s = q.shape[:2]
    f32 = jnp.float32
    q = q.astype(f32)
    k = k.astype(f32) * (M_QK_DIM ** -0.5)
    v = v.astype(f32)
    ig = i_pre.astype(f32)
    lf = jax.nn.log_sigmoid(f_pre.astype(f32))

    def chunks(a):
        a = a.reshape((b, s // M_CHUNK, M_CHUNK) + a.shape[2:])
        return jnp.transpose(a, (1, 0, 3, 2) + tuple(range(4, a.ndim)))

    tril = jnp.tril(jnp.ones((M_CHUNK, M_CHUNK), dtype=bool))

    def step(carry, inp):
        c_st, n_st, m_st = carry
        qc, kc, vc, ic, fc = inp
        bcum = jnp.cumsum(fc, axis=-1)
        dmat = jnp.where(tril, bcum[..., :, None] - bcum[..., None, :] + ic[..., None, :], -jnp.inf)
        inter = bcum + m_st[..., None]
        m_row = jnp.maximum(inter, jnp.max(dmat, axis=-1))
        w_inter = jnp.exp(inter - m_row)
        qk = jnp.einsum('bhld,bhsd->bhls', qc, kc) * jnp.exp(dmat - m_row[..., None])
        num = (w_inter[..., None] * jnp.einsum('bhld,bhdv->bhlv', qc, c_st)
               + jnp.einsum('bhls,bhsv->bhlv', qk, vc))
        den = w_inter * jnp.einsum('bhld,bhd->bhl', qc, n_st) + jnp.sum(qk, axis=-1)
        h = num / jnp.maximum(jnp.abs(den), jnp.exp(-m_row))[..., None]
        b_last = bcum[..., -1]
        g = b_last[..., None] - bcum + ic
        m_new = jnp.maximum(b_last + m_st, jnp.max(g, axis=-1))
        decay = jnp.exp(b_last + m_st - m_new)
        wk = jnp.exp(g - m_new[..., None])
        c_new = decay[..., None, None] * c_st + jnp.einsum('bhs,bhsd,bhsv->bhdv', wk, kc, vc)
        n_new = decay[..., None] * n_st + jnp.einsum('bhs,bhsd->bhd', wk, kc)
        return (c_new, n_new, m_new), h

    init = (jnp.zeros((b, M_HEADS, M_QK_DIM, M_V_DIM), f32),
            jnp.zeros((b, M_HEADS, M_QK_DIM), f32),
            jnp.zeros((b, M_HEADS), f32))
    _, h = lax.scan(step, init, (chunks(q), chunks(k), chunks(v), chunks(ig), chunks(lf)))
    h = jnp.transpose(h, (1, 0, 3, 2, 4)).reshape(b, s, M_HEADS, M_V_DIM)
    return h.astype(out_dtype)


def setup_inputs(seed: int = 0) -> dict:
    key = jax.random.key(seed)
    ks = jax.random.split(key, 20)
    f32 = jnp.float32

    def nrm(k, shape, scale):
        return jax.random.normal(k, shape, f32) * scale

    def gain(k, shape):
        return 1.0 + 0.05 * jax.random.normal(k, shape, f32)

    L, D, F = DEPTH, D_MODEL, D_FF
    CQK = 2 * M_HEADS * M_QK_DIM
    return {
        'x': nrm(ks[0], (BATCH, SEQ, D), 1.0),
        'rel_bias': nrm(ks[1], (REL_BUCKETS, ATT_HEADS), 0.5),
        'ffn1_norm': gain(ks[2], (L, D)),
        'ffn1_w_gu': nrm(ks[3], (L, D, 2 * F), D ** -0.5),
        'ffn1_w_down': nrm(ks[4], (L, F, D), F ** -0.5),
        'mix_norm': gain(ks[5], (L, D)),
        'w_in': nrm(ks[6], (L, D, D_IN), D ** -0.5),
        'q_norm': gain(ks[7], (L, KV_RANK)),
        'kv_norm': gain(ks[8], (L, KV_RANK)),
        'conv_w': nrm(ks[9], (L, CONV_WIDTH, CQK), CONV_WIDTH ** -0.5),
        'conv_b': nrm(ks[10], (L, CQK), 0.02),
        'igate_b': nrm(ks[11], (L, M_HEADS), 0.1),
        'fgate_b': jnp.linspace(3.0, 6.0, M_HEADS, dtype=f32)[None, :] + nrm(ks[12], (L, M_HEADS), 0.1),
        'm_out_norm': gain(ks[13], (L, M_HEADS, M_V_DIM)),
        'w_att_out': nrm(ks[14], (L, ATT_HEADS, KV_RANK, D), (ATT_HEADS * KV_RANK) ** -0.5),
        'w_mem_out': nrm(ks[15], (L, M_HEADS * M_V_DIM, D), (M_HEADS * M_V_DIM) ** -0.5),
        'w_out': nrm(ks[16], (L, D, D), D ** -0.5),
        'ffn2_norm': gain(ks[17], (L, D)),
        'ffn2_w_gu': nrm(ks[18], (L, D, 2 * F), D ** -0.5),
        'ffn2_w_down': nrm(ks[19], (L, F, D), F ** -0.5),
    }


def reference(x, rel_bias, ffn1_norm, ffn1_w_gu, ffn1_w_down, mix_norm, w_in, q_norm, kv_norm,
              conv_w, conv_b, igate_b, fgate_b, m_out_norm, w_att_out, w_mem_out, w_out,
              ffn2_norm, ffn2_w_gu, ffn2_w_down):
    b, s, _ = x.shape
    topk = min(TOPK_MAX, s // 4)
    h = x
    for l in range(DEPTH):
        h = h + 0.5 * swiglu(rms_norm(h, ffn1_norm[l]), ffn1_w_gu[l], ffn1_w_down[l])
        u = rms_norm(h, mix_norm[l])
        proj = u @ w_in[l]
        (aq, ckv, iq, ik, iw, mqk, mv, mo, mi, mf, ga, gm) = jnp.split(proj, SPLIT_POINTS, axis=-1)
        aq = rms_norm(aq.reshape(b, s, ATT_HEADS, KV_RANK), q_norm[l])
        ckv = rms_norm(ckv, kv_norm[l])
        iq = iq.reshape(b, s, IDX_HEADS, IDX_DIM)
        iw = iw * (IDX_HEADS * IDX_DIM) ** -0.5
        o_att = dsa_attention(aq, ckv, iq, ik, iw, rel_bias, topk)
        y_att = jnp.einsum('bshr,hrd->bsd', o_att, w_att_out[l])
        mqk = jax.nn.silu(causal_conv(mqk, conv_w[l], conv_b[l]))
        mq, mk = jnp.split(mqk, 2, axis=-1)
        hm = mlstm(mq.reshape(b, s, M_HEADS, M_QK_DIM), mk.reshape(b, s, M_HEADS, M_QK_DIM),
                   mv.reshape(b, s, M_HEADS, M_V_DIM), mi + igate_b[l], mf + fgate_b[l])
        hm = rms_norm(hm, m_out_norm[l]).reshape(b, s, M_HEADS * M_V_DIM) * jax.nn.sigmoid(mo)
        y_mem = hm @ w_mem_out[l]
        merged = jax.nn.sigmoid(ga) * y_att + jax.nn.sigmoid(gm) * y_mem
        h = h + merged @ w_out[l]
        h = h + 0.5 * swiglu(rms_norm(h, ffn2_norm[l]), ffn2_w_gu[l], ffn2_w_down[l])
    return h
```

```cpp
#include <hip/hip_runtime.h>
#include <cstdio>
#include <cstdint>
#include <cmath>

#define GAS __attribute__((address_space(1)))
#define LAS __attribute__((address_space(3)))
typedef unsigned short bf16;
typedef unsigned v4u __attribute__((ext_vector_type(4)));
typedef unsigned v2u __attribute__((ext_vector_type(2)));
typedef float f32x4 __attribute__((ext_vector_type(4)));
typedef float f32x2 __attribute__((ext_vector_type(2)));
typedef short bf16x8 __attribute__((ext_vector_type(8)));
typedef GAS unsigned gu32;

constexpr int BATCH = 8, SEQ = 2048, D = 2048, DEPTH = 4, M = BATCH * SEQ;
constexpr int AH = 8, RK = 256, IH = 8, IDIM = 64, TOPK = 256;
constexpr int MH = 4, DK = 128, DV = 256, CHUNK = 64, NCHUNK = SEQ / CHUNK;
constexpr int FF = 5504, FF2 = 2 * FF;
constexpr int DIN = 10064, DINP = 10240;
constexpr float EPS = 1e-6f;
constexpr int P_AQ = 0, P_CKV = 2048, P_IQ = 2304, P_IK = 2816, P_MQK = 2880, P_MV = 3904, P_MO = 4928, P_GA = 5952, P_GM = 8000, P_IW = 10048, P_MI = 10056, P_MF = 10060;
__host__ __device__ __forceinline__ int win_src_of_dest(int d) {
    if (d < 2880) return d;
    if (d < 5952) return d + 8;
    if (d < 10048) return d + 16;
    if (d < 10056) return 2880 + (d - 10048);
    if (d < 10064) return 5960 + (d - 10056);
    return -1;
}
__host__ __device__ __forceinline__ int gu_src_of_dest(int d) { const int pn = d >> 8, r = d & 255; return (r < 128) ? (pn * 128 + r) : (FF + pn * 128 + (r - 128)); }

constexpr size_t MiB = 1u << 20;
constexpr size_t WS_CTL = 0, CTL_ZERO_BYTES = 1 * MiB;
constexpr size_t SZ_GU = (size_t)FF2 * D * 2, SZ_DN = (size_t)D * FF * 2, SZ_IN = (size_t)DINP * D * 2, SZ_AO = (size_t)D * D * 2, SZ_MO = (size_t)D * 1024 * 2, SZ_WO = (size_t)D * D * 2;
constexpr size_t LAYER_W = 2 * SZ_GU + 2 * SZ_DN + SZ_IN + SZ_AO + SZ_MO + SZ_WO;
constexpr size_t OW_GU1 = 0, OW_DN1 = OW_GU1 + SZ_GU, OW_IN = OW_DN1 + SZ_DN, OW_AO = OW_IN + SZ_IN, OW_MO = OW_AO + SZ_AO, OW_WO = OW_MO + SZ_MO, OW_GU2 = OW_WO + SZ_WO, OW_DN2 = OW_GU2 + SZ_GU;
constexpr size_t WS_W = 1 * MiB;
constexpr size_t WS_XN = WS_W + DEPTH * LAYER_W;
constexpr size_t WS_PROJ = WS_XN + (size_t)M * D * 2;
constexpr size_t WS_MQK = WS_PROJ + (size_t)M * DINP * 2;
constexpr size_t WS_HRAW = WS_MQK + (size_t)M * 1024 * 2;
constexpr size_t WS_HM = WS_HRAW + (size_t)M * 1024 * 2;
constexpr size_t WS_Y = WS_HM + (size_t)M * 1024 * 2;
constexpr size_t WS_PART = WS_Y + (size_t)M * D * 2;
constexpr size_t WS_END = WS_PART + (size_t)M * 32 * 4;
static_assert(WS_END <= (size_t)1440 * 1000 * 1000, "workspace map must fit 4x the largest input tensor");
static_assert((LAYER_W % 256) == 0, "alignment");

constexpr int CW_TMO = 0, CW_CODE = 1;
constexpr int CW_BAR = 4096;
constexpr int CW_TICKET = 8192;
constexpr int CW_CVT = 8192 + 1024;
constexpr int CW_ATK = 12288;
constexpr int CW_CVD = 14336;
constexpr int CW_GBAR = 16384;
constexpr int NGROUP = 8, GROUP_WG = 32;

constexpr int RING_OFF = 0, RING_BYTES = 131072;
constexpr int LDSCTL_OFF = RING_BYTES, MISC_OFF = LDSCTL_OFF + 320;
constexpr int LDS_BYTES = 147456;
constexpr int NWAVES = 8;

#define RLX_AGENT __ATOMIC_RELAXED, __HIP_MEMORY_SCOPE_AGENT
#define LDS_WAIT() asm volatile("s_waitcnt lgkmcnt(0)" ::: "memory")
#define VM_WAIT() asm volatile("s_waitcnt vmcnt(0)" ::: "memory")
__device__ __forceinline__ unsigned f2bf(float f) { unsigned u = __builtin_bit_cast(unsigned, f); return (u + 0x7fffu + ((u >> 16) & 1u)) >> 16; }
typedef __bf16 bf16x2_hw __attribute__((ext_vector_type(2)));
__device__ __forceinline__ unsigned pk2(float lo, float hi) { const f32x2 v = {lo, hi}; const bf16x2_hw b = __builtin_convertvector(v, bf16x2_hw); return __builtin_bit_cast(unsigned, b); }
__device__ __forceinline__ float bflo(unsigned w) { return __builtin_bit_cast(float, w << 16); }
__device__ __forceinline__ float bfhi(unsigned w) { return __builtin_bit_cast(float, w & 0xffff0000u); }
__device__ __forceinline__ float bf2f(bf16 b) { return __builtin_bit_cast(float, ((unsigned)b) << 16); }
__device__ __forceinline__ float silu_f(float g) { return g * __builtin_amdgcn_rcpf(1.0f + __expf(-g)); }
__device__ __forceinline__ float sigm_f(float g) { return __builtin_amdgcn_rcpf(1.0f + __expf(-g)); }
__device__ __forceinline__ float wave_sum(float v) {
#pragma unroll
    for (int o = 1; o < 64; o <<= 1) v += __shfl_xor(v, o);
    return v;
}
__device__ __forceinline__ float wave_max(float v) {
#pragma unroll
    for (int o = 1; o < 64; o <<= 1) v = fmaxf(v, __shfl_xor(v, o));
    return v;
}
__device__ __forceinline__ unsigned sortable_key(float f) { const unsigned u = __builtin_bit_cast(unsigned, f); return (u & 0x80000000u) ? ~u : (u | 0x80000000u); }
__device__ __forceinline__ int t5_bucket_dev(int n) {
    if (n < 16) return n;
    const float v = logf((float)n / 16.0f) / 2.0794415416798357f * 16.0f;
    int large = 16 + (int)v; return large < 31 ? large : 31;
}
__device__ __forceinline__ int wave_sum_dpp(int v) {
    v += __builtin_amdgcn_update_dpp(0, v, 0xB1, 0xF, 0xF, true);
    v += __builtin_amdgcn_update_dpp(0, v, 0x4E, 0xF, 0xF, true);
    v += __builtin_amdgcn_update_dpp(0, v, 0x141, 0xF, 0xF, true);
    v += __builtin_amdgcn_update_dpp(0, v, 0x140, 0xF, 0xF, true);
    v += __builtin_amdgcn_update_dpp(0, v, 0x142, 0xA, 0xF, true);
    v += __builtin_amdgcn_update_dpp(0, v, 0x143, 0xC, 0xF, true);
    return __builtin_amdgcn_readlane(v, 63);
}
__device__ __forceinline__ int fresh_tid(int wave) { int w_ = wave; asm volatile("" : "+s"(w_)); unsigned m_ = ~0u; asm volatile("" : "+s"(m_)); const int l_ = (int)__builtin_amdgcn_mbcnt_hi(m_, __builtin_amdgcn_mbcnt_lo(m_, 0u));     return w_ * 64 + l_; }

namespace pg8 {
#define PG8_LAS __attribute__((address_space(3)))
typedef unsigned short bf16_t;
typedef short bf16x8 __attribute__((ext_vector_type(8)));
typedef float f32x4 __attribute__((ext_vector_type(4)));
typedef unsigned u32x4 __attribute__((ext_vector_type(4)));
constexpr int BM = 256, BK = 64, HALF = 128, HTB = HALF * BK * 2  , STAGE_BYTES = 8 * HTB, NXCD = 8, WGM = 8;

__host__ __device__ __forceinline__ int lds_byte(int r, int c) { const int st = (r >> 4) * 2 + (c >> 5), rr = r & 15, cc = c & 31, ob = rr * 64 + cc * 2; return st * 1024 + (ob ^ (((ob >> 9) & 1) << 5)); }
__host__ __device__ __forceinline__ void stage_rc(int b, int& R, int& C) { const int st = b / 1024, sb = b % 1024, swz = sb ^ (((sb >> 9) & 1) << 5); R = (st >> 1) * 16 + swz / 64; C = (st & 1) * 32 + (swz % 64) / 2; }
__host__ __device__ __forceinline__ int perm32(int rho) { const int n = rho >> 4, i = rho & 15; return 8 * (i >> 2) + 4 * n + (i & 3); }

struct Unit { int pm, pn; };
struct Gemm { const bf16_t* A; const bf16_t* Bt; int M, N, K, lda, wave; };

struct StaticOrder {
    int nM, nN, nwg, G, c;
    __host__ __device__ void init(int M, int N, int G_, int c_) { nM = M / BM; nN = N / BM; nwg = nM * nN; G = G_; c = c_; }
    __host__ __device__ bool next(int i, Unit& u) const {
        const long L = (long)i * G + c; if (L >= nwg) return false;
        int wgid = (int)L; { const int q = nwg / NXCD, r = nwg % NXCD, xcd = wgid % NXCD, off = wgid / NXCD; wgid = (xcd < r ? xcd * (q + 1) : r * (q + 1) + (xcd - r) * q) + off; }
        const int nig = WGM * nN, gid = wgid / nig, fm = gid * WGM, gsz = (nM - fm) < WGM ? (nM - fm) : WGM;
        u.pm = fm + ((wgid % nig) % gsz); u.pn = (wgid % nig) / gsz; return true;
    }
    __device__ __forceinline__ void a_ready(const Unit&) const {}
    __device__ __forceinline__ void done(const Unit&) const {}
};

__device__ __forceinline__ unsigned cvt_pk_bf16(float lo, float hi) { return pk2(lo, hi); }

__device__ __forceinline__ void rows_rstd(float (&rs)[2][4], const float* part, int row0, int fq) {
    f32x4 a[2][4], b[2][4];
#pragma unroll
    for (int ai = 0; ai < 2; ++ai)
#pragma unroll
        for (int m = 0; m < 4; ++m) { const float* p = part + (size_t)(row0 + ai * HALF + m * 16) * 32 + 8 * fq; a[ai][m] = *(const __attribute__((address_space(1))) f32x4*)p; b[ai][m] = *(const __attribute__((address_space(1))) f32x4*)(p + 4); }
#pragma unroll
    for (int ai = 0; ai < 2; ++ai)
#pragma unroll
        for (int m = 0; m < 4; ++m) { float s = ((a[ai][m][0] + a[ai][m][1]) + (a[ai][m][2] + a[ai][m][3])) + ((b[ai][m][0] + b[ai][m][1]) + (b[ai][m][2] + b[ai][m][3]));
            s += __shfl_xor(s, 16); s += __shfl_xor(s, 32); rs[ai][m] = 1.0f / sqrtf(s * (1.0f / 2048.0f) + 1e-6f); }
}
struct EpiBf16 {
    static constexpr bool PERM = true, AFTER_DRAIN = false;
    bf16_t* O; int ldc; const float* ssq; const PG8_LAS float* rtab; int pm0;
    __device__ __forceinline__ void operator()(const f32x4 (&acc)[2][2][4][2], const Unit& u, int wr, int wc, int fr, int fq) const {
        const int row0 = u.pm * BM + wr * 64 + fr; const int col0 = u.pn * BM + wc * 32 + 8 * fq;
#pragma unroll
        for (int ai = 0; ai < 2; ++ai)
#pragma unroll
            for (int m = 0; m < 4; ++m) { const int row = row0 + ai * HALF + m * 16; bf16_t* rowp = O + (size_t)row * ldc + col0;
                const float rs = rtab[wr * 64 + fr + ai * HALF + m * 16];
#pragma unroll
                for (int bj = 0; bj < 2; ++bj) { const f32x4 v0 = acc[ai][bj][m][0] * rs, v1 = acc[ai][bj][m][1] * rs;
                    u32x4 w; w.x = cvt_pk_bf16(v0[0], v0[1]); w.y = cvt_pk_bf16(v0[2], v0[3]); w.z = cvt_pk_bf16(v1[0], v1[1]); w.w = cvt_pk_bf16(v1[2], v1[3]);
                    *(__attribute__((address_space(1))) u32x4*)(rowp + bj * HALF) = w; } }
    }
};
struct EpiProj {
    static constexpr bool PERM = true, AFTER_DRAIN = false;
    bf16_t* O; int ldc; const PG8_LAS float* rtab; PG8_LAS float* tab2; const float* qg; const float* kg;
    __device__ __forceinline__ void operator()(const f32x4 (&acc)[2][2][4][2], const Unit& u, int wr, int wc, int fr, int fq) const {
        typedef __attribute__((address_space(1))) u32x4 gu4; typedef __attribute__((address_space(1))) const f32x4 gcf4;
        const int row0 = u.pm * BM + wr * 64 + fr; const int col0 = u.pn * BM + wc * 32 + 8 * fq;
        if (u.pn <= 8) {
#pragma unroll
            for (int ai = 0; ai < 2; ++ai)
#pragma unroll
                for (int m = 0; m < 4; ++m) { const int rl = wr * 64 + fr + ai * HALF + m * 16; const float rs = rtab[rl]; float s = 0.f;
#pragma unroll
                    for (int bj = 0; bj < 2; ++bj)
#pragma unroll
                        for (int n = 0; n < 2; ++n) { const f32x4 v = acc[ai][bj][m][n] * rs; s += (v[0] * v[0] + v[1] * v[1]) + (v[2] * v[2] + v[3] * v[3]); }
                    s += __shfl_xor(s, 16); s += __shfl_xor(s, 32);
                    if (fq == 0) tab2[rl * 4 + wc] = s; }
            asm volatile("s_waitcnt lgkmcnt(0)\n\ts_barrier" ::: "memory");
            const float* gp = (u.pn < 8 ? qg : kg) + wc * 32 + 8 * fq;
            const float qsc = (u.pn < 8) ? 0.0625f * 1.4426950408889634f : 1.0f;
            f32x4 gv[2][2];
#pragma unroll
            for (int bj = 0; bj < 2; ++bj)
#pragma unroll
                for (int n = 0; n < 2; ++n) gv[bj][n] = *(gcf4*)(gp + bj * HALF + 4 * n);
#pragma unroll
            for (int ai = 0; ai < 2; ++ai)
#pragma unroll
                for (int m = 0; m < 4; ++m) { const int rl = wr * 64 + fr + ai * HALF + m * 16; bf16_t* rowp = O + (size_t)(row0 + ai * HALF + m * 16) * ldc + col0;
                    const f32x4 t4 = *(const PG8_LAS f32x4*)(tab2 + rl * 4);
                    const float rs = qsc * rtab[rl] / sqrtf(((t4[0] + t4[1]) + (t4[2] + t4[3])) * (1.0f / 256.0f) + 1e-6f);
#pragma unroll
                    for (int bj = 0; bj < 2; ++bj) { const f32x4 v0 = acc[ai][bj][m][0] * rs * gv[bj][0], v1 = acc[ai][bj][m][1] * rs * gv[bj][1];
                        u32x4 w; w.x = cvt_pk_bf16(v0[0], v0[1]); w.y = cvt_pk_bf16(v0[2], v0[3]); w.z = cvt_pk_bf16(v1[0], v1[1]); w.w = cvt_pk_bf16(v1[2], v1[3]);
                        *(gu4*)(rowp + bj * HALF) = w; } }
            asm volatile("s_waitcnt lgkmcnt(0)\n\ts_barrier" ::: "memory");
        } else {
#pragma unroll
            for (int ai = 0; ai < 2; ++ai)
#pragma unroll
                for (int m = 0; m < 4; ++m) { bf16_t* rowp = O + (size_t)(row0 + ai * HALF + m * 16) * ldc + col0;
                    const float rs = rtab[wr * 64 + fr + ai * HALF + m * 16];
#pragma unroll
                    for (int bj = 0; bj < 2; ++bj) { const f32x4 v0 = acc[ai][bj][m][0] * rs, v1 = acc[ai][bj][m][1] * rs;
                        u32x4 w; w.x = cvt_pk_bf16(v0[0], v0[1]); w.y = cvt_pk_bf16(v0[2], v0[3]); w.z = cvt_pk_bf16(v1[0], v1[1]); w.w = cvt_pk_bf16(v1[2], v1[3]);
                        *(gu4*)(rowp + bj * HALF) = w; } }
        }
    }
};
struct EpiSwiGLU {
    static constexpr bool PERM = true, AFTER_DRAIN = false;
    bf16_t* O; int ldc; const float* ssq; const PG8_LAS float* rtab; int pm0;
    __device__ __forceinline__ void operator()(const f32x4 (&acc)[2][2][4][2], const Unit& u, int wr, int wc, int fr, int fq) const {
        const int row0 = u.pm * BM + wr * 64 + fr; const int col0 = u.pn * HALF + wc * 32 + 8 * fq;
#pragma unroll
        for (int ai = 0; ai < 2; ++ai)
#pragma unroll
            for (int m = 0; m < 4; ++m) { const int row = row0 + ai * HALF + m * 16; bf16_t* rowp = O + (size_t)row * ldc + col0;
                const float rs = rtab[wr * 64 + fr + ai * HALF + m * 16];
                f32x4 v0, v1;
                {
                    const float nrs_ = rs * -1.4426950408889634f, rsq_ = rs * rs; const f32x2 nrs2 = {nrs_, nrs_}, rsq2 = {rsq_, rsq_}, one2 = {1.0f, 1.0f};
#pragma unroll
                    for (int h = 0; h < 2; ++h) {
                        const f32x2 g0 = {acc[ai][0][m][0][2 * h], acc[ai][0][m][0][2 * h + 1]}, u0 = {acc[ai][1][m][0][2 * h], acc[ai][1][m][0][2 * h + 1]};
                        const f32x2 g1 = {acc[ai][0][m][1][2 * h], acc[ai][0][m][1][2 * h + 1]}, u1 = {acc[ai][1][m][1][2 * h], acc[ai][1][m][1][2 * h + 1]};
                        const f32x2 a0 = g0 * nrs2, a1 = g1 * nrs2; const f32x2 t0 = (g0 * u0) * rsq2, t1 = (g1 * u1) * rsq2;
                        const f32x2 e0 = {__builtin_amdgcn_exp2f(a0.x), __builtin_amdgcn_exp2f(a0.y)}, e1 = {__builtin_amdgcn_exp2f(a1.x), __builtin_amdgcn_exp2f(a1.y)};
                        const f32x2 d0 = e0 + one2, d1 = e1 + one2;
                        const f32x2 r0 = {__builtin_amdgcn_rcpf(d0.x), __builtin_amdgcn_rcpf(d0.y)}, r1 = {__builtin_amdgcn_rcpf(d1.x), __builtin_amdgcn_rcpf(d1.y)};
                        const f32x2 o0 = t0 * r0, o1 = t1 * r1;
                        v0[2 * h] = o0.x; v0[2 * h + 1] = o0.y; v1[2 * h] = o1.x; v1[2 * h + 1] = o1.y; } }
                u32x4 w; w.x = cvt_pk_bf16(v0[0], v0[1]); w.y = cvt_pk_bf16(v0[2], v0[3]); w.z = cvt_pk_bf16(v1[0], v1[1]); w.w = cvt_pk_bf16(v1[2], v1[3]);
                *(__attribute__((address_space(1))) u32x4*)(rowp) = w; }
    }
};
template <bool FINAL, int ALPHA2> struct EpiResid {
    static constexpr bool PERM = true, AFTER_DRAIN = false;
    bf16_t* H; int ldc; float* ssq; float* outf;
    __device__ __forceinline__ void operator()(const f32x4 (&acc)[2][2][4][2], const Unit& u, int wr, int wc, int fr, int fq) const {
        typedef __attribute__((address_space(1))) const u32x4 gcu4; typedef __attribute__((address_space(1))) f32x4 gf4; typedef __attribute__((address_space(1))) u32x4 gu4; typedef __attribute__((address_space(1))) float gf1;
        const int row0 = u.pm * BM + wr * 64 + fr, col0 = u.pn * BM + wc * 32 + 8 * fq;
#pragma unroll
        for (int ai = 0; ai < 2; ++ai) {
            u32x4 hb[4][2];
#pragma unroll
            for (int m = 0; m < 4; ++m)
#pragma unroll
                for (int bj = 0; bj < 2; ++bj) hb[m][bj] = *(gcu4*)(H + (size_t)(row0 + ai * HALF + m * 16) * ldc + col0 + bj * HALF);
#pragma unroll
            for (int m = 0; m < 4; ++m) { const size_t off = (size_t)(row0 + ai * HALF + m * 16) * ldc + col0; float s = 0.f;
#pragma unroll
                for (int bj = 0; bj < 2; ++bj) { const u32x4 h4 = hb[m][bj];
                    f32x4 v0, v1;
                    v0[0] = __builtin_bit_cast(float, h4.x << 16); v0[1] = __builtin_bit_cast(float, h4.x & 0xffff0000u); v0[2] = __builtin_bit_cast(float, h4.y << 16); v0[3] = __builtin_bit_cast(float, h4.y & 0xffff0000u);
                    v1[0] = __builtin_bit_cast(float, h4.z << 16); v1[1] = __builtin_bit_cast(float, h4.z & 0xffff0000u); v1[2] = __builtin_bit_cast(float, h4.w << 16); v1[3] = __builtin_bit_cast(float, h4.w & 0xffff0000u);
                    v0 = v0 + acc[ai][bj][m][0] * (0.5f * (float)ALPHA2); v1 = v1 + acc[ai][bj][m][1] * (0.5f * (float)ALPHA2);
                    if (FINAL) { *(gf4*)(outf + off + bj * HALF) = v0; *(gf4*)(outf + off + bj * HALF + 4) = v1; }
                    else { s += ((v0[0] * v0[0] + v0[1] * v0[1]) + (v0[2] * v0[2] + v0[3] * v0[3])) + ((v1[0] * v1[0] + v1[1] * v1[1]) + (v1[2] * v1[2] + v1[3] * v1[3]));
                        u32x4 w; w.x = cvt_pk_bf16(v0[0], v0[1]); w.y = cvt_pk_bf16(v0[2], v0[3]); w.z = cvt_pk_bf16(v1[0], v1[1]); w.w = cvt_pk_bf16(v1[2], v1[3]);
                        *(gu4*)(H + off + bj * HALF) = w; } }
                if (!FINAL) { s += __shfl_xor(s, 16); s += __shfl_xor(s, 32);
                    if (fq == 0) *(gf1*)(ssq + (size_t)(row0 + ai * HALF + m * 16) * 32 + u.pn * 4 + wc) = s; } }
        }
    }
};
template <int MODE> struct EpiGate {
    static constexpr bool PERM = true, AFTER_DRAIN = false;
    bf16_t* Y; int ldc; const bf16_t* gate; int ldg;
    __device__ __forceinline__ void operator()(const f32x4 (&acc)[2][2][4][2], const Unit& u, int wr, int wc, int fr, int fq) const {
        typedef __attribute__((address_space(1))) const u32x4 gcu4; typedef __attribute__((address_space(1))) u32x4 gu4;
        const int row0 = u.pm * BM + wr * 64 + fr; const int col0 = u.pn * BM + wc * 32 + 8 * fq;
#pragma unroll
        for (int ai = 0; ai < 2; ++ai) {
            u32x4 gw[4][2], yw[4][2];
#pragma unroll
            for (int m = 0; m < 4; ++m)
#pragma unroll
                for (int bj = 0; bj < 2; ++bj) { const int row = row0 + ai * HALF + m * 16; gw[m][bj] = *(gcu4*)(gate + (size_t)row * ldg + col0 + bj * HALF);
                    if (MODE == 1) yw[m][bj] = *(gcu4*)(Y + (size_t)row * ldc + col0 + bj * HALF); }
#pragma unroll
            for (int m = 0; m < 4; ++m) { const int row = row0 + ai * HALF + m * 16; bf16_t* rowp = Y + (size_t)row * ldc + col0;
#pragma unroll
                for (int bj = 0; bj < 2; ++bj) { const u32x4 g4 = gw[m][bj];
                    float gv[8]; gv[0] = __builtin_bit_cast(float, g4.x << 16); gv[1] = __builtin_bit_cast(float, g4.x & 0xffff0000u); gv[2] = __builtin_bit_cast(float, g4.y << 16); gv[3] = __builtin_bit_cast(float, g4.y & 0xffff0000u);
                    gv[4] = __builtin_bit_cast(float, g4.z << 16); gv[5] = __builtin_bit_cast(float, g4.z & 0xffff0000u); gv[6] = __builtin_bit_cast(float, g4.w << 16); gv[7] = __builtin_bit_cast(float, g4.w & 0xffff0000u);
                    float o[8];
#pragma unroll
                    for (int j = 0; j < 4; ++j) { o[j] = sigm_f(gv[j]) * acc[ai][bj][m][0][j]; o[4 + j] = sigm_f(gv[4 + j]) * acc[ai][bj][m][1][j]; }
                    if (MODE == 1) { const u32x4 y4 = yw[m][bj];
                        o[0] += __builtin_bit_cast(float, y4.x << 16); o[1] += __builtin_bit_cast(float, y4.x & 0xffff0000u); o[2] += __builtin_bit_cast(float, y4.y << 16); o[3] += __builtin_bit_cast(float, y4.y & 0xffff0000u);
                        o[4] += __builtin_bit_cast(float, y4.z << 16); o[5] += __builtin_bit_cast(float, y4.z & 0xffff0000u); o[6] += __builtin_bit_cast(float, y4.w << 16); o[7] += __builtin_bit_cast(float, y4.w & 0xffff0000u); }
                    u32x4 w; w.x = cvt_pk_bf16(o[0], o[1]); w.y = cvt_pk_bf16(o[2], o[3]); w.z = cvt_pk_bf16(o[4], o[5]); w.w = cvt_pk_bf16(o[6], o[7]);
                    *(gu4*)(rowp + bj * HALF) = w; } }
        }
    }
};

template <class Epi, class Sched, bool ALIGN_EPI = false, bool SP2 = false>
__device__ __forceinline__ void gemm_phase(PG8_LAS unsigned char* lds, const Gemm g, const Sched& S, const Epi& E) {
    const int tid_ = fresh_tid(g.wave);
    const int tid = tid_, wid = __builtin_amdgcn_readfirstlane(tid >> 6), lane = tid & 63, wr = wid >> 2, wc = wid & 3, fr = lane & 15, fq = lane >> 4;
    const int K = g.K, nt = K / BK;
    unsigned voffA[2], voffB[2];
#pragma unroll
    for (int i = 0; i < 2; ++i) { int R, C; stage_rc(tid * 16 + i * 8192, R, C); const int Rb = Epi::PERM ? ((R & ~31) + perm32(R & 31)) : R;
        voffA[i] = (unsigned)(R * g.lda + C) * 2u; voffB[i] = (unsigned)(Rb * K + C) * 2u; }
    const size_t kstep = (size_t)(BK * 2);
    const size_t hstepB = (size_t)HALF * K * 2, hstepA = (size_t)HALF * g.lda * 2;
    const size_t tstepB = 2 * hstepB, tstepA = 2 * hstepA;
    const unsigned ldsw = (unsigned)wid * 1024u;
    const int aoff = lds_byte(wr * 64 + fr, fq * 8), boff = lds_byte(wc * 32 + fr, fq * 8);
#define PG8_SA(b, h) (((b) * 2 + (h)) * HTB)
#define PG8_SB(b, h) ((4 + (b) * 2 + (h)) * HTB)
#define PG8_STAGE(bufoff, gbase, voff) do { _Pragma("unroll") for (int _i = 0; _i < 2; ++_i) \
        __builtin_amdgcn_global_load_lds((const unsigned*)((const char*)(gbase) + (voff)[_i]), (PG8_LAS unsigned*)(lds + (bufoff) + ldsw + _i * 8192), 16, 0, 0); } while (0)
#define PG8_LDA(dst, b, h) do { _Pragma("unroll") for (int m = 0; m < 4; ++m) _Pragma("unroll") for (int k = 0; k < 2; ++k) dst[m][k] = *(const PG8_LAS bf16x8*)(lds + PG8_SA(b, h) + aoff + m * 2048 + k * 1024); } while (0)
#define PG8_LDB(dst, b, h) do { _Pragma("unroll") for (int n = 0; n < 2; ++n) _Pragma("unroll") for (int k = 0; k < 2; ++k) dst[n][k] = *(const PG8_LAS bf16x8*)(lds + PG8_SB(b, h) + boff + n * 2048 + k * 1024); } while (0)
#define PG8_MMA(ai, bj, At, Bt) do { __builtin_amdgcn_s_setprio(1); _Pragma("unroll") for (int m = 0; m < 4; ++m) _Pragma("unroll") for (int n = 0; n < 2; ++n) _Pragma("unroll") for (int k = 0; k < 2; ++k) \
        acc[ai][bj][m][n] = __builtin_amdgcn_mfma_f32_16x16x32_bf16(Bt[n][k], At[m][k], acc[ai][bj][m][n], 0, 0, 0); __builtin_amdgcn_s_setprio(0); } while (0)
#define PG8_WAIT_V(n) asm volatile("s_waitcnt vmcnt(" #n ")" ::: "memory")
#define PG8_WAIT_L(n) asm volatile("s_waitcnt lgkmcnt(" #n ")" ::: "memory")
#define PG8_BAR __builtin_amdgcn_s_barrier()
#define PG8_SCHED __builtin_amdgcn_sched_barrier(0)
    Unit cur, nxt; int ui = 0;
    if (!S.next(0, cur)) return;
    f32x4 acc[2][2][4][2];
#pragma unroll
    for (int a = 0; a < 2; ++a)
#pragma unroll
        for (int b = 0; b < 2; ++b)
#pragma unroll
            for (int m = 0; m < 4; ++m)
#pragma unroll
                for (int n = 0; n < 2; ++n) acc[a][b][m][n] = (f32x4){0.f, 0.f, 0.f, 0.f};
    bf16x8 At[4][2], B0[2][2], B1[2][2];
    const char* cA = (const char*)g.A + (size_t)cur.pm * tstepA; const char* cB = (const char*)g.Bt + (size_t)cur.pn * tstepB;
    S.a_ready(cur);
    if constexpr (SP2) {
        PG8_STAGE(PG8_SB(0, 0), cB, voffB); PG8_STAGE(PG8_SB(0, 1), cB + hstepB, voffB); PG8_STAGE(PG8_SA(0, 0), cA, voffA); PG8_STAGE(PG8_SA(0, 1), cA + hstepA, voffA);
        if (wr == 1) PG8_BAR;
        PG8_WAIT_V(2); PG8_BAR;
        PG8_STAGE(PG8_SB(1, 0), cB + kstep, voffB); PG8_STAGE(PG8_SA(1, 0), cA + kstep, voffA); PG8_STAGE(PG8_SB(1, 1), cB + hstepB + kstep, voffB);
        PG8_WAIT_V(6); PG8_BAR;
    } else {
        PG8_STAGE(PG8_SB(0, 0), cB, voffB); PG8_STAGE(PG8_SA(0, 0), cA, voffA); PG8_STAGE(PG8_SB(0, 1), cB + hstepB, voffB); PG8_STAGE(PG8_SA(0, 1), cA + hstepA, voffA);
        if (wr == 1) PG8_BAR;
        PG8_WAIT_V(4); PG8_BAR;
        PG8_STAGE(PG8_SB(1, 0), cB + kstep, voffB); PG8_STAGE(PG8_SA(1, 0), cA + kstep, voffA); PG8_STAGE(PG8_SB(1, 1), cB + hstepB + kstep, voffB);
        PG8_WAIT_V(6); PG8_BAR;
    }
    for (;;) {
        const bool has_next = S.next(ui + 1, nxt);
        const char* nA = has_next ? (const char*)g.A + (size_t)nxt.pm * tstepA : cA; const char* nB = has_next ? (const char*)g.Bt + (size_t)nxt.pn * tstepB : cB;
        for (int t = 0; t < nt; t += 2) {
            const bool last = (t == nt - 2);
            const char* a1 = cA + (size_t)(t + 1) * kstep;
            const char* a2 = last ? nA : cA + (size_t)(t + 2) * kstep; const char* b2 = last ? nB : cB + (size_t)(t + 2) * kstep;
            const char* a3 = a2 + kstep; const char* b3 = b2 + kstep;
            if (last && has_next) S.a_ready(nxt);
            if constexpr (SP2) {
            PG8_LDB(B0, 0, 0); PG8_LDB(B1, 0, 1); PG8_SCHED; PG8_LDA(At, 0, 0); PG8_STAGE(PG8_SA(1, 1), a1 + hstepA, voffA);
            PG8_WAIT_V(8); PG8_WAIT_L(0); PG8_BAR; PG8_MMA(0, 0, At, B0); PG8_MMA(0, 1, At, B1); PG8_BAR; PG8_SCHED;
            PG8_LDA(At, 0, 1); PG8_STAGE(PG8_SB(0, 0), b2, voffB); PG8_STAGE(PG8_SB(0, 1), b2 + hstepB, voffB); PG8_STAGE(PG8_SA(0, 0), a2, voffA);
            PG8_WAIT_V(8); PG8_WAIT_L(0); PG8_BAR; PG8_MMA(1, 0, At, B0); PG8_MMA(1, 1, At, B1); PG8_BAR; PG8_SCHED;
            PG8_LDB(B0, 1, 0); PG8_LDB(B1, 1, 1); PG8_SCHED; PG8_LDA(At, 1, 0); PG8_STAGE(PG8_SA(0, 1), a2 + hstepA, voffA);
            PG8_WAIT_V(8); PG8_WAIT_L(0); PG8_BAR; PG8_MMA(0, 0, At, B0); PG8_MMA(0, 1, At, B1); PG8_BAR; PG8_SCHED;
            PG8_LDA(At, 1, 1); PG8_STAGE(PG8_SB(1, 0), b3, voffB); PG8_STAGE(PG8_SB(1, 1), b3 + hstepB, voffB); PG8_STAGE(PG8_SA(1, 0), a3, voffA);
            PG8_WAIT_V(8); PG8_WAIT_L(0); PG8_BAR; PG8_MMA(1, 0, At, B0); PG8_MMA(1, 1, At, B1); PG8_BAR; PG8_SCHED;
            } else {
            PG8_LDB(B0, 0, 0); PG8_SCHED; PG8_LDA(At, 0, 0); PG8_STAGE(PG8_SA(1, 1), a1 + hstepA, voffA);
            PG8_WAIT_L(8); PG8_BAR; PG8_WAIT_L(0); PG8_MMA(0, 0, At, B0); PG8_BAR; PG8_SCHED;
            PG8_LDB(B1, 0, 1); PG8_STAGE(PG8_SB(0, 0), b2, voffB);
            PG8_BAR; PG8_WAIT_L(0); PG8_MMA(0, 1, At, B1); PG8_BAR;
            PG8_LDA(At, 0, 1); PG8_STAGE(PG8_SA(0, 0), a2, voffA);
            PG8_BAR; PG8_WAIT_L(0); PG8_MMA(1, 0, At, B0); PG8_BAR; PG8_SCHED;
            PG8_STAGE(PG8_SB(0, 1), b2 + hstepB, voffB);
            PG8_WAIT_V(6); PG8_BAR; PG8_MMA(1, 1, At, B1); PG8_BAR;
            PG8_LDB(B0, 1, 0); PG8_SCHED; PG8_LDA(At, 1, 0); PG8_STAGE(PG8_SA(0, 1), a2 + hstepA, voffA);
            PG8_WAIT_L(8); PG8_BAR; PG8_WAIT_L(0); PG8_MMA(0, 0, At, B0); PG8_BAR; PG8_SCHED;
            PG8_LDB(B1, 1, 1); PG8_STAGE(PG8_SB(1, 0), b3, voffB);
            PG8_BAR; PG8_WAIT_L(0); PG8_MMA(0, 1, At, B1); PG8_BAR;
            PG8_LDA(At, 1, 1); PG8_STAGE(PG8_SA(1, 0), a3, voffA);
            PG8_BAR; PG8_WAIT_L(0); PG8_MMA(1, 0, At, B0); PG8_BAR; PG8_SCHED;
            PG8_STAGE(PG8_SB(1, 1), b3 + hstepB, voffB);
            PG8_WAIT_V(6); PG8_BAR; PG8_MMA(1, 1, At, B1); PG8_BAR;
            }
        }
        if constexpr (ALIGN_EPI) { if (wr == 0) PG8_BAR; }
        if constexpr (!Epi::AFTER_DRAIN) { E(acc, cur, wr, wc, fr, fq); S.done(cur); }
        if (!has_next) break;
#pragma unroll
        for (int a = 0; a < 2; ++a)
#pragma unroll
            for (int b = 0; b < 2; ++b)
#pragma unroll
                for (int m = 0; m < 4; ++m)
#pragma unroll
                    for (int n = 0; n < 2; ++n) acc[a][b][m][n] = (f32x4){0.f, 0.f, 0.f, 0.f};
        cur = nxt; cA = nA; cB = nB; ++ui;
        if constexpr (ALIGN_EPI) { if (wr == 1) PG8_BAR; }
    }
    PG8_WAIT_V(0);
    if constexpr (!ALIGN_EPI) { if (wr == 0) PG8_BAR; }
    PG8_BAR;
    if constexpr (Epi::AFTER_DRAIN) { E.fused(acc, cur, wr, wc, fr, fq, lds, wid, lane); S.done(cur); }
#undef PG8_SA
#undef PG8_SB
#undef PG8_STAGE
#undef PG8_LDA
#undef PG8_LDB
#undef PG8_MMA
#undef PG8_WAIT_V
#undef PG8_WAIT_L
#undef PG8_BAR
#undef PG8_SCHED
}
}


#define XB_TMO      128
#define XB_XCNT(j)  (256  + 64 * (j))
#define XB_XSUB(j)  (1280 + 64 * (j))
#define XB_XGEN(j)  (2304 + 64 * (j))
#define XB_TOP      3328
#define XB_TOPGEN   3392
#define XCD_BAR_WORDS 3456
#define XB_SPIN_CAP (1u << 18)

__device__ __forceinline__ unsigned xb_ld(unsigned* p)              { return __hip_atomic_load(p, __ATOMIC_RELAXED, __HIP_MEMORY_SCOPE_AGENT); }
__device__ __forceinline__ unsigned xb_add(unsigned* p, unsigned v) { return __hip_atomic_fetch_add(p, v, __ATOMIC_RELAXED, __HIP_MEMORY_SCOPE_AGENT); }
__device__ __forceinline__ unsigned xb_xcc_id() { return (unsigned)__builtin_amdgcn_s_getreg((3 << 11) | 20) & 0xFu; }
#define XB_SPIN(cond, bar) do { unsigned _sp = 0; while (cond) { __builtin_amdgcn_s_sleep(1); \
    if ((++_sp & 255u) == 0u) { if (xb_ld(&(bar)[XB_TMO])) break; if (_sp > XB_SPIN_CAP) { atomicAdd(&(bar)[XB_TMO], 1u); break; } } } } while (0)

struct XcdBarrier {
    unsigned* bar; unsigned x; unsigned G;
    volatile LAS unsigned* st;
};
__device__ __forceinline__ XcdBarrier xcd_barrier_post(unsigned* bar, volatile LAS unsigned* st, unsigned members) {
    XcdBarrier b; b.bar = bar; b.x = xb_xcc_id(); b.st = st; b.G = members;
    if (threadIdx.x == 0) (void)xb_add(&bar[XB_XCNT(b.x)], 1u);
    return b;
}
__device__ __forceinline__ void xcd_barrier_complete(unsigned* bar, unsigned x, unsigned G, unsigned& nloc, unsigned& nx) {
    unsigned sum, cnt, mine, sp = 0u;
    for (;;) {
        sum = 0u; cnt = 0u; mine = 0u;
#pragma unroll
        for (unsigned j = 0; j < 16; ++j) { const unsigned c = xb_ld(&bar[XB_XCNT(j)]); sum += c; cnt += (c > 0u) ? 1u : 0u; mine = (j == x) ? c : mine; }
        if (sum == G) break;
        __builtin_amdgcn_s_sleep(1);
        if ((++sp & 255u) == 0u) { if (xb_ld(&bar[XB_TMO])) break; if (sp > XB_SPIN_CAP) { atomicAdd(&bar[XB_TMO], 1u); break; } }
    }
    nloc = mine > 0u ? mine : 1u; nx = cnt > 0u ? cnt : 1u;
}
__device__ __forceinline__ void xcd_barrier(const XcdBarrier& b, int wave) {
    asm volatile("s_waitcnt vmcnt(0)" ::: "memory");
    __syncthreads();
    if (fresh_tid(wave) == 0) {
        unsigned* bar = b.bar; asm volatile("" : "+s"(bar));
        __builtin_amdgcn_s_waitcnt(0);
        unsigned nloc = b.st[0], nx = b.st[1];
        if (nloc == 0u) { xcd_barrier_complete(bar, b.x, b.G, nloc, nx); b.st[0] = nloc; b.st[1] = nx; }
        const unsigned old = xb_add(&bar[XB_XSUB(b.x)], 1u);
        const unsigned gen = old / nloc;
        if (old + 1u == (gen + 1u) * nloc) {
            __builtin_amdgcn_fence(__ATOMIC_RELEASE, "agent");
            asm volatile("s_waitcnt vmcnt(0)" ::: "memory");
            if (nx > 1u) {
            const unsigned og = xb_add(&bar[XB_TOP], 1u);
            const unsigned tg = og / nx;
            if (og + 1u == (tg + 1u) * nx) xb_add(&bar[XB_TOPGEN], 1u);
            else XB_SPIN(xb_ld(&bar[XB_TOPGEN]) == tg, bar);
            }
            xb_add(&bar[XB_XGEN(b.x)], 1u);
            __builtin_amdgcn_fence(__ATOMIC_ACQUIRE, "agent");
            asm volatile("s_waitcnt vmcnt(0)" ::: "memory");
        } else {
            XB_SPIN(xb_ld(&bar[XB_XGEN(b.x)]) == gen, bar);
            __builtin_amdgcn_fence(__ATOMIC_ACQUIRE, "agent");
            asm volatile("s_waitcnt vmcnt(0)" ::: "memory");
        }
    }
    __syncthreads();
}

struct Frame {
    LAS unsigned char* lds;
    volatile LAS unsigned* MISC;
    gu32* ctl;
    int tid, lane, wave;
    int vcu, G;
    unsigned char* ws;
    float* out;
};
struct Args { const float* in[20]; float* out; unsigned char* ws; int ph_lo, ph_hi; };
typedef const __attribute__((address_space(4))) Args* KArgs;
__device__ __forceinline__ KArgs kargs() { KArgs p = (KArgs)__builtin_amdgcn_kernarg_segment_ptr(); asm volatile("" : "+s"(p)); return p; }
enum { IN_X = 0, IN_RELB, IN_F1N, IN_F1GU, IN_F1DN, IN_MIXN, IN_WIN, IN_QN, IN_KVN, IN_CONVW, IN_CONVB, IN_IGB, IN_FGB, IN_MON, IN_WAO, IN_WMO, IN_WOUT, IN_F2N, IN_F2GU, IN_F2DN };

template <class SrcMap>
__device__ __forceinline__ void transpose_item(const float* W, int K, int Nsrc, bf16* WT, LAS unsigned* scr, int kb, int db, int lane, const SrcMap& src, const float* gk) {
    const int k0 = 64 * kb, d0 = 64 * db, nq = lane & 15, kq2 = lane >> 4; const int sc = src(d0 + 4 * nq);
    f32x4 v[16];
    const float* wp = W + (size_t)(k0 + 2 * kq2) * Nsrc + (sc >= 0 ? sc : 0);
#pragma unroll
    for (int i = 0; i < 8; ++i) { v[2 * i] = *(const GAS f32x4*)(wp + (size_t)(8 * i) * Nsrc); v[2 * i + 1] = *(const GAS f32x4*)(wp + (size_t)(8 * i + 1) * Nsrc); }
    if (sc < 0) {
#pragma unroll
        for (int i = 0; i < 16; ++i) v[i] = (f32x4){0.f, 0.f, 0.f, 0.f}; }
    if (gk) {
#pragma unroll
        for (int i = 0; i < 8; ++i) { const f32x2 g2 = *(const GAS f32x2*)(gk + k0 + 2 * kq2 + 8 * i); v[2 * i] = v[2 * i] * g2.x; v[2 * i + 1] = v[2 * i + 1] * g2.y; } }
#pragma unroll
    for (int i = 0; i < 8; ++i)
#pragma unroll
        for (int j = 0; j < 4; ++j) scr[(4 * nq + j) * 33 + 4 * i + kq2] = pk2(v[2 * i][j], v[2 * i + 1][j]);
    LDS_WAIT(); asm volatile("" ::: "memory");
    const int c = lane & 7;
#pragma unroll
    for (int r = 0; r < 8; ++r) { const int nn = 8 * r + (lane >> 3); const LAS unsigned* s = scr + nn * 33 + 4 * c;
        v4u o; o.x = s[0]; o.y = s[1]; o.z = s[2]; o.w = s[3];
        *(GAS v4u*)(WT + (size_t)(d0 + nn) * K + k0 + 8 * c) = o; }
    LDS_WAIT(); asm volatile("" ::: "memory");
}
struct SrcIdent { __device__ __forceinline__ int operator()(int d) const { return d; } };
struct SrcGU { __device__ __forceinline__ int operator()(int d) const { return gu_src_of_dest(d); } };
struct SrcWin { __device__ __forceinline__ int operator()(int d) const { return win_src_of_dest(d); } };

template <class SrcMap>
__device__ __forceinline__ void transpose_matrix(Frame& F, const float* W, int K, int Nsrc, int Ndst, bf16* WT, const SrcMap& src, const float* gk = nullptr) {
    const int lane_ = fresh_tid(F.wave) & 63;
    LAS unsigned* scr = (LAS unsigned*)(F.lds + RING_OFF + F.wave * 16384);
    const int gw = F.vcu * NWAVES + F.wave, NGW = F.G * NWAVES;
    const int nkb = K / 64, ndb = Ndst / 64, nit = nkb * ndb;
    for (int it = gw; it < nit; it += NGW) { const int kb = it / ndb, db = it % ndb; transpose_item(W, K, Nsrc, WT, scr, kb, db, lane_, src, gk); }
}
constexpr int CV_GU = (D / 64) * (FF2 / 64), CV_DN = (FF / 64) * (D / 64), CV_IN = (D / 64) * (DINP / 64), CV_AO = (D / 64) * (D / 64), CV_MO = (1024 / 64) * (D / 64), CV_WO = CV_AO;
constexpr int CV_ITEMS = 2 * CV_GU + 2 * CV_DN + CV_IN + CV_AO + CV_MO + CV_WO;
static_assert(CV_ITEMS % 8 == 0, "conversion items are dealt eight (one per wave) at a time");
__device__ __forceinline__ void convert_item(Frame& F, int l, int item, int lane) {
    LAS unsigned* scr = (LAS unsigned*)(F.lds + RING_OFF + F.wave * 16384);
    unsigned char* wl = F.ws + WS_W + (size_t)l * LAYER_W;
    int r = item;
    if (r < CV_GU) { constexpr int ndb = FF2 / 64; transpose_item(kargs()->in[IN_F1GU] + (size_t)l * D * FF2, D, FF2, (bf16*)(wl + OW_GU1), scr, r / ndb, r % ndb, lane, SrcGU(), kargs()->in[IN_F1N] + (size_t)l * D); return; } r -= CV_GU;
    if (r < CV_DN) { constexpr int ndb = D / 64; transpose_item(kargs()->in[IN_F1DN] + (size_t)l * FF * D, FF, D, (bf16*)(wl + OW_DN1), scr, r / ndb, r % ndb, lane, SrcIdent(), nullptr); return; } r -= CV_DN;
    if (r < CV_IN) { constexpr int ndb = DINP / 64; transpose_item(kargs()->in[IN_WIN] + (size_t)l * D * DIN, D, DIN, (bf16*)(wl + OW_IN), scr, r / ndb, r % ndb, lane, SrcWin(), kargs()->in[IN_MIXN] + (size_t)l * D); return; } r -= CV_IN;
    if (r < CV_AO) { constexpr int ndb = D / 64; transpose_item(kargs()->in[IN_WAO] + (size_t)l * D * D, D, D, (bf16*)(wl + OW_AO), scr, r / ndb, r % ndb, lane, SrcIdent(), nullptr); return; } r -= CV_AO;
    if (r < CV_MO) { constexpr int ndb = D / 64; transpose_item(kargs()->in[IN_WMO] + (size_t)l * 1024 * D, 1024, D, (bf16*)(wl + OW_MO), scr, r / ndb, r % ndb, lane, SrcIdent(), nullptr); return; } r -= CV_MO;
    if (r < CV_WO) { constexpr int ndb = D / 64; transpose_item(kargs()->in[IN_WOUT] + (size_t)l * D * D, D, D, (bf16*)(wl + OW_WO), scr, r / ndb, r % ndb, lane, SrcIdent(), nullptr); return; } r -= CV_WO;
    if (r < CV_GU) { constexpr int ndb = FF2 / 64; transpose_item(kargs()->in[IN_F2GU] + (size_t)l * D * FF2, D, FF2, (bf16*)(wl + OW_GU2), scr, r / ndb, r % ndb, lane, SrcGU(), kargs()->in[IN_F2N] + (size_t)l * D); return; } r -= CV_GU;
    { constexpr int ndb = D / 64; transpose_item(kargs()->in[IN_F2DN] + (size_t)l * FF * D, FF, D, (bf16*)(wl + OW_DN2), scr, r / ndb, r % ndb, lane, SrcIdent(), nullptr); }
}
struct CvItem { const float* wp; const float* gk; bf16* out; int Nsrc, K, sc; };
template <class SrcMap>
__device__ __forceinline__ CvItem cv_make(const float* W, int K, int Nsrc, bf16* WT, int kb, int db, int lane, const SrcMap& src, const float* gk) {
    const int k0 = 64 * kb, d0 = 64 * db, nq = lane & 15, kq2 = lane >> 4; const int sc = src(d0 + 4 * nq);
    CvItem it; it.wp = W + (size_t)(k0 + 2 * kq2) * Nsrc + (sc >= 0 ? sc : 0); it.gk = gk ? gk + k0 + 2 * kq2 : nullptr; it.out = WT + (size_t)d0 * K + k0; it.Nsrc = Nsrc; it.K = K; it.sc = sc; return it;
}
__device__ __forceinline__ CvItem cv_item(Frame& F, int l, int item, int lane) {
    unsigned char* wl = F.ws + WS_W + (size_t)l * LAYER_W;
    int r = item;
    if (r < CV_GU) { constexpr int ndb = FF2 / 64; return cv_make(kargs()->in[IN_F1GU] + (size_t)l * D * FF2, D, FF2, (bf16*)(wl + OW_GU1), r / ndb, r % ndb, lane, SrcGU(), kargs()->in[IN_F1N] + (size_t)l * D); } r -= CV_GU;
    if (r < CV_DN) { constexpr int ndb = D / 64; return cv_make(kargs()->in[IN_F1DN] + (size_t)l * FF * D, FF, D, (bf16*)(wl + OW_DN1), r / ndb, r % ndb, lane, SrcIdent(), nullptr); } r -= CV_DN;
    if (r < CV_IN) { constexpr int ndb = DINP / 64; return cv_make(kargs()->in[IN_WIN] + (size_t)l * D * DIN, D, DIN, (bf16*)(wl + OW_IN), r / ndb, r % ndb, lane, SrcWin(), kargs()->in[IN_MIXN] + (size_t)l * D); } r -= CV_IN;
    if (r < CV_AO) { constexpr int ndb = D / 64; return cv_make(kargs()->in[IN_WAO] + (size_t)l * D * D, D, D, (bf16*)(wl + OW_AO), r / ndb, r % ndb, lane, SrcIdent(), nullptr); } r -= CV_AO;
    if (r < CV_MO) { constexpr int ndb = D / 64; return cv_make(kargs()->in[IN_WMO] + (size_t)l * 1024 * D, 1024, D, (bf16*)(wl + OW_MO), r / ndb, r % ndb, lane, SrcIdent(), nullptr); } r -= CV_MO;
    if (r < CV_WO) { constexpr int ndb = D / 64; return cv_make(kargs()->in[IN_WOUT] + (size_t)l * D * D, D, D, (bf16*)(wl + OW_WO), r / ndb, r % ndb, lane, SrcIdent(), nullptr); } r -= CV_WO;
    if (r < CV_GU) { constexpr int ndb = FF2 / 64; return cv_make(kargs()->in[IN_F2GU] + (size_t)l * D * FF2, D, FF2, (bf16*)(wl + OW_GU2), r / ndb, r % ndb, lane, SrcGU(), kargs()->in[IN_F2N] + (size_t)l * D); } r -= CV_GU;
    { constexpr int ndb = D / 64; return cv_make(kargs()->in[IN_F2DN] + (size_t)l * FF * D, FF, D, (bf16*)(wl + OW_DN2), r / ndb, r % ndb, lane, SrcIdent(), nullptr); }
}
__device__ __forceinline__ void cv_load(const CvItem& it, f32x4 (&v)[16]) {
#pragma unroll
    for (int i = 0; i < 8; ++i) { v[2 * i] = *(const GAS f32x4*)(it.wp + (size_t)(8 * i) * it.Nsrc); v[2 * i + 1] = *(const GAS f32x4*)(it.wp + (size_t)(8 * i + 1) * it.Nsrc); }
}
__device__ __forceinline__ void cv_finish(const CvItem& it, f32x4 (&v)[16], LAS unsigned* scr, int lane) {
    const int nq = lane & 15, kq2 = lane >> 4;
    if (it.sc < 0) {
#pragma unroll
        for (int i = 0; i < 16; ++i) v[i] = (f32x4){0.f, 0.f, 0.f, 0.f}; }
    if (it.gk) {
#pragma unroll
        for (int i = 0; i < 8; ++i) { const f32x2 g2 = *(const GAS f32x2*)(it.gk + 8 * i); v[2 * i] = v[2 * i] * g2.x; v[2 * i + 1] = v[2 * i + 1] * g2.y; } }
#pragma unroll
    for (int i = 0; i < 8; ++i)
#pragma unroll
        for (int j = 0; j < 4; ++j) scr[(4 * nq + j) * 33 + 4 * i + kq2] = pk2(v[2 * i][j], v[2 * i + 1][j]);
    LDS_WAIT(); asm volatile("" ::: "memory");
    const int c = lane & 7;
#pragma unroll
    for (int r = 0; r < 8; ++r) { const int nn = 8 * r + (lane >> 3); const LAS unsigned* s = scr + nn * 33 + 4 * c;
        v4u o; o.x = s[0]; o.y = s[1]; o.z = s[2]; o.w = s[3];
        *(GAS v4u*)(it.out + (size_t)nn * it.K + 8 * c) = o; }
    LDS_WAIT(); asm volatile("" ::: "memory");
}
__device__ __forceinline__ void p_prologue(Frame& F) {
    const int lane_ = fresh_tid(F.wave) & 63;
    const int gw = F.vcu * NWAVES + F.wave, NGW = F.G * NWAVES;
    for (int it = gw; it < CV_ITEMS; it += NGW) convert_item(F, 0, it, lane_);
}

__device__ __forceinline__ void p_xprep(Frame& F_, const float* h, bf16* hb, float* ssq) {
    Frame F = F_; F.lane = fresh_tid(F.wave) & 63;
    const int gw = F.vcu * NWAVES + F.wave, NGW = F.G * NWAVES;
    for (int m = gw; m < M; m += NGW) {
        const GAS f32x4* xr = (const GAS f32x4*)(h + (size_t)m * D) + F.lane;
        f32x4 v[8]; float s = 0.f;
#pragma unroll
        for (int j = 0; j < 8; ++j) { v[j] = xr[64 * j]; s += (v[j].x * v[j].x + v[j].y * v[j].y) + (v[j].z * v[j].z + v[j].w * v[j].w); }
        s = wave_sum(s); if (F.lane < 32) ssq[(size_t)m * 32 + F.lane] = (F.lane == 0) ? s : 0.f;
        GAS v2u* o8 = (GAS v2u*)(hb + (size_t)m * D) + F.lane;
#pragma unroll
        for (int j = 0; j < 8; ++j) { v2u o; o.x = pk2(v[j].x, v[j].y); o.y = pk2(v[j].z, v[j].w); o8[64 * j] = o; }
    }
}

__device__ __forceinline__ void p_prep(Frame& F, int l) {
    const int lane = fresh_tid(F.wave) & 63;
    const int gw = F.vcu * NWAVES + F.wave, NGW = F.G * NWAVES;
    bf16* proj = (bf16*)(F.ws + WS_PROJ); bf16* mqk = (bf16*)(F.ws + WS_MQK);
    const float* qg = kargs()->in[IN_QN] + l * RK; const float* kg = kargs()->in[IN_KVN] + l * RK;
    const float* cw = kargs()->in[IN_CONVW] + (size_t)l * 4 * 1024; const float* cb = kargs()->in[IN_CONVB] + (size_t)l * 1024;
    const f32x4 qgv = *((const GAS f32x4*)qg + lane), kgv = *((const GAS f32x4*)kg + lane);
    float w[4][16], cbv[16];
#pragma unroll
    for (int k = 0; k < 4; ++k)
#pragma unroll
        for (int q = 0; q < 4; ++q) { const f32x4 t = *((const GAS f32x4*)(cw + k * 1024 + 16 * lane) + q); w[k][4 * q] = t.x; w[k][4 * q + 1] = t.y; w[k][4 * q + 2] = t.z; w[k][4 * q + 3] = t.w; }
#pragma unroll
    for (int q = 0; q < 4; ++q) { const f32x4 t = *((const GAS f32x4*)(cb + 16 * lane) + q); cbv[4 * q] = t.x; cbv[4 * q + 1] = t.y; cbv[4 * q + 2] = t.z; cbv[4 * q + 3] = t.w; }
    const float kscale = (lane >= 32) ? 0.08838834764831845f : 1.0f;
    for (int j8 = 0; j8 < 8; ++j8) { const int m = (gw >> 8) * SEQ + (gw & 255) + 256 * j8;
        bf16* row = proj + (size_t)m * DINP;
        const int t = m % SEQ;
        float acc[16];
#pragma unroll
        for (int i = 0; i < 16; ++i) acc[i] = cbv[i];
#pragma unroll
        for (int k = 0; k < 4; ++k) { const int tt = t - 3 + k;
            if (tt >= 0) { const GAS v4u* p = (const GAS v4u*)(proj + (size_t)(m - 3 + k) * DINP + P_MQK + 16 * lane); const v4u x0 = p[0], x1 = p[1];
                const unsigned xs[8] = {x0.x, x0.y, x0.z, x0.w, x1.x, x1.y, x1.z, x1.w};
#pragma unroll
                for (int i = 0; i < 8; ++i) { acc[2 * i] += w[k][2 * i] * bflo(xs[i]); acc[2 * i + 1] += w[k][2 * i + 1] * bfhi(xs[i]); } } }
        v4u o0, o1;
#pragma unroll
        for (int i = 0; i < 16; ++i) acc[i] = silu_f(acc[i]) * kscale;
        o0.x = pk2(acc[0], acc[1]); o0.y = pk2(acc[2], acc[3]); o0.z = pk2(acc[4], acc[5]); o0.w = pk2(acc[6], acc[7]);
        o1.x = pk2(acc[8], acc[9]); o1.y = pk2(acc[10], acc[11]); o1.z = pk2(acc[12], acc[13]); o1.w = pk2(acc[14], acc[15]);
        GAS v4u* po = (GAS v4u*)(mqk + (size_t)m * 1024 + 16 * lane); po[0] = o0; po[1] = o1;
    }
}

__device__ __forceinline__ void p_mpost(Frame& F, int l) {
    const int lane = fresh_tid(F.wave) & 63;
    const int gw = F.vcu * NWAVES + F.wave, NGW = F.G * NWAVES;
    const bf16* proj = (const bf16*)(F.ws + WS_PROJ); const bf16* hraw = (const bf16*)(F.ws + WS_HRAW); bf16* hm = (bf16*)(F.ws + WS_HM);
    const float* gn = kargs()->in[IN_MON] + (size_t)l * MH * DV;
    for (int j8 = 0; j8 < 8; ++j8) { const int m = (gw >> 8) * SEQ + (gw & 255) + 256 * j8;
#pragma unroll
        for (int hh = 0; hh < MH; ++hh) {
            const v2u x = *((const GAS v2u*)(hraw + (size_t)m * 1024 + hh * DV) + lane);
            const v2u og = *((const GAS v2u*)(proj + (size_t)m * DINP + P_MO + hh * DV) + lane);
            const f32x4 g = *((const GAS f32x4*)(gn + hh * DV) + lane);
            const float a = bflo(x.x), b = bfhi(x.x), c = bflo(x.y), d = bfhi(x.y);
            const float rstd = 1.0f / sqrtf(wave_sum(a * a + b * b + c * c + d * d) * (1.f / DV) + EPS);
            v2u o; o.x = pk2(a * rstd * g.x * sigm_f(bflo(og.x)), b * rstd * g.y * sigm_f(bfhi(og.x))); o.y = pk2(c * rstd * g.z * sigm_f(bflo(og.y)), d * rstd * g.w * sigm_f(bfhi(og.y)));
            *((GAS v2u*)(hm + (size_t)m * 1024 + hh * DV) + lane) = o;
        }
    }
}

#ifndef ATPROBE
#define ATPROBE 0
#endif
#ifndef ATDSEL
#define ATDSEL 7
#endif
#ifndef ATNT1
#define ATNT1 0
#endif
#ifndef ATNODMA
#define ATNODMA 0
#endif
#ifndef ATNOBAR
#define ATNOBAR 0
#endif
#ifndef ATP1
#define ATP1 1
#endif
#ifndef ATP1B
#define ATP1B 1
#endif
#ifndef ATP2
#define ATP2 1
#endif
constexpr int AT_SC = 0, AT_KV = 0, AT_KVBUF = 16384, AT_NBUF = 8;
constexpr int AT_MASK = 131072 + 512, AT_BIAS = AT_MASK + 4096, AT_THR = AT_BIAS + 4160;
static_assert(AT_THR + 256 <= LDS_BYTES, "attention LDS");
typedef short v4i16_t __attribute__((ext_vector_type(4)));
__device__ __forceinline__ bf16x8 lds_rd128(const LAS unsigned char* p) { return *(const LAS bf16x8*)p; }
__device__ __forceinline__ v4i16_t lds_tr64(const LAS unsigned char* p) { return __builtin_amdgcn_ds_read_tr16_b64_v4i16((LAS v4i16_t*)p); }
#define MFMA16(a, b, c) __builtin_amdgcn_mfma_f32_16x16x32_bf16((a), (b), (c), 0, 0, 0)

#define AT_CNT4(n_, c_, k0_, k1_, k2_, k3_) do { unsigned long long t0_, t1_, t2_, t3_; \
    asm volatile("v_cmp_le_u32_e64 %1, %5, %6\n\tv_cmp_le_u32_e64 %2, %5, %7\n\tv_cmp_le_u32_e64 %3, %5, %8\n\tv_cmp_le_u32_e64 %4, %5, %9\n\t" \
                 "v_addc_co_u32_e64 %0, %1, 0, %0, %1\n\tv_addc_co_u32_e64 %0, %2, 0, %0, %2\n\tv_addc_co_u32_e64 %0, %3, 0, %0, %3\n\tv_addc_co_u32_e64 %0, %4, 0, %0, %4" \
                 : "+v"(n_), "=&s"(t0_), "=&s"(t1_), "=&s"(t2_), "=&s"(t3_) : "s"(c_), "v"(k0_), "v"(k1_), "v"(k2_), "v"(k3_)); } while (0)
template <bool DUMMY> __device__ __forceinline__ void attn_unit(Frame& F, int b, int qb, int tid_in) {
    int tid = tid_in; asm volatile("" : "+v"(tid));
    int lane = tid & 63, w = __builtin_amdgcn_readfirstlane(tid >> 6), g = lane >> 4, n = lane & 15;
    bf16* proj = (bf16*)(F.ws + WS_PROJ);
    const int t0 = qb * 16; const size_t rowb = (size_t)b * SEQ;
    LAS unsigned char* L = F.lds;
    LAS unsigned* SC = (LAS unsigned*)(L + AT_SC); LAS unsigned* MASK = (LAS unsigned*)(L + AT_MASK); const LAS float* BIAS = (const LAS float*)(L + AT_BIAS);
    if (!DUMMY || (ATDSEL & 1)) {
        bf16x8 Aq[4][2][2];
#pragma unroll
        for (int p = 0; p < 4; ++p)
#pragma unroll
            for (int j = 0; j < 2; ++j)
#pragma unroll
                for (int ks = 0; ks < 2; ++ks) { const int q = 4 * p + (n >> 2), head = 4 * j + (n & 3);
                    Aq[p][j][ks] = *(const GAS bf16x8*)(proj + (rowb + t0 + q) * DINP + P_IQ + head * 64 + 32 * ks + 8 * g); }
        float wq[4][8];
#pragma unroll
        for (int p = 0; p < 4; ++p) { const v4u x = *(const GAS v4u*)(proj + (rowb + t0 + 4 * p + g) * DINP + P_IW); const unsigned xs[4] = {x.x, x.y, x.z, x.w};
#pragma unroll
          for (int i = 0; i < 4; ++i) { wq[p][2 * i] = bflo(xs[i]) * 0.044194173824159216f; wq[p][2 * i + 1] = bfhi(xs[i]) * 0.044194173824159216f; } }
        const bf16* kbase = proj + rowb * DINP + P_IK + 8 * g;
        bf16x8 Bc[4][2];
#define AT_LDB(dst, i0_) do { _Pragma("unroll") for (int k_ = 0; k_ < 4; ++k_) { int i_ = (i0_) + 8 * k_; i_ = i_ > qb ? qb : i_; \
            const GAS bf16x8* kp_ = (const GAS bf16x8*)(kbase + (size_t)(16 * i_ + n) * DINP); dst[k_][0] = kp_[0]; dst[k_][1] = kp_[4]; } } while (0)
        for (int i0 = w; i0 <= qb; i0 += 32) {
            AT_LDB(Bc, i0);
#pragma unroll
            for (int k = 0; k < 4; ++k) { const int i = i0 + 8 * k;
                if (i <= qb) {
                    const int key = 16 * i + n;
#pragma unroll
                    for (int p = 0; p < 4; ++p) {
                        f32x4 a0 = (f32x4){0.f, 0.f, 0.f, 0.f}, a1 = (f32x4){0.f, 0.f, 0.f, 0.f};
                        a0 = MFMA16(Aq[p][0][0], Bc[k][0], a0); a0 = MFMA16(Aq[p][0][1], Bc[k][1], a0);
                        a1 = MFMA16(Aq[p][1][0], Bc[k][0], a1); a1 = MFMA16(Aq[p][1][1], Bc[k][1], a1);
                        float sc = 0.f;
#pragma unroll
                        for (int e = 0; e < 4; ++e) { sc += wq[p][e] * fmaxf(a0[e], 0.f); sc += wq[p][4 + e] * fmaxf(a1[e], 0.f); }
                        SC[(4 * p + g) * 2048 + key] = (key <= t0 + 4 * p + g) ? sortable_key(sc + 0.0f) : 0u;
                    }
                } }
        }
#undef AT_LDB
    }
    LDS_WAIT(); __syncthreads();
    asm volatile("" : "+v"(tid)); lane = tid & 63; g = lane >> 4; n = lane & 15;
    bf16x8 Qf[8]; const bf16* lsrc; unsigned ldsw0;
    const int nt32 = (DUMMY && ATNT1) ? 1 : (qb >> 1) + 1;
#define AT_GLDS(gsrc_, dst_) do { unsigned keep_; asm volatile("s_mov_b32 %0, m0\n\ts_mov_b32 m0, %2\n\ts_nop 0\n\tglobal_load_lds_dwordx4 %1, off\n\ts_mov_b32 m0, %0" : "=&s"(keep_) : "v"(gsrc_), "s"(dst_) : "memory"); } while (0)
#define AT_LOAD(it_, buf_) do { const bf16* s_ = lsrc + (size_t)(it_) * 32 * DINP; const unsigned d_ = (unsigned)__builtin_amdgcn_readfirstlane(ldsw0 + (unsigned)(buf_) * AT_KVBUF); \
        AT_GLDS(s_, d_); AT_GLDS(s_ + 128, d_ + 8192u); } while (0)
#define AT_TILE(i_) ((i_) < nt32 ? (i_) : nt32 - 1)
#define AT_RING_START() do { { const bf16* qr_ = proj + (rowb + t0 + 2 * w + (n >> 3)) * DINP + P_AQ + (n & 7) * RK; _Pragma("unroll") for (int ks = 0; ks < 8; ++ks) Qf[ks] = *(const GAS bf16x8*)(qr_ + 32 * ks + 8 * g); } \
        const int lrow_ = 8 * (w >> 1) + ((lane >> 2) & 7), lch_ = 4 * (((w & 1) << 1) | (lane >> 5)) + ((lane & 3) ^ ((lrow_ >> 2) & 3)); \
        lsrc = proj + (rowb + lrow_) * DINP + P_CKV + lch_ * 8; ldsw0 = (unsigned)(size_t)(L + AT_KV) + (unsigned)w * 1024u; \
        _Pragma("unroll") for (int i = 0; i < 7; ++i) if (!(DUMMY && ATNODMA)) AT_LOAD(AT_TILE(i), i); } while (0)
    if (!DUMMY || (ATDSEL & 2)) {
        const bool all = (t0 + 16 <= TOPK);
        const unsigned long long lt_mask = (lane == 0) ? 0ull : (~0ull >> (64 - lane));
        const int jn = (t0 + 16 + 63) >> 6;
        const int qa = 2 * w, ta = t0 + qa, tb_ = ta + 1;
        unsigned ka[32], kb2[32];
#pragma unroll
        for (int j = 0; j < 32; ++j) { const int s = lane + 64 * j; ka[j] = (j < jn && s <= ta) ? SC[qa * 2048 + s] : 0u; kb2[j] = (j < jn && s <= tb_) ? SC[(qa + 1) * 2048 + s] : 0u; }
        LDS_WAIT(); __syncthreads();
        if (!DUMMY || (ATDSEL & 4)) AT_RING_START();
        unsigned Ta = 0u, Tb = 0u; bool exa = false, exb = false;
        if (!all) {
            for (int bit = 31; bit >= 0 && !(exa && exb); --bit) {
                const unsigned ca = Ta | (1u << bit), cb = Tb | (1u << bit); int na = 0, nb = 0;
#pragma unroll
                for (int c8 = 0; c8 < 4; ++c8) if (8 * c8 < jn) {
#pragma unroll
                    for (int j = 8 * c8; j < 8 * c8 + 8; j += 4) { AT_CNT4(na, ca, ka[j], ka[j + 1], ka[j + 2], ka[j + 3]); AT_CNT4(nb, cb, kb2[j], kb2[j + 1], kb2[j + 2], kb2[j + 3]); } }
                na = wave_sum_dpp(na); nb = wave_sum_dpp(nb);
                if (!exa) { if (na >= TOPK) Ta = ca; exa = (na == TOPK); }
                if (!exb) { if (nb >= TOPK) Tb = cb; exb = (nb == TOPK); }
            }
        }
#pragma unroll
        for (int qq = 0; qq < 2; ++qq) {
            const int q = qa + qq, t = t0 + q; const unsigned T = qq ? Tb : Ta; const bool ex = qq ? exb : exa;
            int need_eq = 0;
            if (!all && !ex) { int cg = 0;
#pragma unroll
                for (int j = 0; j < 32; ++j) cg += ((qq ? kb2[j] : ka[j]) > T) ? 1 : 0;
                need_eq = TOPK - wave_sum_dpp(cg); }
            int eq_seen = 0;
#pragma unroll
            for (int j = 0; j < 32; ++j) {
                const int s = lane + 64 * j; const unsigned kk = qq ? kb2[j] : ka[j]; bool sel;
                if (all) sel = (s <= t);
                else if (ex) sel = (kk >= T);
                else { const bool eq = (kk == T); const unsigned long long em = __ballot(eq); const int rank = eq_seen + __popcll(em & lt_mask); sel = (kk > T) || (eq && rank < need_eq); eq_seen += __popcll(em); }
                const unsigned long long sm = __ballot(sel);
                if (lane == 0) { MASK[q * 64 + 2 * j] = (unsigned)sm; MASK[q * 64 + 2 * j + 1] = (unsigned)(sm >> 32); }
            }
        }
    }
    LDS_WAIT(); __syncthreads();
    asm volatile("" : "+v"(tid)); lane = tid & 63; g = lane >> 4; n = lane & 15;
    if (!DUMMY || (ATDSEL & 4)) {
        const int q = 2 * w + (n >> 3), hh = n & 7, t = t0 + q;
        bf16* qrow = proj + (rowb + t) * DINP + P_AQ + hh * RK;
        if (DUMMY && !(ATDSEL & 2)) AT_RING_START();
        f32x4 O[16]; f32x4 OL = (f32x4){0.f, 0.f, 0.f, 0.f};
        const float b31 = BIAS[128 * 8 + hh];
        int rbase[2], tbase[2][2];
#pragma unroll
        for (int tt = 0; tt < 2; ++tt) { const int row = 8 * (n >> 2) + 4 * tt + (n & 3); rbase[tt] = 2048 * (row >> 3) + 64 * (row & 7) + 16 * (g ^ ((row >> 2) & 3)); }
#pragma unroll
        for (int tt = 0; tt < 2; ++tt)
#pragma unroll
            for (int od = 0; od < 2; ++od) { const int qq = n >> 2, p = n & 3; const int x = (((od ^ (g & 1)) << 1) | ((p >> 1) ^ tt));
                tbase[tt][od] = 2048 * g + 64 * (4 * tt + qq) + 16 * x + 8 * (p & 1); }
        {
#pragma unroll
        for (int mt = 0; mt < 16; ++mt) O[mt] = (f32x4){0.f, 0.f, 0.f, 0.f};
        asm volatile("s_waitcnt vmcnt(12)" ::: "memory"); __syncthreads();
        bf16x8 fa[2][8]; f32x4 sa[2], cin[2]; v4i16_t va[8][2], vb[8][2]; unsigned bitsw; bf16x8 Pf;
        const bf16x8 ONES = (bf16x8){0x3F80, 0x3F80, 0x3F80, 0x3F80, 0x3F80, 0x3F80, 0x3F80, 0x3F80};
        const unsigned b31u = __builtin_bit_cast(unsigned, b31);
#define AT_CINIT(i_) do { const unsigned bits_ = bitsw >> (8 * g); \
            if ((t0 - (32 * (i_) + 31)) >= 128) { \
                _Pragma("unroll") for (int j = 0; j < 8; ++j) { const unsigned m_ = (unsigned)__builtin_amdgcn_sbfe((int)bits_, j, 1); cin[j >> 2][j & 3] = __builtin_bit_cast(float, (m_ & b31u) | (~m_ & 0xF149F2CAu)); } \
            } else { const int kb = 32 * (i_) + 8 * g; \
                _Pragma("unroll") for (int j = 0; j < 8; ++j) { int dist = t - (kb + j); dist = dist < 0 ? 0 : (dist > 128 ? 128 : dist); const unsigned bv_ = __builtin_bit_cast(unsigned, BIAS[dist * 8 + hh]); \
                    const unsigned m_ = (unsigned)__builtin_amdgcn_sbfe((int)bits_, j, 1); cin[j >> 2][j & 3] = __builtin_bit_cast(float, (m_ & bv_) | (~m_ & 0xF149F2CAu)); } } } while (0)
#define AT_FA(tt_, b_) do { _Pragma("unroll") for (int ks = 0; ks < 8; ++ks) fa[tt_][ks] = lds_rd128((b_) + rbase[tt_] + (ks >> 2) * 8192 + 512 * (ks & 3)); } while (0)
#define AT_S(tt_) do { asm volatile("" : "+v"(fa[tt_][0]), "+v"(fa[tt_][1]), "+v"(fa[tt_][2]), "+v"(fa[tt_][3]), "+v"(fa[tt_][4]), "+v"(fa[tt_][5]), "+v"(fa[tt_][6]), "+v"(fa[tt_][7]));        \
            sa[tt_] = cin[tt_]; _Pragma("unroll") for (int ks = 0; ks < 8; ++ks) sa[tt_] = MFMA16(fa[tt_][ks], Qf[ks], sa[tt_]); } while (0)
#define AT_TR(b_) do { _Pragma("unroll") for (int mt = 0; mt < 8; ++mt) { const int off = 512 * (mt >> 1); va[mt][0] = lds_tr64((b_) + tbase[0][mt & 1] + off); va[mt][1] = lds_tr64((b_) + tbase[1][mt & 1] + off); } \
            _Pragma("unroll") for (int mt = 0; mt < 8; ++mt) { const int off = 8192 + 512 * (mt >> 1); vb[mt][0] = lds_tr64((b_) + tbase[0][mt & 1] + off); vb[mt][1] = lds_tr64((b_) + tbase[1][mt & 1] + off); } } while (0)
#define AT_SOFTMAX(i_) do { v4u pw; pw.x = pk2(__builtin_amdgcn_exp2f(sa[0][0]), __builtin_amdgcn_exp2f(sa[0][1])); pw.y = pk2(__builtin_amdgcn_exp2f(sa[0][2]), __builtin_amdgcn_exp2f(sa[0][3])); \
            pw.z = pk2(__builtin_amdgcn_exp2f(sa[1][0]), __builtin_amdgcn_exp2f(sa[1][1])); pw.w = pk2(__builtin_amdgcn_exp2f(sa[1][2]), __builtin_amdgcn_exp2f(sa[1][3])); Pf = __builtin_bit_cast(bf16x8, pw); } while (0)
#define AT_PV(vx_, o0_) do { _Pragma("unroll") for (int mt = 0; mt < 8; ++mt) { const bf16x8 a = (bf16x8){vx_[mt][0][0], vx_[mt][0][1], vx_[mt][0][2], vx_[mt][0][3], vx_[mt][1][0], vx_[mt][1][1], vx_[mt][1][2], vx_[mt][1][3]}; \
            O[(o0_) + mt] = MFMA16(a, Pf, O[(o0_) + mt]); } } while (0)
#define AT_SB() __builtin_amdgcn_sched_barrier(0)
#define AT_LOOP(ROT_) do { AT_FA(0, L + AT_KV); AT_FA(1, L + AT_KV); bitsw = MASK[q * 64]; AT_SB(); AT_CINIT(0); AT_S(0); AT_S(1); AT_SB(); AT_TR(L + AT_KV); AT_SB(); if (!(ROT_)) { AT_SOFTMAX(0); AT_SB(); } \
        for (int it = 0; it < nt32; ++it) { \
            const LAS unsigned char* nbuf = L + AT_KV + ((it + 1) & 7) * AT_KVBUF; \
              \
            if (DUMMY && ATNOBAR) asm volatile("s_waitcnt vmcnt(10)" ::: "memory"); else if (ROT_) asm volatile("s_waitcnt vmcnt(10)\n\ts_barrier" ::: "memory"); else asm volatile("s_waitcnt vmcnt(10) lgkmcnt(0)\n\ts_barrier" ::: "memory"); \
            if (ROT_) { AT_SOFTMAX(it); AT_SB(); } \
            { const unsigned mw_ = MASK[q * 64 + it + 1]; bitsw = (it + 1 < nt32) ? mw_ : 0u; }        \
            if (!(DUMMY && ATNODMA)) AT_LOAD(AT_TILE(it + 7), (it + 7) & 7); \
            AT_FA(0, nbuf); AT_SB(); AT_PV(va, 0); OL = MFMA16(ONES, Pf, OL); AT_SB(); AT_CINIT(it + 1); AT_SB(); AT_FA(1, nbuf); AT_SB(); AT_S(0); AT_SB(); AT_PV(vb, 8); AT_SB(); AT_S(1); AT_SB(); \
            AT_TR(nbuf); AT_SB(); \
            if (!(ROT_)) { AT_SOFTMAX(it + 1); AT_SB(); } \
        } } while (0)
        if (w < 4) { asm volatile("; order A" ::: "memory"); AT_LOOP(false); } else { asm volatile("; order B" ::: "memory"); AT_LOOP(true); }
#undef AT_LOOP
#undef AT_FA
#undef AT_S
#undef AT_TR
#undef AT_SOFTMAX
#undef AT_CINIT
#undef AT_PV
#undef AT_SB
        asm volatile("s_waitcnt vmcnt(0)" ::: "memory"); __syncthreads();
        }
#undef AT_LOAD
#undef AT_GLDS
#undef AT_TILE
        const float inv = 1.0f / OL[0];
#pragma unroll
        for (int k = 0; k < 8; ++k) {
            unsigned ax = pk2(O[2 * k][0] * inv, O[2 * k][1] * inv), ay = pk2(O[2 * k][2] * inv, O[2 * k][3] * inv);
            unsigned bx = pk2(O[2 * k + 1][0] * inv, O[2 * k + 1][1] * inv), by = pk2(O[2 * k + 1][2] * inv, O[2 * k + 1][3] * inv);
            { const auto r_ = __builtin_amdgcn_permlane16_swap(ax, bx, false, false); ax = r_[0]; bx = r_[1]; }
            { const auto r_ = __builtin_amdgcn_permlane16_swap(ay, by, false, false); ay = r_[0]; by = r_[1]; }
            const v4u o = {ax, ay, bx, by};
            const int d0 = (g & 1) ? 32 * k + 16 + 4 * (g - 1) : 32 * k + 4 * g;
            if (DUMMY) *(GAS v4u*)((bf16*)(F.ws + WS_HM) + (rowb + t) * D + hh * RK + d0) = o; else *(GAS v4u*)(qrow + d0) = o; }
    }
    __syncthreads();
}
template <bool DUMMY> __device__ __forceinline__ void p_attn(Frame& F_, const float* relb) {
    Frame F = F_; const int tid = fresh_tid(F.wave);
    LAS float* BIAS = (LAS float*)(F.lds + AT_BIAS);
    for (int i = tid; i < 129 * 8; i += NWAVES * 64) { const int nn = i >> 3, hh = i & 7; BIAS[i] = relb[t5_bucket_dev(nn) * AH + hh] * 1.4426950408889634f; }
    __syncthreads();
    for (int k = 0; k < 4; ++k) { const int pi = 2 * F.vcu + (k >> 1); if (pi >= BATCH * 64) break; const int b = pi >> 6, x = pi & 63; attn_unit<DUMMY>(F, b, (k & 1) ? (127 - x) : x, tid); }
}

constexpr int ML_Q = 0, ML_K = 16384, ML_V = 32768, ML_VW = 49152, ML_P = 65536, ML_PSTR = 144, ML_BC = ML_P + 64 * ML_PSTR, ML_AV = ML_BC + 8192, ML_PM = ML_AV + 8192,
              ML_MST = ML_PM + 8192, ML_NV = ML_MST + 256, ML_DINV = ML_NV + 512, ML_END = ML_DINV + 256;
static_assert(ML_END <= RING_BYTES, "mLSTM LDS");
__device__ __forceinline__ int img_off(int row, int ch) { const int r = row & 31; return 8192 * (row >> 5) + 2048 * (r >> 3) + 512 * (ch >> 2) + 64 * (r & 7) + 16 * ((ch & 3) ^ ((r >> 2) & 3)); }

__device__ __forceinline__ void mlstm_unit(Frame& F, const float* igb_, const float* fgb_, int l, int b, int hh, int half, int tid) {
    const int lane = tid & 63, w = __builtin_amdgcn_readfirstlane(tid >> 6), g = lane >> 4, n = lane & 15;
    const bf16* proj = (const bf16*)(F.ws + WS_PROJ); const bf16* mqk = (const bf16*)(F.ws + WS_MQK); bf16* hraw = (bf16*)(F.ws + WS_HRAW);
    LAS unsigned char* L = F.lds;
    LAS float* BC = (LAS float*)(L + ML_BC); LAS float* AV = (LAS float*)(L + ML_AV); LAS float* PM = (LAS float*)(L + ML_PM); LAS float* MST = (LAS float*)(L + ML_MST);
    LAS float* NV = (LAS float*)(L + ML_NV); LAS float* DINV = (LAS float*)(L + ML_DINV);
    const size_t rowb = (size_t)b * SEQ;
    {
        const float igb = igb_[l * MH + hh], fgb = fgb_[l * MH + hh];
        for (int cc = 0; cc < 4; ++cc) { const int tok = (4 * w + cc) * 64 + lane;
            const float ig = bf2f(proj[(rowb + tok) * DINP + P_MI + hh]) + igb;
            const float fp = bf2f(proj[(rowb + tok) * DINP + P_MF + hh]) + fgb;
            const float lf = fminf(fp, 0.f) - log1pf(__expf(-fabsf(fp)));
            float bc = lf;
#pragma unroll
            for (int o = 1; o < 64; o <<= 1) { const float v = __shfl_up(bc, o); if (lane >= o) bc += v; }
            const float a = ig - bc; float pm = a;
#pragma unroll
            for (int o = 1; o < 64; o <<= 1) { const float v = __shfl_up(pm, o); if (lane >= o) pm = fmaxf(pm, v); }
            BC[tok] = bc; AV[tok] = a; PM[tok] = pm; }
        if (tid < 128) NV[tid] = 0.f;
        for (int i = tid; i < 64 * ML_PSTR / 4; i += 512) ((LAS unsigned*)(L + ML_P))[i] = 0u;
    }
    LDS_WAIT(); __syncthreads();
    if (tid == 0) { float m = 0.f; MST[0] = 0.f; for (int c = 0; c < NCHUNK; ++c) { m = BC[64 * c + 63] + fmaxf(m, PM[64 * c + 63]); MST[c + 1] = m; } }
    int ld_off[2]; const bf16* ld_q[2]; const bf16* ld_v[2];
#pragma unroll
    for (int i = 0; i < 2; ++i) { const int idx = tid + 512 * i, r = idx >> 4, ch = idx & 15; ld_off[i] = img_off(r, ch);
        ld_q[i] = mqk + (rowb + r) * 1024 + hh * DK + ch * 8; ld_v[i] = proj + (rowb + r) * DINP + P_MV + hh * DV + half * 128 + ch * 8; }
    const int rr_base = img_off(n, g);
    int tb[2][2];
#pragma unroll
    for (int tt = 0; tt < 2; ++tt)
#pragma unroll
        for (int od = 0; od < 2; ++od) { const int qq = n >> 2, p = n & 3; const int x = (((od ^ (g & 1)) << 1) | ((p >> 1) ^ tt)); tb[tt][od] = 2048 * g + 64 * (4 * tt + qq) + 16 * x + 8 * (p & 1); }
#define ML_TR(img, ks, c, tt) lds_tr64(L + (img) + 8192 * (ks) + 512 * ((c) >> 1) + tb[tt][(c) & 1])
    f32x4 Cacc[8];
#pragma unroll
    for (int mt = 0; mt < 8; ++mt) Cacc[mt] = (f32x4){0.f, 0.f, 0.f, 0.f};
    v4u rq[2], rk[2], rv[2];
#pragma unroll
    for (int i = 0; i < 2; ++i) { rq[i] = *(const GAS v4u*)(ld_q[i]); rk[i] = *(const GAS v4u*)(ld_q[i] + 512); rv[i] = *(const GAS v4u*)(ld_v[i]); }
    __syncthreads();
    for (int c = 0; c < NCHUNK; ++c) {
        const float mst = MST[c], mnew = MST[c + 1], blast = BC[64 * c + 63];
#pragma unroll
        for (int i = 0; i < 2; ++i) { const int idx = tid + 512 * i, r = idx >> 4;
            *(LAS v4u*)(L + ML_Q + ld_off[i]) = rq[i]; *(LAS v4u*)(L + ML_K + ld_off[i]) = rk[i]; *(LAS v4u*)(L + ML_V + ld_off[i]) = rv[i];
            const float wk = __expf(blast + AV[64 * c + r] - mnew);
            v4u vw; vw.x = pk2(bflo(rv[i].x) * wk, bfhi(rv[i].x) * wk); vw.y = pk2(bflo(rv[i].y) * wk, bfhi(rv[i].y) * wk); vw.z = pk2(bflo(rv[i].z) * wk, bfhi(rv[i].z) * wk); vw.w = pk2(bflo(rv[i].w) * wk, bfhi(rv[i].w) * wk);
            *(LAS v4u*)(L + ML_VW + ld_off[i]) = vw; }
        LDS_WAIT(); __syncthreads();
        if (c + 1 < NCHUNK) {
#pragma unroll
            for (int i = 0; i < 2; ++i) { const size_t adv = (size_t)(c + 1) * 64; rq[i] = *(const GAS v4u*)(ld_q[i] + adv * 1024); rk[i] = *(const GAS v4u*)(ld_q[i] + adv * 1024 + 512); rv[i] = *(const GAS v4u*)(ld_v[i] + adv * DINP); } }
        for (int ti = w; ti < 10; ti += 8) {
            const int kt = (int)((0x3221110000ull >> (4 * ti)) & 15ull), nt = (int)((0x3323213210ull >> (4 * ti)) & 15ull);
            bf16x8 fa[4], fb[4];
#pragma unroll
            for (int ks = 0; ks < 4; ++ks) { fa[ks] = lds_rd128(L + ML_K + img_off(16 * kt + n, 4 * ks + g)); fb[ks] = lds_rd128(L + ML_Q + img_off(16 * nt + n, 4 * ks + g)); }
            const int j = 16 * nt + n; const float pmj = PM[64 * c + j];
            const f32x4 av = *(const LAS f32x4*)(AV + 64 * c + 16 * kt + 4 * g);
            __builtin_amdgcn_sched_barrier(0);
            f32x4 s = (f32x4){0.f, 0.f, 0.f, 0.f};
#pragma unroll
            for (int ks = 0; ks < 4; ++ks) s = MFMA16(fa[ks], fb[ks], s);
            const float mx = fmaxf(mst, pmj);
            float pv[4];
#pragma unroll
            for (int e = 0; e < 4; ++e) { const int sk = 16 * kt + 4 * g + e; pv[e] = (sk <= j) ? s[e] * __expf(av[e] - mx) : 0.f; }
            v2u pw; pw.x = pk2(pv[0], pv[1]); pw.y = pk2(pv[2], pv[3]);
            *(LAS v2u*)(L + ML_P + j * ML_PSTR + (16 * kt + 4 * g) * 2) = pw;
        }
        f32x4 dacc = (f32x4){0.f, 0.f, 0.f, 0.f};
        if (w < 4) {
            f32x4 n0[4], n1[4]; bf16x8 bqd[4];
#pragma unroll
            for (int ks = 0; ks < 4; ++ks) { n0[ks] = *(const LAS f32x4*)(NV + 32 * ks + 8 * g); n1[ks] = *(const LAS f32x4*)(NV + 32 * ks + 8 * g + 4); bqd[ks] = lds_rd128(L + ML_Q + img_off(16 * w + n, 4 * ks + g)); }
            __builtin_amdgcn_sched_barrier(0);
#pragma unroll
            for (int ks = 0; ks < 4; ++ks) {
                v4u aw; aw.x = pk2(n0[ks][0], n0[ks][1]); aw.y = pk2(n0[ks][2], n0[ks][3]); aw.z = pk2(n1[ks][0], n1[ks][1]); aw.w = pk2(n1[ks][2], n1[ks][3]);
                if (n != 0) { aw.x = 0u; aw.y = 0u; aw.z = 0u; aw.w = 0u; }
                dacc = MFMA16(__builtin_bit_cast(bf16x8, aw), bqd[ks], dacc); }
        }
        LDS_WAIT(); __syncthreads();
        const float mxw = fmaxf(mst, PM[64 * c + 16 * (w & 3) + n]);
        bf16x8 bpd[2];
        if (w < 4) {
#pragma unroll
            for (int ks = 0; ks < 2; ++ks) bpd[ks] = lds_rd128(L + ML_P + (16 * w + n) * ML_PSTR + (32 * ks + 8 * g) * 2);
        }
        f32x4 avn[2][2]; v4i16_t klo[2], khi[2];
#pragma unroll
        for (int ks = 0; ks < 2; ++ks) { avn[ks][0] = *(const LAS f32x4*)(AV + 64 * c + 32 * ks + 8 * g); avn[ks][1] = *(const LAS f32x4*)(AV + 64 * c + 32 * ks + 8 * g + 4); klo[ks] = ML_TR(ML_K, ks, w, 0); khi[ks] = ML_TR(ML_K, ks, w, 1); }
        v2u qb0[4][4], qb1[4][4]; float pmn[4];
#pragma unroll
        for (int nt = 0; nt < 4; ++nt) { const int row = 16 * nt + n; pmn[nt] = PM[64 * c + row];
#pragma unroll
            for (int s4 = 0; s4 < 4; ++s4) { qb0[nt][s4] = *(const LAS v2u*)(L + ML_Q + img_off(row, 4 * s4 + (g >> 1)) + 8 * (g & 1)); qb1[nt][s4] = *(const LAS v2u*)(L + ML_Q + img_off(row, 4 * s4 + 2 + (g >> 1)) + 8 * (g & 1)); } }
        const float nvold = (g == 0) ? NV[16 * w + n] : 0.f;
        __builtin_amdgcn_sched_barrier(0);
        if (w < 4) {
            const float wint = __expf(mst - mxw);
            dacc = dacc * wint;
            v4u ow; ow.x = (n == 0) ? 0x3f803f80u : 0u; ow.y = ow.x; ow.z = ow.x; ow.w = ow.x;
#pragma unroll
            for (int ks = 0; ks < 2; ++ks) dacc = MFMA16(__builtin_bit_cast(bf16x8, ow), bpd[ks], dacc);
            if (g == 0) { const float den = dacc[0]; const float mrow = BC[64 * c + 16 * w + n] + mxw; DINV[16 * w + n] = 1.0f / fmaxf(fabsf(den), __expf(-mrow)); }
        }
        {
            f32x4 nacc = (f32x4){0.f, 0.f, 0.f, 0.f};
#pragma unroll
            for (int ks = 0; ks < 2; ++ks) {
                float wkv[8];
#pragma unroll
                for (int jj = 0; jj < 8; ++jj) wkv[jj] = __expf(blast + avn[ks][jj >> 2][jj & 3] - mnew);
                v4u aw; aw.x = pk2(wkv[0], wkv[1]); aw.y = pk2(wkv[2], wkv[3]); aw.z = pk2(wkv[4], wkv[5]); aw.w = pk2(wkv[6], wkv[7]);
                if (n != 0) { aw.x = 0u; aw.y = 0u; aw.z = 0u; aw.w = 0u; }
                const bf16x8 bk = (bf16x8){klo[ks][0], klo[ks][1], klo[ks][2], klo[ks][3], khi[ks][0], khi[ks][1], khi[ks][2], khi[ks][3]};
                nacc = MFMA16(__builtin_bit_cast(bf16x8, aw), bk, nacc); }
            if (g == 0) { const float decay = __expf(blast + mst - mnew); NV[16 * w + n] = decay * nvold + nacc[0]; }
        }
        f32x4 Hacc[4];
        {
            v4u awc[4];
#pragma unroll
            for (int s4 = 0; s4 < 4; ++s4) { awc[s4].x = pk2(Cacc[2 * s4][0], Cacc[2 * s4][1]); awc[s4].y = pk2(Cacc[2 * s4][2], Cacc[2 * s4][3]); awc[s4].z = pk2(Cacc[2 * s4 + 1][0], Cacc[2 * s4 + 1][1]); awc[s4].w = pk2(Cacc[2 * s4 + 1][2], Cacc[2 * s4 + 1][3]); }
#pragma unroll
            for (int nt = 0; nt < 4; ++nt) {
                f32x4 h = (f32x4){0.f, 0.f, 0.f, 0.f};
#pragma unroll
                for (int s4 = 0; s4 < 4; ++s4) { v4u bw; bw.x = qb0[nt][s4].x; bw.y = qb0[nt][s4].y; bw.z = qb1[nt][s4].x; bw.w = qb1[nt][s4].y;
                    h = MFMA16(__builtin_bit_cast(bf16x8, awc[s4]), __builtin_bit_cast(bf16x8, bw), h); }
                const float wint = __expf(mst - fmaxf(mst, pmn[nt]));
                Hacc[nt] = h * wint;
            }
        }
        __builtin_amdgcn_sched_barrier(0);
        v4i16_t vlo2[2], vhi2[2], wlo2[2], whi2[2]; bf16x8 bpp[2][4]; v4i16_t alo[2][8], ahi[2][8];
#pragma unroll
        for (int ks = 0; ks < 2; ++ks) { vlo2[ks] = ML_TR(ML_V, ks, w, 0); vhi2[ks] = ML_TR(ML_V, ks, w, 1);
#pragma unroll
            for (int nt = 0; nt < 4; ++nt) bpp[ks][nt] = lds_rd128(L + ML_P + (16 * nt + n) * ML_PSTR + (32 * ks + 8 * g) * 2); }
#define ML_STATE_READS(ks_) do { wlo2[ks_] = ML_TR(ML_VW, ks_, w, 0); whi2[ks_] = ML_TR(ML_VW, ks_, w, 1); \
            _Pragma("unroll") for (int mt = 0; mt < 8; ++mt) { alo[ks_][mt] = ML_TR(ML_K, ks_, mt, 0); ahi[ks_][mt] = ML_TR(ML_K, ks_, mt, 1); } } while (0)
#define ML_STATE_MMA(ks_) do { const bf16x8 bv = (bf16x8){wlo2[ks_][0], wlo2[ks_][1], wlo2[ks_][2], wlo2[ks_][3], whi2[ks_][0], whi2[ks_][1], whi2[ks_][2], whi2[ks_][3]}; \
            _Pragma("unroll") for (int mt = 0; mt < 8; ++mt) { const bf16x8 ak = (bf16x8){alo[ks_][mt][0], alo[ks_][mt][1], alo[ks_][mt][2], alo[ks_][mt][3], ahi[ks_][mt][0], ahi[ks_][mt][1], ahi[ks_][mt][2], ahi[ks_][mt][3]}; \
                Cacc[mt] = MFMA16(ak, bv, Cacc[mt]); } } while (0)
        ML_STATE_READS(0);
        __builtin_amdgcn_sched_barrier(0);
#pragma unroll
        for (int ks = 0; ks < 2; ++ks) {
            const bf16x8 av = (bf16x8){vlo2[ks][0], vlo2[ks][1], vlo2[ks][2], vlo2[ks][3], vhi2[ks][0], vhi2[ks][1], vhi2[ks][2], vhi2[ks][3]};
#pragma unroll
            for (int nt = 0; nt < 4; ++nt) Hacc[nt] = MFMA16(av, bpp[ks][nt], Hacc[nt]);
        }
        __builtin_amdgcn_sched_barrier(0);
        ML_STATE_READS(1);
        __builtin_amdgcn_sched_barrier(0);
        {
            const float decay = __expf(blast + mst - mnew);
#pragma unroll
            for (int mt = 0; mt < 8; ++mt) Cacc[mt] = Cacc[mt] * decay;
            ML_STATE_MMA(0); ML_STATE_MMA(1);
        }
#undef ML_STATE_READS
#undef ML_STATE_MMA
        LDS_WAIT(); __syncthreads();
#pragma unroll
        for (int nt = 0; nt < 4; ++nt) { const int j = 16 * nt + n; const float di = DINV[j];
            v2u o; o.x = pk2(Hacc[nt][0] * di, Hacc[nt][1] * di); o.y = pk2(Hacc[nt][2] * di, Hacc[nt][3] * di);
            *(GAS v2u*)(hraw + (rowb + 64 * c + j) * 1024 + hh * DV + half * 128 + 16 * w + 4 * g) = o; }
    }
#undef ML_TR
    __syncthreads();
}
#ifndef CVPROBE
#define CVPROBE 0
#endif
#if CVPROBE
#define CVPROBE_DUP(k_) convert_item(F, l + 1, ((int)ct_ * 4 + (k_)) * 8 + F.wave, fresh_tid(F.wave) & 63);
#else
#define CVPROBE_DUP(k_)
#endif
#ifndef MIX_NCONV
#define MIX_NCONV 96
#endif
constexpr int MIX_CONV0 = 64;
static_assert(CV_ITEMS % 32 == 0, "conversion tickets are four workgroup items");
__device__ __forceinline__ void p_mix(Frame& F_, const float* relb, const float* igb_, const float* fgb_, int l) {
    Frame F = F_; const int tid = fresh_tid(F.wave);
    LAS float* BIAS = (LAS float*)(F.lds + AT_BIAS);
    for (int i = tid; i < 129 * 8; i += NWAVES * 64) { const int nn = i >> 3, hh = i & 7; BIAS[i] = relb[t5_bucket_dev(nn) * AH + hh] * 1.4426950408889634f; }
    __syncthreads();
    int bid_ = (int)blockIdx.x; asm volatile("" : "+s"(bid_));
    const int grp_ = bid_ & 7, rank_ = bid_ >> 3;
    if (rank_ < MH * 2) mlstm_unit(F, igb_, fgb_, l, grp_, rank_ >> 1, rank_ & 1, tid);
    const int tid2 = fresh_tid(F.wave);
    unsigned* ctr = (unsigned*)(F.ctl + CW_ATK + 64 * (8 * l + grp_));
    unsigned* ctrc = (unsigned*)(F.ctl + CW_CVT + 64 * l);
    volatile LAS unsigned* tk = F.MISC + 20;
    const bool has_conv = (l + 1 < DEPTH);
    const bool conv_first = has_conv && bid_ >= MIX_CONV0 && bid_ < MIX_CONV0 + MIX_NCONV;
#define MIX_CONVERT() do { for (;;) { if (tid2 == 0) tk[0] = __hip_atomic_fetch_add(ctrc, 1u, __ATOMIC_RELAXED, __HIP_MEMORY_SCOPE_AGENT); __syncthreads(); const unsigned ct_ = tk[0]; __syncthreads(); \
        if (ct_ >= (unsigned)(CV_ITEMS / 32)) break; \
        { const int ln_ = fresh_tid(F.wave) & 63; LAS unsigned* scr_ = (LAS unsigned*)(F.lds + RING_OFF + F.wave * 16384); f32x4 va_[16], vb_[16]; \
          CvItem ia_ = cv_item(F, l + 1, ((int)ct_ * 4 + 0) * 8 + F.wave, ln_); cv_load(ia_, va_); \
          CvItem ib_ = cv_item(F, l + 1, ((int)ct_ * 4 + 1) * 8 + F.wave, ln_); cv_load(ib_, vb_); cv_finish(ia_, va_, scr_, ln_); \
          ia_ = cv_item(F, l + 1, ((int)ct_ * 4 + 2) * 8 + F.wave, ln_); cv_load(ia_, va_); cv_finish(ib_, vb_, scr_, ln_); \
          ib_ = cv_item(F, l + 1, ((int)ct_ * 4 + 3) * 8 + F.wave, ln_); cv_load(ib_, vb_); cv_finish(ia_, va_, scr_, ln_); cv_finish(ib_, vb_, scr_, ln_); } } } while (0)
    if (conv_first) MIX_CONVERT();
    unsigned mine = 0u;
    if (tid2 == 0) mine = __hip_atomic_fetch_add(ctr, 1u, __ATOMIC_RELAXED, __HIP_MEMORY_SCOPE_AGENT);
    for (;;) {
        if (tid2 == 0) tk[0] = mine;
        __syncthreads();
        const unsigned ticket = tk[0];
        __syncthreads();
        if (ticket >= 128u) break;
        if (tid2 == 0) mine = __hip_atomic_fetch_add(ctr, 1u, __ATOMIC_RELAXED, __HIP_MEMORY_SCOPE_AGENT);
        attn_unit<false>(F, grp_, 127 - (int)ticket, tid2);
#if ATPROBE
        attn_unit<true>(F, grp_, 127 - (int)ticket, tid2);
#endif
    }
    if (has_conv && !conv_first) MIX_CONVERT();
#undef MIX_CONVERT
}

__device__ __forceinline__ void gu_tail_convert(Frame& F_, int tl, int ntk) {
    Frame F = F_; const int tid2 = fresh_tid(F.wave); const int l = tl - 1;
    unsigned* ctrc = (unsigned*)(F.ctl + CW_CVT + 64 * l);
    volatile LAS unsigned* tk = F.MISC + 20;
    for (int i = 0; i < ntk; ++i) {
        if (tid2 == 0) tk[0] = __hip_atomic_fetch_add(ctrc, 1u, __ATOMIC_RELAXED, __HIP_MEMORY_SCOPE_AGENT); __syncthreads(); const unsigned ct_ = tk[0]; __syncthreads();
        if (ct_ >= (unsigned)(CV_ITEMS / 32)) break;
        { const int ln_ = fresh_tid(F.wave) & 63; LAS unsigned* scr_ = (LAS unsigned*)(F.lds + RING_OFF + F.wave * 16384); f32x4 va_[16], vb_[16];
          CvItem ia_ = cv_item(F, l + 1, ((int)ct_ * 4 + 0) * 8 + F.wave, ln_); cv_load(ia_, va_);
          CvItem ib_ = cv_item(F, l + 1, ((int)ct_ * 4 + 1) * 8 + F.wave, ln_); cv_load(ib_, vb_); cv_finish(ia_, va_, scr_, ln_);
          ia_ = cv_item(F, l + 1, ((int)ct_ * 4 + 2) * 8 + F.wave, ln_); cv_load(ia_, va_); cv_finish(ib_, vb_, scr_, ln_);
          ib_ = cv_item(F, l + 1, ((int)ct_ * 4 + 3) * 8 + F.wave, ln_); cv_load(ib_, vb_); cv_finish(ia_, va_, scr_, ln_); cv_finish(ib_, vb_, scr_, ln_); }
    }
    __syncthreads();
}

constexpr int GU_TAIL_C0 = (M / 256) * (FF2 / 256) % 256;
#ifndef GU_TAIL_NTK
#define GU_TAIL_NTK 3
#endif
constexpr int PH_PER_LAYER = 12, N_PHASES = 1 + DEPTH * PH_PER_LAYER;
__global__ void __launch_bounds__(NWAVES * 64, 2) trunk_fwd(const Args A) {
    extern __shared__ __attribute__((aligned(16))) unsigned char lds[];
    Frame F;
    F.lds = (LAS unsigned char*)lds;
    F.MISC = (volatile LAS unsigned*)(F.lds + MISC_OFF);
    F.tid = threadIdx.x; F.lane = F.tid & 63; F.wave = __builtin_amdgcn_readfirstlane(F.tid >> 6);
    F.G = gridDim.x; { const int bx = blockIdx.x; F.vcu = (F.G % 8 == 0) ? (bx % 8) * (F.G / 8) + bx / 8 : bx; }
    F.ws = kargs()->ws; F.ctl = (gu32*)(kargs()->ws + WS_CTL); F.out = kargs()->out;
    for (int u = F.tid; u < (LDS_BYTES - LDSCTL_OFF) / 4; u += NWAVES * 64) ((LAS unsigned*)(F.lds + LDSCTL_OFF))[u] = 0u;
    __syncthreads();
    const int lo = kargs()->ph_lo, hi = kargs()->ph_hi;
    const bool multi = (hi - lo) > 1;
    XcdBarrier bar; bar.bar = (unsigned*)(F.ctl + CW_BAR); bar.x = 0; bar.st = nullptr;
    if (multi) bar = xcd_barrier_post((unsigned*)(F.ctl + CW_BAR), F.MISC + 8, (unsigned)gridDim.x);
    const int grp = (int)blockIdx.x & 7;
    XcdBarrier gbar; gbar.bar = (unsigned*)(F.ctl + CW_GBAR + 4096 * grp); gbar.x = 0; gbar.st = nullptr; gbar.G = GROUP_WG;
    if (multi) gbar = xcd_barrier_post((unsigned*)(F.ctl + CW_GBAR + 4096 * grp), F.MISC + 12, GROUP_WG);
#define IN(k) (lo <= (k) && (k) < hi)
    auto lbid = []() { int b_ = (int)blockIdx.x; asm volatile("" : "+s"(b_)); return b_; };
    const LAS float* RTAB = (const LAS float*)(F.lds + AT_MASK);
#define RSTD_TABLE(S_, pm0_) do { const int c_ = lbid(); pm0_ = 8 * (c_ & 7) + ((c_ >> 3) & 7);        \
        const int t_ = fresh_tid(F.wave); if (t_ < 256) { const float* p_ = SSQ + (size_t)(pm0_ * 256 + t_) * 32; float s_ = 0.f; \
        _Pragma("unroll") for (int i_ = 0; i_ < 8; ++i_) { const f32x4 a_ = *(const GAS f32x4*)(p_ + 4 * i_); s_ += (a_.x + a_.y) + (a_.z + a_.w); } \
        ((LAS float*)(F.lds + AT_MASK))[t_] = 1.0f / sqrtf(s_ * (1.0f / 2048.0f) + 1e-6f); } __syncthreads(); } while (0)
#define SEAM(k) do { if (IN(k) && IN((k) + 1)) xcd_barrier(gbar, F.wave); } while (0)
    if (IN(0)) { p_prologue(F); p_xprep(F, kargs()->in[IN_X], (bf16*)(F.ws + WS_XN), (float*)(F.ws + WS_PART)); if (IN(1)) xcd_barrier(bar, F.wave); }
#pragma unroll 1
    for (int l = 0; l < DEPTH; ++l) {
        const int pb = 1 + l * PH_PER_LAYER;
        { unsigned char* ws_ = kargs()->ws; float* out_ = kargs()->out; unsigned ldsb_ = 0u; asm volatile("" : "+s"(ws_), "+s"(out_), "+s"(ldsb_));
          F.ws = ws_; F.out = out_; F.ctl = (gu32*)(ws_ + WS_CTL); F.lds = (LAS unsigned char*)lds + ldsb_;
          }
        bf16* XN = (bf16*)(F.ws + WS_XN); bf16* PROJ = (bf16*)(F.ws + WS_PROJ); bf16* HMB = (bf16*)(F.ws + WS_HM); bf16* YB = (bf16*)(F.ws + WS_Y);
        float* SSQ = (float*)(F.ws + WS_PART);
        unsigned char* wl = F.ws + WS_W + (size_t)l * LAYER_W;
        if (l > 0 && multi) { if (fresh_tid(F.wave) == 0) { unsigned* cvd = (unsigned*)(F.ctl + CW_CVD + 64 * (l - 1)); unsigned sp_ = 0u;
                while (__hip_atomic_load(cvd, __ATOMIC_RELAXED, __HIP_MEMORY_SCOPE_AGENT) < (unsigned)NGROUP) { __builtin_amdgcn_s_sleep(2); if (++sp_ > (1u << 24)) break; }
                __builtin_amdgcn_fence(__ATOMIC_ACQUIRE, "agent"); }
            __syncthreads(); }
        if (IN(pb + 0)) { pg8::Gemm g{XN, (const bf16*)(wl + OW_GU1), M, FF2, D, D, F.wave}; pg8::StaticOrder S; S.init(M, FF2, F.G, lbid());
            int pm0; RSTD_TABLE(S, pm0); pg8::EpiSwiGLU E{PROJ, DINP, SSQ, RTAB, pm0}; pg8::gemm_phase<pg8::EpiSwiGLU, pg8::StaticOrder, true, true>(F.lds + RING_OFF, g, S, E);
            if (lbid() >= GU_TAIL_C0 && l + 1 < DEPTH) gu_tail_convert(F, l + 1, GU_TAIL_NTK); SEAM(pb + 0); }
        if (IN(pb + 1)) { pg8::Gemm g{PROJ, (const bf16*)(wl + OW_DN1), M, D, FF, DINP, F.wave}; pg8::StaticOrder S; S.init(M, D, F.G, lbid());
            pg8::EpiResid<false, 1> E{XN, D, SSQ, nullptr}; pg8::gemm_phase<pg8::EpiResid<false, 1>, pg8::StaticOrder, true, true>(F.lds + RING_OFF, g, S, E); SEAM(pb + 1); }
        if (IN(pb + 2)) { pg8::Gemm g{XN, (const bf16*)(wl + OW_IN), M, DINP, D, D, F.wave}; pg8::StaticOrder S; S.init(M, DINP, F.G, lbid());
            int pm0; RSTD_TABLE(S, pm0); pg8::EpiProj E{PROJ, DINP, RTAB, (LAS float*)(F.lds + AT_MASK + 1024), kargs()->in[IN_QN] + l * RK, kargs()->in[IN_KVN] + l * RK}; pg8::gemm_phase<pg8::EpiProj, pg8::StaticOrder, true, true>(F.lds + RING_OFF, g, S, E); SEAM(pb + 2); }
        if (IN(pb + 3)) { p_prep(F, l); SEAM(pb + 3); }
        if (IN(pb + 4)) { p_mix(F, kargs()->in[IN_RELB], kargs()->in[IN_IGB], kargs()->in[IN_FGB], l); if (IN(pb + 6)) xcd_barrier(gbar, F.wave);
            if (l + 1 < DEPTH && ((int)blockIdx.x >> 3) == 0 && fresh_tid(F.wave) == 0) __hip_atomic_fetch_add((unsigned*)(F.ctl + CW_CVD + 64 * l), 1u, __ATOMIC_RELAXED, __HIP_MEMORY_SCOPE_AGENT); }
        if (IN(pb + 6)) { p_mpost(F, l); SEAM(pb + 6); }
        if (IN(pb + 7)) { pg8::Gemm g{PROJ + P_AQ, (const bf16*)(wl + OW_AO), M, D, D, DINP, F.wave}; pg8::StaticOrder S; S.init(M, D, F.G, lbid());
            pg8::EpiGate<0> E{YB, D, PROJ + P_GA, DINP}; pg8::gemm_phase<pg8::EpiGate<0>, pg8::StaticOrder, true, true>(F.lds + RING_OFF, g, S, E); if (!IN(pb + 8)) {} else __syncthreads(); }
        if (IN(pb + 8)) { pg8::Gemm g{HMB, (const bf16*)(wl + OW_MO), M, D, 1024, 1024, F.wave}; pg8::StaticOrder S; S.init(M, D, F.G, lbid());
            pg8::EpiGate<1> E{YB, D, PROJ + P_GM, DINP}; pg8::gemm_phase<pg8::EpiGate<1>, pg8::StaticOrder, true, true>(F.lds + RING_OFF, g, S, E); SEAM(pb + 8); }
        if (IN(pb + 9)) { pg8::Gemm g{YB, (const bf16*)(wl + OW_WO), M, D, D, D, F.wave}; pg8::StaticOrder S; S.init(M, D, F.G, lbid());
            pg8::EpiResid<false, 2> E{XN, D, SSQ, nullptr}; pg8::gemm_phase<pg8::EpiResid<false, 2>, pg8::StaticOrder, true, true>(F.lds + RING_OFF, g, S, E); SEAM(pb + 9); }
        if (IN(pb + 10)) { pg8::Gemm g{XN, (const bf16*)(wl + OW_GU2), M, FF2, D, D, F.wave}; pg8::StaticOrder S; S.init(M, FF2, F.G, lbid());
            int pm0; RSTD_TABLE(S, pm0); pg8::EpiSwiGLU E{PROJ, DINP, SSQ, RTAB, pm0}; pg8::gemm_phase<pg8::EpiSwiGLU, pg8::StaticOrder, true, true>(F.lds + RING_OFF, g, S, E);
            if (lbid() >= GU_TAIL_C0 && l + 2 < DEPTH) gu_tail_convert(F, l + 2, GU_TAIL_NTK); SEAM(pb + 10); }
        if (IN(pb + 11)) { pg8::Gemm g{PROJ, (const bf16*)(wl + OW_DN2), M, D, FF, DINP, F.wave}; pg8::StaticOrder S; S.init(M, D, F.G, lbid());
            if (l + 1 < DEPTH) { pg8::EpiResid<false, 1> E{XN, D, SSQ, nullptr}; pg8::gemm_phase<pg8::EpiResid<false, 1>, pg8::StaticOrder, true, true>(F.lds + RING_OFF, g, S, E); }
            else { pg8::EpiResid<true, 1> E{XN, D, SSQ, F.out}; pg8::gemm_phase<pg8::EpiResid<true, 1>, pg8::StaticOrder, true, true>(F.lds + RING_OFF, g, S, E); }
            SEAM(pb + 11); }
    }
#undef IN
#undef SEAM
}

#ifndef N_LAUNCH_MODE
#define N_LAUNCH_MODE 1
#endif
extern "C" void kernel_launch(void* const* d_in, const int* in_sizes, int n_in, void* d_out, int out_size, void* d_ws, size_t ws_size, hipStream_t stream) {
    static int grid = 0;
    if (grid == 0) {
        if (n_in != 20 || in_sizes[0] != M * D || out_size != M * D || ws_size < WS_END) { fprintf(stderr, "kernel_launch: unexpected shapes / workspace (n_in %d, ws %zu, need %zu)\n", n_in, ws_size, (size_t)WS_END); grid = -1; return; }
        int dev = 0, cus = 0, per_cu = 0;
        if (hipGetDevice(&dev) != hipSuccess || hipDeviceGetAttribute(&cus, hipDeviceAttributeMultiprocessorCount, dev) != hipSuccess) { grid = -1; return; }
        if (hipFuncSetAttribute((const void*)trunk_fwd, hipFuncAttributeMaxDynamicSharedMemorySize, LDS_BYTES) != hipSuccess) { fprintf(stderr, "kernel_launch: hipFuncSetAttribute failed\n"); grid = -1; return; }
        if (hipOccupancyMaxActiveBlocksPerMultiprocessor(&per_cu, (const void*)trunk_fwd, NWAVES * 64, LDS_BYTES) != hipSuccess || per_cu < 1)
            fprintf(stderr, "kernel_launch: note: occupancy query reports %d workgroups per CU\n", per_cu);
        (void)hipGetLastError();
        grid = cus;
    }
    if (grid < 0) return;
    if (hipMemsetAsync((char*)d_ws + WS_CTL, 0, CTL_ZERO_BYTES, stream) != hipSuccess) return;
    Args a{};
    for (int i = 0; i < 20; ++i) a.in[i] = (const float*)d_in[i];
    a.out = (float*)d_out; a.ws = (unsigned char*)d_ws;
    if (N_LAUNCH_MODE == 1) {
        a.ph_lo = 0; a.ph_hi = N_PHASES;
        hipLaunchKernelGGL(trunk_fwd, dim3(grid), dim3(NWAVES * 64), LDS_BYTES, stream, a);
    } else {
        for (int p = 0; p < N_PHASES; ++p) {
            a.ph_lo = p; a.ph_hi = p + 1; hipLaunchKernelGGL(trunk_fwd, dim3(grid), dim3(NWAVES * 64), LDS_BYTES, stream, a); }
    }
}
```

```cpp
#include <hip/hip_runtime.h>
#include <cstdio>
#include <cstdint>
#include <cmath>

#define GAS __attribute__((address_space(1)))
#define LAS __attribute__((address_space(3)))
typedef unsigned short bf16;
typedef unsigned v4u __attribute__((ext_vector_type(4)));
typedef unsigned v2u __attribute__((ext_vector_type(2)));
typedef float f32x4 __attribute__((ext_vector_type(4)));
typedef float f32x2 __attribute__((ext_vector_type(2)));
typedef short bf16x8 __attribute__((ext_vector_type(8)));
typedef GAS unsigned gu32;

constexpr int BATCH = 8, SEQ = 2048, D = 2048, DEPTH = 4, M = BATCH * SEQ;
constexpr int AH = 8, RK = 256, IH = 8, IDIM = 64, TOPK = 256;
constexpr int MH = 4, DK = 128, DV = 256, CHUNK = 64, NCHUNK = SEQ / CHUNK;
constexpr int FF = 5504, FF2 = 2 * FF;
constexpr int DIN = 10064, DINP = 10240;
constexpr float EPS = 1e-6f;
constexpr int P_AQ = 0, P_CKV = 2048, P_IQ = 2304, P_IK = 2816, P_MQK = 2880, P_MV = 3904, P_MO = 4928, P_GA = 5952, P_GM = 8000, P_IW = 10048, P_MI = 10056, P_MF = 10060;
__host__ __device__ __forceinline__ int win_src_of_dest(int d) {
    if (d < 2880) return d;
    if (d < 5952) return d + 8;
    if (d < 10048) return d + 16;
    if (d < 10056) return 2880 + (d - 10048);
    if (d < 10064) return 5960 + (d - 10056);
    return -1;
}
__host__ __device__ __forceinline__ int gu_src_of_dest(int d) { const int pn = d >> 8, r = d & 255; return (r < 128) ? (pn * 128 + r) : (FF + pn * 128 + (r - 128)); }

constexpr size_t MiB = 1u << 20;
constexpr size_t WS_CTL = 0, CTL_ZERO_BYTES = 2 * MiB;
constexpr size_t SZ_GU = (size_t)FF2 * D * 2, SZ_DN = (size_t)D * FF * 2, SZ_IN = (size_t)DINP * D * 2, SZ_AO = (size_t)D * D * 2, SZ_MO = (size_t)D * 1024 * 2, SZ_WO = (size_t)D * D * 2;
constexpr size_t LAYER_W = 2 * SZ_GU + 2 * SZ_DN + SZ_IN + SZ_AO + SZ_MO + SZ_WO;
constexpr size_t OW_GU1 = 0, OW_DN1 = OW_GU1 + SZ_GU, OW_IN = OW_DN1 + SZ_DN, OW_AO = OW_IN + SZ_IN, OW_MO = OW_AO + SZ_AO, OW_WO = OW_MO + SZ_MO, OW_GU2 = OW_WO + SZ_WO, OW_DN2 = OW_GU2 + SZ_GU;
constexpr size_t WS_W = 2 * MiB;
constexpr size_t WS_XN = WS_W + DEPTH * LAYER_W;
constexpr size_t WS_PROJ = WS_XN + (size_t)M * D * 2;
constexpr size_t WS_MQK = WS_PROJ + (size_t)M * DINP * 2;
constexpr size_t WS_HRAW = WS_MQK + (size_t)M * 1024 * 2;
constexpr size_t WS_HM = WS_HRAW + (size_t)M * 1024 * 2;
constexpr size_t WS_Y = WS_HM + (size_t)M * 1024 * 2;
constexpr size_t WS_PART = WS_Y + (size_t)M * D * 2;
constexpr size_t WS_END = WS_PART + (size_t)M * 32 * 4;
static_assert(WS_END <= (size_t)1440 * 1000 * 1000, "workspace map must fit 4x the largest input tensor");
static_assert((LAYER_W % 256) == 0, "alignment");

constexpr int CW_TMO = 0, CW_CODE = 1;
constexpr int CW_BAR = 4096;
constexpr int CW_TICKET = 8192;
constexpr int CW_CVT = 8192 + 1024;
constexpr int CW_ATK = 12288;
constexpr int CW_CVD = 14336;
constexpr int CW_GBAR = 16384;
constexpr int CW_TBAR = 65536;
constexpr int TEAM_WG = 4;
constexpr int NGROUP = 8, GROUP_WG = 32;

constexpr int RING_OFF = 0, RING_BYTES = 131072;
constexpr int LDSCTL_OFF = RING_BYTES, MISC_OFF = LDSCTL_OFF + 320;
constexpr int LDS_BYTES = 147456;
constexpr int NWAVES = 8;

#define RLX_AGENT __ATOMIC_RELAXED, __HIP_MEMORY_SCOPE_AGENT
#define LDS_WAIT() asm volatile("s_waitcnt lgkmcnt(0)" ::: "memory")
#define VM_WAIT() asm volatile("s_waitcnt vmcnt(0)" ::: "memory")
__device__ __forceinline__ unsigned f2bf(float f) { unsigned u = __builtin_bit_cast(unsigned, f); return (u + 0x7fffu + ((u >> 16) & 1u)) >> 16; }
typedef __bf16 bf16x2_hw __attribute__((ext_vector_type(2)));
__device__ __forceinline__ unsigned pk2(float lo, float hi) { const f32x2 v = {lo, hi}; const bf16x2_hw b = __builtin_convertvector(v, bf16x2_hw); return __builtin_bit_cast(unsigned, b); }
__device__ __forceinline__ float bflo(unsigned w) { return __builtin_bit_cast(float, w << 16); }
__device__ __forceinline__ float bfhi(unsigned w) { return __builtin_bit_cast(float, w & 0xffff0000u); }
__device__ __forceinline__ float bf2f(bf16 b) { return __builtin_bit_cast(float, ((unsigned)b) << 16); }
__device__ __forceinline__ float silu_f(float g) { return g * __builtin_amdgcn_rcpf(1.0f + __expf(-g)); }
__device__ __forceinline__ float sigm_f(float g) { return __builtin_amdgcn_rcpf(1.0f + __expf(-g)); }
__device__ __forceinline__ float wave_sum(float v) {
#pragma unroll
    for (int o = 1; o < 64; o <<= 1) v += __shfl_xor(v, o);
    return v;
}
__device__ __forceinline__ float wave_max(float v) {
#pragma unroll
    for (int o = 1; o < 64; o <<= 1) v = fmaxf(v, __shfl_xor(v, o));
    return v;
}
__device__ __forceinline__ unsigned sortable_key(float f) { const unsigned u = __builtin_bit_cast(unsigned, f); return (u & 0x80000000u) ? ~u : (u | 0x80000000u); }
__device__ __forceinline__ int t5_bucket_dev(int n) {
    if (n < 16) return n;
    const float v = logf((float)n / 16.0f) / 2.0794415416798357f * 16.0f;
    int large = 16 + (int)v; return large < 31 ? large : 31;
}
__device__ __forceinline__ int wave_sum_dpp(int v) {
    v += __builtin_amdgcn_update_dpp(0, v, 0xB1, 0xF, 0xF, true);
    v += __builtin_amdgcn_update_dpp(0, v, 0x4E, 0xF, 0xF, true);
    v += __builtin_amdgcn_update_dpp(0, v, 0x141, 0xF, 0xF, true);
    v += __builtin_amdgcn_update_dpp(0, v, 0x140, 0xF, 0xF, true);
    v += __builtin_amdgcn_update_dpp(0, v, 0x142, 0xA, 0xF, true);
    v += __builtin_amdgcn_update_dpp(0, v, 0x143, 0xC, 0xF, true);
    return __builtin_amdgcn_readlane(v, 63);
}
__device__ __forceinline__ int fresh_tid(int wave) { int w_ = wave; asm volatile("" : "+s"(w_)); unsigned m_ = ~0u; asm volatile("" : "+s"(m_)); const int l_ = (int)__builtin_amdgcn_mbcnt_hi(m_, __builtin_amdgcn_mbcnt_lo(m_, 0u));     return w_ * 64 + l_; }

namespace pg8 {
#define PG8_LAS __attribute__((address_space(3)))
typedef unsigned short bf16_t;
typedef short bf16x8 __attribute__((ext_vector_type(8)));
typedef float f32x4 __attribute__((ext_vector_type(4)));
typedef unsigned u32x4 __attribute__((ext_vector_type(4)));
constexpr int BM = 256, BK = 64, HALF = 128, HTB = HALF * BK * 2  , STAGE_BYTES = 8 * HTB, NXCD = 8, WGM = 8;

__host__ __device__ __forceinline__ int lds_byte(int r, int c) { const int st = (r >> 4) * 2 + (c >> 5), rr = r & 15, cc = c & 31, ob = rr * 64 + cc * 2; return st * 1024 + (ob ^ (((ob >> 9) & 1) << 5)); }
__host__ __device__ __forceinline__ void stage_rc(int b, int& R, int& C) { const int st = b / 1024, sb = b % 1024, swz = sb ^ (((sb >> 9) & 1) << 5); R = (st >> 1) * 16 + swz / 64; C = (st & 1) * 32 + (swz % 64) / 2; }
__host__ __device__ __forceinline__ int perm32(int rho) { const int n = rho >> 4, i = rho & 15; return 8 * (i >> 2) + 4 * n + (i & 3); }

struct Unit { int pm, pn; };
struct Gemm { const bf16_t* A; const bf16_t* Bt; int M, N, K, lda, wave; };

struct StaticOrder {
    int nM, nN, nwg, G, c;
    __host__ __device__ void init(int M, int N, int G_, int c_) { nM = M / BM; nN = N / BM; nwg = nM * nN; G = G_; c = c_; }
    __host__ __device__ bool next(int i, Unit& u) const {
        const long L = (long)i * G + c; if (L >= nwg) return false;
        int wgid = (int)L; { const int q = nwg / NXCD, r = nwg % NXCD, xcd = wgid % NXCD, off = wgid / NXCD; wgid = (xcd < r ? xcd * (q + 1) : r * (q + 1) + (xcd - r) * q) + off; }
        const int nig = WGM * nN, gid = wgid / nig, fm = gid * WGM, gsz = (nM - fm) < WGM ? (nM - fm) : WGM;
        u.pm = fm + ((wgid % nig) % gsz); u.pn = (wgid % nig) / gsz; return true;
    }
    __device__ __forceinline__ void a_ready(const Unit&) const {}
    __device__ __forceinline__ void done(const Unit&) const {}
};

__device__ __forceinline__ unsigned cvt_pk_bf16(float lo, float hi) { return pk2(lo, hi); }

__device__ __forceinline__ void rows_rstd(float (&rs)[2][4], const float* part, int row0, int fq) {
    f32x4 a[2][4], b[2][4];
#pragma unroll
    for (int ai = 0; ai < 2; ++ai)
#pragma unroll
        for (int m = 0; m < 4; ++m) { const float* p = part + (size_t)(row0 + ai * HALF + m * 16) * 32 + 8 * fq; a[ai][m] = *(const __attribute__((address_space(1))) f32x4*)p; b[ai][m] = *(const __attribute__((address_space(1))) f32x4*)(p + 4); }
#pragma unroll
    for (int ai = 0; ai < 2; ++ai)
#pragma unroll
        for (int m = 0; m < 4; ++m) { float s = ((a[ai][m][0] + a[ai][m][1]) + (a[ai][m][2] + a[ai][m][3])) + ((b[ai][m][0] + b[ai][m][1]) + (b[ai][m][2] + b[ai][m][3]));
            s += __shfl_xor(s, 16); s += __shfl_xor(s, 32); rs[ai][m] = 1.0f / sqrtf(s * (1.0f / 2048.0f) + 1e-6f); }
}
struct EpiBf16 {
    static constexpr bool PERM = true, AFTER_DRAIN = false;
    bf16_t* O; int ldc; const float* ssq; const PG8_LAS float* rtab; int pm0;
    __device__ __forceinline__ void operator()(const f32x4 (&acc)[2][2][4][2], const Unit& u, int wr, int wc, int fr, int fq) const {
        const int row0 = u.pm * BM + wr * 64 + fr; const int col0 = u.pn * BM + wc * 32 + 8 * fq;
#pragma unroll
        for (int ai = 0; ai < 2; ++ai)
#pragma unroll
            for (int m = 0; m < 4; ++m) { const int row = row0 + ai * HALF + m * 16; bf16_t* rowp = O + (size_t)row * ldc + col0;
                const float rs = rtab[wr * 64 + fr + ai * HALF + m * 16];
#pragma unroll
                for (int bj = 0; bj < 2; ++bj) { const f32x4 v0 = acc[ai][bj][m][0] * rs, v1 = acc[ai][bj][m][1] * rs;
                    u32x4 w; w.x = cvt_pk_bf16(v0[0], v0[1]); w.y = cvt_pk_bf16(v0[2], v0[3]); w.z = cvt_pk_bf16(v1[0], v1[1]); w.w = cvt_pk_bf16(v1[2], v1[3]);
                    *(__attribute__((address_space(1))) u32x4*)(rowp + bj * HALF) = w; } }
    }
};
struct EpiProj {
    static constexpr bool PERM = true, AFTER_DRAIN = false;
    bf16_t* O; int ldc; const PG8_LAS float* rtab; PG8_LAS float* tab2; const float* qg; const float* kg;
    __device__ __forceinline__ void operator()(const f32x4 (&acc)[2][2][4][2], const Unit& u, int wr, int wc, int fr, int fq) const {
        typedef __attribute__((address_space(1))) u32x4 gu4; typedef __attribute__((address_space(1))) const f32x4 gcf4;
        const int row0 = u.pm * BM + wr * 64 + fr; const int col0 = u.pn * BM + wc * 32 + 8 * fq;
        if (u.pn <= 8) {
#pragma unroll
            for (int ai = 0; ai < 2; ++ai)
#pragma unroll
                for (int m = 0; m < 4; ++m) { const int rl = wr * 64 + fr + ai * HALF + m * 16; const float rs = rtab[rl]; float s = 0.f;
#pragma unroll
                    for (int bj = 0; bj < 2; ++bj)
#pragma unroll
                        for (int n = 0; n < 2; ++n) { const f32x4 v = acc[ai][bj][m][n] * rs; s += (v[0] * v[0] + v[1] * v[1]) + (v[2] * v[2] + v[3] * v[3]); }
                    s += __shfl_xor(s, 16); s += __shfl_xor(s, 32);
                    if (fq == 0) tab2[rl * 4 + wc] = s; }
            asm volatile("s_waitcnt lgkmcnt(0)\n\ts_barrier" ::: "memory");
            const float* gp = (u.pn < 8 ? qg : kg) + wc * 32 + 8 * fq;
            const float qsc = (u.pn < 8) ? 0.0625f * 1.4426950408889634f : 1.0f;
            f32x4 gv[2][2];
#pragma unroll
            for (int bj = 0; bj < 2; ++bj)
#pragma unroll
                for (int n = 0; n < 2; ++n) gv[bj][n] = *(gcf4*)(gp + bj * HALF + 4 * n);
#pragma unroll
            for (int ai = 0; ai < 2; ++ai)
#pragma unroll
                for (int m = 0; m < 4; ++m) { const int rl = wr * 64 + fr + ai * HALF + m * 16; bf16_t* rowp = O + (size_t)(row0 + ai * HALF + m * 16) * ldc + col0;
                    const f32x4 t4 = *(const PG8_LAS f32x4*)(tab2 + rl * 4);
                    const float rs = qsc * rtab[rl] / sqrtf(((t4[0] + t4[1]) + (t4[2] + t4[3])) * (1.0f / 256.0f) + 1e-6f);
#pragma unroll
                    for (int bj = 0; bj < 2; ++bj) { const f32x4 v0 = acc[ai][bj][m][0] * rs * gv[bj][0], v1 = acc[ai][bj][m][1] * rs * gv[bj][1];
                        u32x4 w; w.x = cvt_pk_bf16(v0[0], v0[1]); w.y = cvt_pk_bf16(v0[2], v0[3]); w.z = cvt_pk_bf16(v1[0], v1[1]); w.w = cvt_pk_bf16(v1[2], v1[3]);
                        *(gu4*)(rowp + bj * HALF) = w; } }
            asm volatile("s_waitcnt lgkmcnt(0)\n\ts_barrier" ::: "memory");
        } else {
#pragma unroll
            for (int ai = 0; ai < 2; ++ai)
#pragma unroll
                for (int m = 0; m < 4; ++m) { bf16_t* rowp = O + (size_t)(row0 + ai * HALF + m * 16) * ldc + col0;
                    const float rs = rtab[wr * 64 + fr + ai * HALF + m * 16];
#pragma unroll
                    for (int bj = 0; bj < 2; ++bj) { const f32x4 v0 = acc[ai][bj][m][0] * rs, v1 = acc[ai][bj][m][1] * rs;
                        u32x4 w; w.x = cvt_pk_bf16(v0[0], v0[1]); w.y = cvt_pk_bf16(v0[2], v0[3]); w.z = cvt_pk_bf16(v1[0], v1[1]); w.w = cvt_pk_bf16(v1[2], v1[3]);
                        *(gu4*)(rowp + bj * HALF) = w; } }
        }
    }
};
struct EpiSwiGLU {
    static constexpr bool PERM = true, AFTER_DRAIN = false;
    bf16_t* O; int ldc; const float* ssq; const PG8_LAS float* rtab; int pm0;
    __device__ __forceinline__ void operator()(const f32x4 (&acc)[2][2][4][2], const Unit& u, int wr, int wc, int fr, int fq) const {
        const int row0 = u.pm * BM + wr * 64 + fr; const int col0 = u.pn * HALF + wc * 32 + 8 * fq;
#pragma unroll
        for (int ai = 0; ai < 2; ++ai)
#pragma unroll
            for (int m = 0; m < 4; ++m) { const int row = row0 + ai * HALF + m * 16; bf16_t* rowp = O + (size_t)row * ldc + col0;
                const float rs = rtab[wr * 64 + fr + ai * HALF + m * 16];
                f32x4 v0, v1;
                {
                    const float nrs_ = rs * -1.4426950408889634f, rsq_ = rs * rs; const f32x2 nrs2 = {nrs_, nrs_}, rsq2 = {rsq_, rsq_}, one2 = {1.0f, 1.0f};
#pragma unroll
                    for (int h = 0; h < 2; ++h) {
                        const f32x2 g0 = {acc[ai][0][m][0][2 * h], acc[ai][0][m][0][2 * h + 1]}, u0 = {acc[ai][1][m][0][2 * h], acc[ai][1][m][0][2 * h + 1]};
                        const f32x2 g1 = {acc[ai][0][m][1][2 * h], acc[ai][0][m][1][2 * h + 1]}, u1 = {acc[ai][1][m][1][2 * h], acc[ai][1][m][1][2 * h + 1]};
                        const f32x2 a0 = g0 * nrs2, a1 = g1 * nrs2; const f32x2 t0 = (g0 * u0) * rsq2, t1 = (g1 * u1) * rsq2;
                        const f32x2 e0 = {__builtin_amdgcn_exp2f(a0.x), __builtin_amdgcn_exp2f(a0.y)}, e1 = {__builtin_amdgcn_exp2f(a1.x), __builtin_amdgcn_exp2f(a1.y)};
                        const f32x2 d0 = e0 + one2, d1 = e1 + one2;
                        const f32x2 r0 = {__builtin_amdgcn_rcpf(d0.x), __builtin_amdgcn_rcpf(d0.y)}, r1 = {__builtin_amdgcn_rcpf(d1.x), __builtin_amdgcn_rcpf(d1.y)};
                        const f32x2 o0 = t0 * r0, o1 = t1 * r1;
                        v0[2 * h] = o0.x; v0[2 * h + 1] = o0.y; v1[2 * h] = o1.x; v1[2 * h + 1] = o1.y; } }
                u32x4 w; w.x = cvt_pk_bf16(v0[0], v0[1]); w.y = cvt_pk_bf16(v0[2], v0[3]); w.z = cvt_pk_bf16(v1[0], v1[1]); w.w = cvt_pk_bf16(v1[2], v1[3]);
                *(__attribute__((address_space(1))) u32x4*)(rowp) = w; }
    }
};
template <bool FINAL, int ALPHA2> struct EpiResid {
    static constexpr bool PERM = true, AFTER_DRAIN = false;
    bf16_t* H; int ldc; float* ssq; float* outf;
    __device__ __forceinline__ void operator()(const f32x4 (&acc)[2][2][4][2], const Unit& u, int wr, int wc, int fr, int fq) const {
        typedef __attribute__((address_space(1))) const u32x4 gcu4; typedef __attribute__((address_space(1))) f32x4 gf4; typedef __attribute__((address_space(1))) u32x4 gu4; typedef __attribute__((address_space(1))) float gf1;
        const int row0 = u.pm * BM + wr * 64 + fr, col0 = u.pn * BM + wc * 32 + 8 * fq;
#pragma unroll
        for (int ai = 0; ai < 2; ++ai) {
            u32x4 hb[4][2];
#pragma unroll
            for (int m = 0; m < 4; ++m)
#pragma unroll
                for (int bj = 0; bj < 2; ++bj) hb[m][bj] = *(gcu4*)(H + (size_t)(row0 + ai * HALF + m * 16) * ldc + col0 + bj * HALF);
#pragma unroll
            for (int m = 0; m < 4; ++m) { const size_t off = (size_t)(row0 + ai * HALF + m * 16) * ldc + col0; float s = 0.f;
#pragma unroll
                for (int bj = 0; bj < 2; ++bj) { const u32x4 h4 = hb[m][bj];
                    f32x4 v0, v1;
                    v0[0] = __builtin_bit_cast(float, h4.x << 16); v0[1] = __builtin_bit_cast(float, h4.x & 0xffff0000u); v0[2] = __builtin_bit_cast(float, h4.y << 16); v0[3] = __builtin_bit_cast(float, h4.y & 0xffff0000u);
                    v1[0] = __builtin_bit_cast(float, h4.z << 16); v1[1] = __builtin_bit_cast(float, h4.z & 0xffff0000u); v1[2] = __builtin_bit_cast(float, h4.w << 16); v1[3] = __builtin_bit_cast(float, h4.w & 0xffff0000u);
                    v0 = v0 + acc[ai][bj][m][0] * (0.5f * (float)ALPHA2); v1 = v1 + acc[ai][bj][m][1] * (0.5f * (float)ALPHA2);
                    if (FINAL) { *(gf4*)(outf + off + bj * HALF) = v0; *(gf4*)(outf + off + bj * HALF + 4) = v1; }
                    else { s += ((v0[0] * v0[0] + v0[1] * v0[1]) + (v0[2] * v0[2] + v0[3] * v0[3])) + ((v1[0] * v1[0] + v1[1] * v1[1]) + (v1[2] * v1[2] + v1[3] * v1[3]));
                        u32x4 w; w.x = cvt_pk_bf16(v0[0], v0[1]); w.y = cvt_pk_bf16(v0[2], v0[3]); w.z = cvt_pk_bf16(v1[0], v1[1]); w.w = cvt_pk_bf16(v1[2], v1[3]);
                        *(gu4*)(H + off + bj * HALF) = w; } }
                if (!FINAL) { s += __shfl_xor(s, 16); s += __shfl_xor(s, 32);
                    if (fq == 0) *(gf1*)(ssq + (size_t)(row0 + ai * HALF + m * 16) * 32 + u.pn * 4 + wc) = s; } }
        }
    }
};
template <int MODE> struct EpiGate {
    static constexpr bool PERM = true, AFTER_DRAIN = false;
    bf16_t* Y; int ldc; const bf16_t* gate; int ldg;
    __device__ __forceinline__ void operator()(const f32x4 (&acc)[2][2][4][2], const Unit& u, int wr, int wc, int fr, int fq) const {
        typedef __attribute__((address_space(1))) const u32x4 gcu4; typedef __attribute__((address_space(1))) u32x4 gu4;
        const int row0 = u.pm * BM + wr * 64 + fr; const int col0 = u.pn * BM + wc * 32 + 8 * fq;
#pragma unroll
        for (int ai = 0; ai < 2; ++ai) {
            u32x4 gw[4][2], yw[4][2];
#pragma unroll
            for (int m = 0; m < 4; ++m)
#pragma unroll
                for (int bj = 0; bj < 2; ++bj) { const int row = row0 + ai * HALF + m * 16; gw[m][bj] = *(gcu4*)(gate + (size_t)row * ldg + col0 + bj * HALF);
                    if (MODE == 1) yw[m][bj] = *(gcu4*)(Y + (size_t)row * ldc + col0 + bj * HALF); }
#pragma unroll
            for (int m = 0; m < 4; ++m) { const int row = row0 + ai * HALF + m * 16; bf16_t* rowp = Y + (size_t)row * ldc + col0;
#pragma unroll
                for (int bj = 0; bj < 2; ++bj) { const u32x4 g4 = gw[m][bj];
                    float gv[8]; gv[0] = __builtin_bit_cast(float, g4.x << 16); gv[1] = __builtin_bit_cast(float, g4.x & 0xffff0000u); gv[2] = __builtin_bit_cast(float, g4.y << 16); gv[3] = __builtin_bit_cast(float, g4.y & 0xffff0000u);
                    gv[4] = __builtin_bit_cast(float, g4.z << 16); gv[5] = __builtin_bit_cast(float, g4.z & 0xffff0000u); gv[6] = __builtin_bit_cast(float, g4.w << 16); gv[7] = __builtin_bit_cast(float, g4.w & 0xffff0000u);
                    float o[8];
#pragma unroll
                    for (int j = 0; j < 4; ++j) { o[j] = sigm_f(gv[j]) * acc[ai][bj][m][0][j]; o[4 + j] = sigm_f(gv[4 + j]) * acc[ai][bj][m][1][j]; }
                    if (MODE == 1) { const u32x4 y4 = yw[m][bj];
                        o[0] += __builtin_bit_cast(float, y4.x << 16); o[1] += __builtin_bit_cast(float, y4.x & 0xffff0000u); o[2] += __builtin_bit_cast(float, y4.y << 16); o[3] += __builtin_bit_cast(float, y4.y & 0xffff0000u);
                        o[4] += __builtin_bit_cast(float, y4.z << 16); o[5] += __builtin_bit_cast(float, y4.z & 0xffff0000u); o[6] += __builtin_bit_cast(float, y4.w << 16); o[7] += __builtin_bit_cast(float, y4.w & 0xffff0000u); }
                    u32x4 w; w.x = cvt_pk_bf16(o[0], o[1]); w.y = cvt_pk_bf16(o[2], o[3]); w.z = cvt_pk_bf16(o[4], o[5]); w.w = cvt_pk_bf16(o[6], o[7]);
                    *(gu4*)(rowp + bj * HALF) = w; } }
        }
    }
};

template <class Epi, class Sched, bool ALIGN_EPI = false, bool SP2 = false>
__device__ __forceinline__ void gemm_phase(PG8_LAS unsigned char* lds, const Gemm g, const Sched& S, const Epi& E) {
    const int tid_ = fresh_tid(g.wave);
    const int tid = tid_, wid = __builtin_amdgcn_readfirstlane(tid >> 6), lane = tid & 63, wr = wid >> 2, wc = wid & 3, fr = lane & 15, fq = lane >> 4;
    const int K = g.K, nt = K / BK;
    unsigned voffA[2], voffB[2];
#pragma unroll
    for (int i = 0; i < 2; ++i) { int R, C; stage_rc(tid * 16 + i * 8192, R, C); const int Rb = Epi::PERM ? ((R & ~31) + perm32(R & 31)) : R;
        voffA[i] = (unsigned)(R * g.lda + C) * 2u; voffB[i] = (unsigned)(Rb * K + C) * 2u; }
    const size_t kstep = (size_t)(BK * 2);
    const size_t hstepB = (size_t)HALF * K * 2, hstepA = (size_t)HALF * g.lda * 2;
    const size_t tstepB = 2 * hstepB, tstepA = 2 * hstepA;
    const unsigned ldsw = (unsigned)wid * 1024u;
    const int aoff = lds_byte(wr * 64 + fr, fq * 8), boff = lds_byte(wc * 32 + fr, fq * 8);
#define PG8_SA(b, h) (((b) * 2 + (h)) * HTB)
#define PG8_SB(b, h) ((4 + (b) * 2 + (h)) * HTB)
#define PG8_STAGE(bufoff, gbase, voff) do { _Pragma("unroll") for (int _i = 0; _i < 2; ++_i) \
        __builtin_amdgcn_global_load_lds((const unsigned*)((const char*)(gbase) + (voff)[_i]), (PG8_LAS unsigned*)(lds + (bufoff) + ldsw + _i * 8192), 16, 0, 0); } while (0)
#define PG8_LDA(dst, b, h) do { _Pragma("unroll") for (int m = 0; m < 4; ++m) _Pragma("unroll") for (int k = 0; k < 2; ++k) dst[m][k] = *(const PG8_LAS bf16x8*)(lds + PG8_SA(b, h) + aoff + m * 2048 + k * 1024); } while (0)
#define PG8_LDB(dst, b, h) do { _Pragma("unroll") for (int n = 0; n < 2; ++n) _Pragma("unroll") for (int k = 0; k < 2; ++k) dst[n][k] = *(const PG8_LAS bf16x8*)(lds + PG8_SB(b, h) + boff + n * 2048 + k * 1024); } while (0)
#define PG8_MMA(ai, bj, At, Bt) do { __builtin_amdgcn_s_setprio(1); _Pragma("unroll") for (int m = 0; m < 4; ++m) _Pragma("unroll") for (int n = 0; n < 2; ++n) _Pragma("unroll") for (int k = 0; k < 2; ++k) \
        acc[ai][bj][m][n] = __builtin_amdgcn_mfma_f32_16x16x32_bf16(Bt[n][k], At[m][k], acc[ai][bj][m][n], 0, 0, 0); __builtin_amdgcn_s_setprio(0); } while (0)
#define PG8_WAIT_V(n) asm volatile("s_waitcnt vmcnt(" #n ")" ::: "memory")
#define PG8_WAIT_L(n) asm volatile("s_waitcnt lgkmcnt(" #n ")" ::: "memory")
#define PG8_BAR __builtin_amdgcn_s_barrier()
#define PG8_SCHED __builtin_amdgcn_sched_barrier(0)
    Unit cur, nxt; int ui = 0;
    if (!S.next(0, cur)) return;
    f32x4 acc[2][2][4][2];
#pragma unroll
    for (int a = 0; a < 2; ++a)
#pragma unroll
        for (int b = 0; b < 2; ++b)
#pragma unroll
            for (int m = 0; m < 4; ++m)
#pragma unroll
                for (int n = 0; n < 2; ++n) acc[a][b][m][n] = (f32x4){0.f, 0.f, 0.f, 0.f};
    bf16x8 At[4][2], B0[2][2], B1[2][2];
    const char* cA = (const char*)g.A + (size_t)cur.pm * tstepA; const char* cB = (const char*)g.Bt + (size_t)cur.pn * tstepB;
    S.a_ready(cur);
    if constexpr (SP2) {
        PG8_STAGE(PG8_SB(0, 0), cB, voffB); PG8_STAGE(PG8_SB(0, 1), cB + hstepB, voffB); PG8_STAGE(PG8_SA(0, 0), cA, voffA); PG8_STAGE(PG8_SA(0, 1), cA + hstepA, voffA);
        if (wr == 1) PG8_BAR;
        PG8_WAIT_V(2); PG8_BAR;
        PG8_STAGE(PG8_SB(1, 0), cB + kstep, voffB); PG8_STAGE(PG8_SA(1, 0), cA + kstep, voffA); PG8_STAGE(PG8_SB(1, 1), cB + hstepB + kstep, voffB);
        PG8_WAIT_V(6); PG8_BAR;
    } else {
        PG8_STAGE(PG8_SB(0, 0), cB, voffB); PG8_STAGE(PG8_SA(0, 0), cA, voffA); PG8_STAGE(PG8_SB(0, 1), cB + hstepB, voffB); PG8_STAGE(PG8_SA(0, 1), cA + hstepA, voffA);
        if (wr == 1) PG8_BAR;
        PG8_WAIT_V(4); PG8_BAR;
        PG8_STAGE(PG8_SB(1, 0), cB + kstep, voffB); PG8_STAGE(PG8_SA(1, 0), cA + kstep, voffA); PG8_STAGE(PG8_SB(1, 1), cB + hstepB + kstep, voffB);
        PG8_WAIT_V(6); PG8_BAR;
    }
    for (;;) {
        const bool has_next = S.next(ui + 1, nxt);
        const char* nA = has_next ? (const char*)g.A + (size_t)nxt.pm * tstepA : cA; const char* nB = has_next ? (const char*)g.Bt + (size_t)nxt.pn * tstepB : cB;
        for (int t = 0; t < nt; t += 2) {
            const bool last = (t == nt - 2);
            const char* a1 = cA + (size_t)(t + 1) * kstep;
            const char* a2 = last ? nA : cA + (size_t)(t + 2) * kstep; const char* b2 = last ? nB : cB + (size_t)(t + 2) * kstep;
            const char* a3 = a2 + kstep; const char* b3 = b2 + kstep;
            if (last && has_next) S.a_ready(nxt);
            if constexpr (SP2) {
            PG8_LDB(B0, 0, 0); PG8_LDB(B1, 0, 1); PG8_SCHED; PG8_LDA(At, 0, 0); PG8_STAGE(PG8_SA(1, 1), a1 + hstepA, voffA);
            PG8_WAIT_V(8); PG8_WAIT_L(0); PG8_BAR; PG8_MMA(0, 0, At, B0); PG8_MMA(0, 1, At, B1); PG8_BAR; PG8_SCHED;
            PG8_LDA(At, 0, 1); PG8_STAGE(PG8_SB(0, 0), b2, voffB); PG8_STAGE(PG8_SB(0, 1), b2 + hstepB, voffB); PG8_STAGE(PG8_SA(0, 0), a2, voffA);
            PG8_WAIT_V(8); PG8_WAIT_L(0); PG8_BAR; PG8_MMA(1, 0, At, B0); PG8_MMA(1, 1, At, B1); PG8_BAR; PG8_SCHED;
            PG8_LDB(B0, 1, 0); PG8_LDB(B1, 1, 1); PG8_SCHED; PG8_LDA(At, 1, 0); PG8_STAGE(PG8_SA(0, 1), a2 + hstepA, voffA);
            PG8_WAIT_V(8); PG8_WAIT_L(0); PG8_BAR; PG8_MMA(0, 0, At, B0); PG8_MMA(0, 1, At, B1); PG8_BAR; PG8_SCHED;
            PG8_LDA(At, 1, 1); PG8_STAGE(PG8_SB(1, 0), b3, voffB); PG8_STAGE(PG8_SB(1, 1), b3 + hstepB, voffB); PG8_STAGE(PG8_SA(1, 0), a3, voffA);
            PG8_WAIT_V(8); PG8_WAIT_L(0); PG8_BAR; PG8_MMA(1, 0, At, B0); PG8_MMA(1, 1, At, B1); PG8_BAR; PG8_SCHED;
            } else {
            PG8_LDB(B0, 0, 0); PG8_SCHED; PG8_LDA(At, 0, 0); PG8_STAGE(PG8_SA(1, 1), a1 + hstepA, voffA);
            PG8_WAIT_L(8); PG8_BAR; PG8_WAIT_L(0); PG8_MMA(0, 0, At, B0); PG8_BAR; PG8_SCHED;
            PG8_LDB(B1, 0, 1); PG8_STAGE(PG8_SB(0, 0), b2, voffB);
            PG8_BAR; PG8_WAIT_L(0); PG8_MMA(0, 1, At, B1); PG8_BAR;
            PG8_LDA(At, 0, 1); PG8_STAGE(PG8_SA(0, 0), a2, voffA);
            PG8_BAR; PG8_WAIT_L(0); PG8_MMA(1, 0, At, B0); PG8_BAR; PG8_SCHED;
            PG8_STAGE(PG8_SB(0, 1), b2 + hstepB, voffB);
            PG8_WAIT_V(6); PG8_BAR; PG8_MMA(1, 1, At, B1); PG8_BAR;
            PG8_LDB(B0, 1, 0); PG8_SCHED; PG8_LDA(At, 1, 0); PG8_STAGE(PG8_SA(0, 1), a2 + hstepA, voffA);
            PG8_WAIT_L(8); PG8_BAR; PG8_WAIT_L(0); PG8_MMA(0, 0, At, B0); PG8_BAR; PG8_SCHED;
            PG8_LDB(B1, 1, 1); PG8_STAGE(PG8_SB(1, 0), b3, voffB);
            PG8_BAR; PG8_WAIT_L(0); PG8_MMA(0, 1, At, B1); PG8_BAR;
            PG8_LDA(At, 1, 1); PG8_STAGE(PG8_SA(1, 0), a3, voffA);
            PG8_BAR; PG8_WAIT_L(0); PG8_MMA(1, 0, At, B0); PG8_BAR; PG8_SCHED;
            PG8_STAGE(PG8_SB(1, 1), b3 + hstepB, voffB);
            PG8_WAIT_V(6); PG8_BAR; PG8_MMA(1, 1, At, B1); PG8_BAR;
            }
        }
        if constexpr (ALIGN_EPI) { if (wr == 0) PG8_BAR; }
        if constexpr (!Epi::AFTER_DRAIN) { E(acc, cur, wr, wc, fr, fq); S.done(cur); }
        if (!has_next) break;
#pragma unroll
        for (int a = 0; a < 2; ++a)
#pragma unroll
            for (int b = 0; b < 2; ++b)
#pragma unroll
                for (int m = 0; m < 4; ++m)
#pragma unroll
                    for (int n = 0; n < 2; ++n) acc[a][b][m][n] = (f32x4){0.f, 0.f, 0.f, 0.f};
        cur = nxt; cA = nA; cB = nB; ++ui;
        if constexpr (ALIGN_EPI) { if (wr == 1) PG8_BAR; }
    }
    PG8_WAIT_V(0);
    if constexpr (!ALIGN_EPI) { if (wr == 0) PG8_BAR; }
    PG8_BAR;
    if constexpr (Epi::AFTER_DRAIN) { E.fused(acc, cur, wr, wc, fr, fq, lds, wid, lane); S.done(cur); }
#undef PG8_SA
#undef PG8_SB
#undef PG8_STAGE
#undef PG8_LDA
#undef PG8_LDB
#undef PG8_MMA
#undef PG8_WAIT_V
#undef PG8_WAIT_L
#undef PG8_BAR
#undef PG8_SCHED
}
}


#define XB_TMO      128
#define XB_XCNT(j)  (256  + 64 * (j))
#define XB_XSUB(j)  (1280 + 64 * (j))
#define XB_XGEN(j)  (2304 + 64 * (j))
#define XB_TOP      3328
#define XB_TOPGEN   3392
#define XCD_BAR_WORDS 3456
#define XB_SPIN_CAP (1u << 18)

__device__ __forceinline__ unsigned xb_ld(unsigned* p)              { return __hip_atomic_load(p, __ATOMIC_RELAXED, __HIP_MEMORY_SCOPE_AGENT); }
__device__ __forceinline__ unsigned xb_add(unsigned* p, unsigned v) { return __hip_atomic_fetch_add(p, v, __ATOMIC_RELAXED, __HIP_MEMORY_SCOPE_AGENT); }
__device__ __forceinline__ unsigned xb_xcc_id() { return (unsigned)__builtin_amdgcn_s_getreg((3 << 11) | 20) & 0xFu; }
#define XB_SPIN(cond, bar) do { unsigned _sp = 0; while (cond) { __builtin_amdgcn_s_sleep(1); \
    if ((++_sp & 255u) == 0u) { if (xb_ld(&(bar)[XB_TMO])) break; if (_sp > XB_SPIN_CAP) { atomicAdd(&(bar)[XB_TMO], 1u); break; } } } } while (0)

struct XcdBarrier {
    unsigned* bar; unsigned x; unsigned G;
    volatile LAS unsigned* st;
};
__device__ __forceinline__ XcdBarrier xcd_barrier_post(unsigned* bar, volatile LAS unsigned* st, unsigned members) {
    XcdBarrier b; b.bar = bar; b.x = xb_xcc_id(); b.st = st; b.G = members;
    if (threadIdx.x == 0) (void)xb_add(&bar[XB_XCNT(b.x)], 1u);
    return b;
}
__device__ __forceinline__ void xcd_barrier_complete(unsigned* bar, unsigned x, unsigned G, unsigned& nloc, unsigned& nx) {
    unsigned sum, cnt, mine, sp = 0u;
    for (;;) {
        sum = 0u; cnt = 0u; mine = 0u;
#pragma unroll
        for (unsigned j = 0; j < 16; ++j) { const unsigned c = xb_ld(&bar[XB_XCNT(j)]); sum += c; cnt += (c > 0u) ? 1u : 0u; mine = (j == x) ? c : mine; }
        if (sum == G) break;
        __builtin_amdgcn_s_sleep(1);
        if ((++sp & 255u) == 0u) { if (xb_ld(&bar[XB_TMO])) break; if (sp > XB_SPIN_CAP) { atomicAdd(&bar[XB_TMO], 1u); break; } }
    }
    nloc = mine > 0u ? mine : 1u; nx = cnt > 0u ? cnt : 1u;
}
__device__ __forceinline__ void xcd_barrier(const XcdBarrier& b, int wave) {
    asm volatile("s_waitcnt vmcnt(0)" ::: "memory");
    __syncthreads();
    if (fresh_tid(wave) == 0) {
        unsigned* bar = b.bar; asm volatile("" : "+s"(bar));
        __builtin_amdgcn_s_waitcnt(0);
        unsigned nloc = b.st[0], nx = b.st[1];
        if (nloc == 0u) { xcd_barrier_complete(bar, b.x, b.G, nloc, nx); b.st[0] = nloc; b.st[1] = nx; }
        const unsigned old = xb_add(&bar[XB_XSUB(b.x)], 1u);
        const unsigned gen = old / nloc;
        if (old + 1u == (gen + 1u) * nloc) {
            __builtin_amdgcn_fence(__ATOMIC_RELEASE, "agent");
            asm volatile("s_waitcnt vmcnt(0)" ::: "memory");
            if (nx > 1u) {
            const unsigned og = xb_add(&bar[XB_TOP], 1u);
            const unsigned tg = og / nx;
            if (og + 1u == (tg + 1u) * nx) xb_add(&bar[XB_TOPGEN], 1u);
            else XB_SPIN(xb_ld(&bar[XB_TOPGEN]) == tg, bar);
            }
            xb_add(&bar[XB_XGEN(b.x)], 1u);
            __builtin_amdgcn_fence(__ATOMIC_ACQUIRE, "agent");
            asm volatile("s_waitcnt vmcnt(0)" ::: "memory");
        } else {
            XB_SPIN(xb_ld(&bar[XB_XGEN(b.x)]) == gen, bar);
            __builtin_amdgcn_fence(__ATOMIC_ACQUIRE, "agent");
            asm volatile("s_waitcnt vmcnt(0)" ::: "memory");
        }
    }
    __syncthreads();
}

struct Frame {
    LAS unsigned char* lds;
    volatile LAS unsigned* MISC;
    gu32* ctl;
    int tid, lane, wave;
    int vcu, G;
    unsigned char* ws;
    float* out;
};
struct Args { const float* in[20]; float* out; unsigned char* ws; int ph_lo, ph_hi; };
typedef const __attribute__((address_space(4))) Args* KArgs;
__device__ __forceinline__ KArgs kargs() { KArgs p = (KArgs)__builtin_amdgcn_kernarg_segment_ptr(); asm volatile("" : "+s"(p)); return p; }
enum { IN_X = 0, IN_RELB, IN_F1N, IN_F1GU, IN_F1DN, IN_MIXN, IN_WIN, IN_QN, IN_KVN, IN_CONVW, IN_CONVB, IN_IGB, IN_FGB, IN_MON, IN_WAO, IN_WMO, IN_WOUT, IN_F2N, IN_F2GU, IN_F2DN };

template <class SrcMap>
__device__ __forceinline__ void transpose_item(const float* W, int K, int Nsrc, bf16* WT, LAS unsigned* scr, int kb, int db, int lane, const SrcMap& src, const float* gk) {
    const int k0 = 64 * kb, d0 = 64 * db, nq = lane & 15, kq2 = lane >> 4; const int sc = src(d0 + 4 * nq);
    f32x4 v[16];
    const float* wp = W + (size_t)(k0 + 2 * kq2) * Nsrc + (sc >= 0 ? sc : 0);
#pragma unroll
    for (int i = 0; i < 8; ++i) { v[2 * i] = *(const GAS f32x4*)(wp + (size_t)(8 * i) * Nsrc); v[2 * i + 1] = *(const GAS f32x4*)(wp + (size_t)(8 * i + 1) * Nsrc); }
    if (sc < 0) {
#pragma unroll
        for (int i = 0; i < 16; ++i) v[i] = (f32x4){0.f, 0.f, 0.f, 0.f}; }
    if (gk) {
#pragma unroll
        for (int i = 0; i < 8; ++i) { const f32x2 g2 = *(const GAS f32x2*)(gk + k0 + 2 * kq2 + 8 * i); v[2 * i] = v[2 * i] * g2.x; v[2 * i + 1] = v[2 * i + 1] * g2.y; } }
#pragma unroll
    for (int i = 0; i < 8; ++i)
#pragma unroll
        for (int j = 0; j < 4; ++j) scr[(4 * nq + j) * 33 + 4 * i + kq2] = pk2(v[2 * i][j], v[2 * i + 1][j]);
    LDS_WAIT(); asm volatile("" ::: "memory");
    const int c = lane & 7;
#pragma unroll
    for (int r = 0; r < 8; ++r) { const int nn = 8 * r + (lane >> 3); const LAS unsigned* s = scr + nn * 33 + 4 * c;
        v4u o; o.x = s[0]; o.y = s[1]; o.z = s[2]; o.w = s[3];
        *(GAS v4u*)(WT + (size_t)(d0 + nn) * K + k0 + 8 * c) = o; }
    LDS_WAIT(); asm volatile("" ::: "memory");
}
struct SrcIdent { __device__ __forceinline__ int operator()(int d) const { return d; } };
struct SrcGU { __device__ __forceinline__ int operator()(int d) const { return gu_src_of_dest(d); } };
struct SrcWin { __device__ __forceinline__ int operator()(int d) const { return win_src_of_dest(d); } };

template <class SrcMap>
__device__ __forceinline__ void transpose_matrix(Frame& F, const float* W, int K, int Nsrc, int Ndst, bf16* WT, const SrcMap& src, const float* gk = nullptr) {
    const int lane_ = fresh_tid(F.wave) & 63;
    LAS unsigned* scr = (LAS unsigned*)(F.lds + RING_OFF + F.wave * 16384);
    const int gw = F.vcu * NWAVES + F.wave, NGW = F.G * NWAVES;
    const int nkb = K / 64, ndb = Ndst / 64, nit = nkb * ndb;
    for (int it = gw; it < nit; it += NGW) { const int kb = it / ndb, db = it % ndb; transpose_item(W, K, Nsrc, WT, scr, kb, db, lane_, src, gk); }
}
constexpr int CV_GU = (D / 64) * (FF2 / 64), CV_DN = (FF / 64) * (D / 64), CV_IN = (D / 64) * (DINP / 64), CV_AO = (D / 64) * (D / 64), CV_MO = (1024 / 64) * (D / 64), CV_WO = CV_AO;
constexpr int CV_ITEMS = 2 * CV_GU + 2 * CV_DN + CV_IN + CV_AO + CV_MO + CV_WO;
static_assert(CV_ITEMS % 8 == 0, "conversion items are dealt eight (one per wave) at a time");
__device__ __forceinline__ void convert_item(Frame& F, int l, int item, int lane) {
    LAS unsigned* scr = (LAS unsigned*)(F.lds + RING_OFF + F.wave * 16384);
    unsigned char* wl = F.ws + WS_W + (size_t)l * LAYER_W;
    int r = item;
    if (r < CV_GU) { constexpr int ndb = FF2 / 64; transpose_item(kargs()->in[IN_F1GU] + (size_t)l * D * FF2, D, FF2, (bf16*)(wl + OW_GU1), scr, r / ndb, r % ndb, lane, SrcGU(), kargs()->in[IN_F1N] + (size_t)l * D); return; } r -= CV_GU;
    if (r < CV_DN) { constexpr int ndb = D / 64; transpose_item(kargs()->in[IN_F1DN] + (size_t)l * FF * D, FF, D, (bf16*)(wl + OW_DN1), scr, r / ndb, r % ndb, lane, SrcIdent(), nullptr); return; } r -= CV_DN;
    if (r < CV_IN) { constexpr int ndb = DINP / 64; transpose_item(kargs()->in[IN_WIN] + (size_t)l * D * DIN, D, DIN, (bf16*)(wl + OW_IN), scr, r / ndb, r % ndb, lane, SrcWin(), kargs()->in[IN_MIXN] + (size_t)l * D); return; } r -= CV_IN;
    if (r < CV_AO) { constexpr int ndb = D / 64; transpose_item(kargs()->in[IN_WAO] + (size_t)l * D * D, D, D, (bf16*)(wl + OW_AO), scr, r / ndb, r % ndb, lane, SrcIdent(), nullptr); return; } r -= CV_AO;
    if (r < CV_MO) { constexpr int ndb = D / 64; transpose_item(kargs()->in[IN_WMO] + (size_t)l * 1024 * D, 1024, D, (bf16*)(wl + OW_MO), scr, r / ndb, r % ndb, lane, SrcIdent(), nullptr); return; } r -= CV_MO;
    if (r < CV_WO) { constexpr int ndb = D / 64; transpose_item(kargs()->in[IN_WOUT] + (size_t)l * D * D, D, D, (bf16*)(wl + OW_WO), scr, r / ndb, r % ndb, lane, SrcIdent(), nullptr); return; } r -= CV_WO;
    if (r < CV_GU) { constexpr int ndb = FF2 / 64; transpose_item(kargs()->in[IN_F2GU] + (size_t)l * D * FF2, D, FF2, (bf16*)(wl + OW_GU2), scr, r / ndb, r % ndb, lane, SrcGU(), kargs()->in[IN_F2N] + (size_t)l * D); return; } r -= CV_GU;
    { constexpr int ndb = D / 64; transpose_item(kargs()->in[IN_F2DN] + (size_t)l * FF * D, FF, D, (bf16*)(wl + OW_DN2), scr, r / ndb, r % ndb, lane, SrcIdent(), nullptr); }
}
struct CvItem { const float* wp; const float* gk; bf16* out; int Nsrc, K, sc; };
template <class SrcMap>
__device__ __forceinline__ CvItem cv_make(const float* W, int K, int Nsrc, bf16* WT, int kb, int db, int lane, const SrcMap& src, const float* gk) {
    const int k0 = 64 * kb, d0 = 64 * db, nq = lane & 15, kq2 = lane >> 4; const int sc = src(d0 + 4 * nq);
    CvItem it; it.wp = W + (size_t)(k0 + 2 * kq2) * Nsrc + (sc >= 0 ? sc : 0); it.gk = gk ? gk + k0 + 2 * kq2 : nullptr; it.out = WT + (size_t)d0 * K + k0; it.Nsrc = Nsrc; it.K = K; it.sc = sc; return it;
}
__device__ __forceinline__ CvItem cv_item(Frame& F, int l, int item, int lane) {
    unsigned char* wl = F.ws + WS_W + (size_t)l * LAYER_W;
    int r = item;
    if (r < CV_GU) { constexpr int ndb = FF2 / 64; return cv_make(kargs()->in[IN_F1GU] + (size_t)l * D * FF2, D, FF2, (bf16*)(wl + OW_GU1), r / ndb, r % ndb, lane, SrcGU(), kargs()->in[IN_F1N] + (size_t)l * D); } r -= CV_GU;
    if (r < CV_DN) { constexpr int ndb = D / 64; return cv_make(kargs()->in[IN_F1DN] + (size_t)l * FF * D, FF, D, (bf16*)(wl + OW_DN1), r / ndb, r % ndb, lane, SrcIdent(), nullptr); } r -= CV_DN;
    if (r < CV_IN) { constexpr int ndb = DINP / 64; return cv_make(kargs()->in[IN_WIN] + (size_t)l * D * DIN, D, DIN, (bf16*)(wl + OW_IN), r / ndb, r % ndb, lane, SrcWin(), kargs()->in[IN_MIXN] + (size_t)l * D); } r -= CV_IN;
    if (r < CV_AO) { constexpr int ndb = D / 64; return cv_make(kargs()->in[IN_WAO] + (size_t)l * D * D, D, D, (bf16*)(wl + OW_AO), r / ndb, r % ndb, lane, SrcIdent(), nullptr); } r -= CV_AO;
    if (r < CV_MO) { constexpr int ndb = D / 64; return cv_make(kargs()->in[IN_WMO] + (size_t)l * 1024 * D, 1024, D, (bf16*)(wl + OW_MO), r / ndb, r % ndb, lane, SrcIdent(), nullptr); } r -= CV_MO;
    if (r < CV_WO) { constexpr int ndb = D / 64; return cv_make(kargs()->in[IN_WOUT] + (size_t)l * D * D, D, D, (bf16*)(wl + OW_WO), r / ndb, r % ndb, lane, SrcIdent(), nullptr); } r -= CV_WO;
    if (r < CV_GU) { constexpr int ndb = FF2 / 64; return cv_make(kargs()->in[IN_F2GU] + (size_t)l * D * FF2, D, FF2, (bf16*)(wl + OW_GU2), r / ndb, r % ndb, lane, SrcGU(), kargs()->in[IN_F2N] + (size_t)l * D); } r -= CV_GU;
    { constexpr int ndb = D / 64; return cv_make(kargs()->in[IN_F2DN] + (size_t)l * FF * D, FF, D, (bf16*)(wl + OW_DN2), r / ndb, r % ndb, lane, SrcIdent(), nullptr); }
}
__device__ __forceinline__ void cv_load(const CvItem& it, f32x4 (&v)[16]) {
#pragma unroll
    for (int i = 0; i < 8; ++i) { v[2 * i] = *(const GAS f32x4*)(it.wp + (size_t)(8 * i) * it.Nsrc); v[2 * i + 1] = *(const GAS f32x4*)(it.wp + (size_t)(8 * i + 1) * it.Nsrc); }
}
__device__ __forceinline__ void cv_finish(const CvItem& it, f32x4 (&v)[16], LAS unsigned* scr, int lane) {
    const int nq = lane & 15, kq2 = lane >> 4;
    if (it.sc < 0) {
#pragma unroll
        for (int i = 0; i < 16; ++i) v[i] = (f32x4){0.f, 0.f, 0.f, 0.f}; }
    if (it.gk) {
#pragma unroll
        for (int i = 0; i < 8; ++i) { const f32x2 g2 = *(const GAS f32x2*)(it.gk + 8 * i); v[2 * i] = v[2 * i] * g2.x; v[2 * i + 1] = v[2 * i + 1] * g2.y; } }
#pragma unroll
    for (int i = 0; i < 8; ++i)
#pragma unroll
        for (int j = 0; j < 4; ++j) scr[(4 * nq + j) * 33 + 4 * i + kq2] = pk2(v[2 * i][j], v[2 * i + 1][j]);
    LDS_WAIT(); asm volatile("" ::: "memory");
    const int c = lane & 7;
#pragma unroll
    for (int r = 0; r < 8; ++r) { const int nn = 8 * r + (lane >> 3); const LAS unsigned* s = scr + nn * 33 + 4 * c;
        v4u o; o.x = s[0]; o.y = s[1]; o.z = s[2]; o.w = s[3];
        *(GAS v4u*)(it.out + (size_t)nn * it.K + 8 * c) = o; }
    LDS_WAIT(); asm volatile("" ::: "memory");
}
__device__ __forceinline__ void p_prologue(Frame& F) {
    const int lane_ = fresh_tid(F.wave) & 63;
    const int gw = F.vcu * NWAVES + F.wave, NGW = F.G * NWAVES;
    for (int it = gw; it < CV_ITEMS; it += NGW) convert_item(F, 0, it, lane_);
}

__device__ __forceinline__ void p_xprep(Frame& F_, const float* h, bf16* hb, float* ssq) {
    Frame F = F_; F.lane = fresh_tid(F.wave) & 63;
    const int gw = F.vcu * NWAVES + F.wave, NGW = F.G * NWAVES;
    for (int m = gw; m < M; m += NGW) {
        const GAS f32x4* xr = (const GAS f32x4*)(h + (size_t)m * D) + F.lane;
        f32x4 v[8]; float s = 0.f;
#pragma unroll
        for (int j = 0; j < 8; ++j) { v[j] = xr[64 * j]; s += (v[j].x * v[j].x + v[j].y * v[j].y) + (v[j].z * v[j].z + v[j].w * v[j].w); }
        s = wave_sum(s); if (F.lane < 32) ssq[(size_t)m * 32 + F.lane] = (F.lane == 0) ? s : 0.f;
        GAS v2u* o8 = (GAS v2u*)(hb + (size_t)m * D) + F.lane;
#pragma unroll
        for (int j = 0; j < 8; ++j) { v2u o; o.x = pk2(v[j].x, v[j].y); o.y = pk2(v[j].z, v[j].w); o8[64 * j] = o; }
    }
}

__device__ __forceinline__ void p_prep(Frame& F, int l) {
    const int lane = fresh_tid(F.wave) & 63;
    const int gw = F.vcu * NWAVES + F.wave, NGW = F.G * NWAVES;
    bf16* proj = (bf16*)(F.ws + WS_PROJ); bf16* mqk = (bf16*)(F.ws + WS_MQK);
    const float* qg = kargs()->in[IN_QN] + l * RK; const float* kg = kargs()->in[IN_KVN] + l * RK;
    const float* cw = kargs()->in[IN_CONVW] + (size_t)l * 4 * 1024; const float* cb = kargs()->in[IN_CONVB] + (size_t)l * 1024;
    const f32x4 qgv = *((const GAS f32x4*)qg + lane), kgv = *((const GAS f32x4*)kg + lane);
    float w[4][16], cbv[16];
#pragma unroll
    for (int k = 0; k < 4; ++k)
#pragma unroll
        for (int q = 0; q < 4; ++q) { const f32x4 t = *((const GAS f32x4*)(cw + k * 1024 + 16 * lane) + q); w[k][4 * q] = t.x; w[k][4 * q + 1] = t.y; w[k][4 * q + 2] = t.z; w[k][4 * q + 3] = t.w; }
#pragma unroll
    for (int q = 0; q < 4; ++q) { const f32x4 t = *((const GAS f32x4*)(cb + 16 * lane) + q); cbv[4 * q] = t.x; cbv[4 * q + 1] = t.y; cbv[4 * q + 2] = t.z; cbv[4 * q + 3] = t.w; }
    const float kscale = (lane >= 32) ? 0.08838834764831845f : 1.0f;
    for (int j8 = 0; j8 < 8; ++j8) { const int m = (gw >> 8) * SEQ + (gw & 255) + 256 * j8;
        bf16* row = proj + (size_t)m * DINP;
        const int t = m % SEQ;
        float acc[16];
#pragma unroll
        for (int i = 0; i < 16; ++i) acc[i] = cbv[i];
#pragma unroll
        for (int k = 0; k < 4; ++k) { const int tt = t - 3 + k;
            if (tt >= 0) { const GAS v4u* p = (const GAS v4u*)(proj + (size_t)(m - 3 + k) * DINP + P_MQK + 16 * lane); const v4u x0 = p[0], x1 = p[1];
                const unsigned xs[8] = {x0.x, x0.y, x0.z, x0.w, x1.x, x1.y, x1.z, x1.w};
#pragma unroll
                for (int i = 0; i < 8; ++i) { acc[2 * i] += w[k][2 * i] * bflo(xs[i]); acc[2 * i + 1] += w[k][2 * i + 1] * bfhi(xs[i]); } } }
        v4u o0, o1;
#pragma unroll
        for (int i = 0; i < 16; ++i) acc[i] = silu_f(acc[i]) * kscale;
        o0.x = pk2(acc[0], acc[1]); o0.y = pk2(acc[2], acc[3]); o0.z = pk2(acc[4], acc[5]); o0.w = pk2(acc[6], acc[7]);
        o1.x = pk2(acc[8], acc[9]); o1.y = pk2(acc[10], acc[11]); o1.z = pk2(acc[12], acc[13]); o1.w = pk2(acc[14], acc[15]);
        GAS v4u* po = (GAS v4u*)(mqk + (size_t)m * 1024 + 16 * lane); po[0] = o0; po[1] = o1;
    }
}

__device__ __forceinline__ void p_mpost(Frame& F, int l) {
    const int lane = fresh_tid(F.wave) & 63;
    const int gw = F.vcu * NWAVES + F.wave, NGW = F.G * NWAVES;
    const bf16* proj = (const bf16*)(F.ws + WS_PROJ); const bf16* hraw = (const bf16*)(F.ws + WS_HRAW); bf16* hm = (bf16*)(F.ws + WS_HM);
    const float* gn = kargs()->in[IN_MON] + (size_t)l * MH * DV;
    for (int j8 = 0; j8 < 8; ++j8) { const int m = (gw >> 8) * SEQ + (gw & 255) + 256 * j8;
#pragma unroll
        for (int hh = 0; hh < MH; ++hh) {
            const v2u x = *((const GAS v2u*)(hraw + (size_t)m * 1024 + hh * DV) + lane);
            const v2u og = *((const GAS v2u*)(proj + (size_t)m * DINP + P_MO + hh * DV) + lane);
            const f32x4 g = *((const GAS f32x4*)(gn + hh * DV) + lane);
            const float a = bflo(x.x), b = bfhi(x.x), c = bflo(x.y), d = bfhi(x.y);
            const float rstd = 1.0f / sqrtf(wave_sum(a * a + b * b + c * c + d * d) * (1.f / DV) + EPS);
            v2u o; o.x = pk2(a * rstd * g.x * sigm_f(bflo(og.x)), b * rstd * g.y * sigm_f(bfhi(og.x))); o.y = pk2(c * rstd * g.z * sigm_f(bflo(og.y)), d * rstd * g.w * sigm_f(bfhi(og.y)));
            *((GAS v2u*)(hm + (size_t)m * 1024 + hh * DV) + lane) = o;
        }
    }
}

#ifndef ATPROBE
#define ATPROBE 0
#endif
#ifndef ATDSEL
#define ATDSEL 7
#endif
#ifndef ATNT1
#define ATNT1 0
#endif
#ifndef ATNODMA
#define ATNODMA 0
#endif
#ifndef ATNOBAR
#define ATNOBAR 0
#endif
#ifndef ATP1
#define ATP1 1
#endif
#ifndef ATP1B
#define ATP1B 1
#endif
#ifndef ATP2
#define ATP2 1
#endif
constexpr int AT_SC = 0, AT_KV = 0, AT_KVBUF = 16384, AT_NBUF = 8;
constexpr int AT_MASK = 131072 + 512, AT_BIAS = AT_MASK + 4096, AT_THR = AT_BIAS + 4160;
static_assert(AT_THR + 256 <= LDS_BYTES, "attention LDS");
typedef short v4i16_t __attribute__((ext_vector_type(4)));
__device__ __forceinline__ bf16x8 lds_rd128(const LAS unsigned char* p) { return *(const LAS bf16x8*)p; }
__device__ __forceinline__ v4i16_t lds_tr64(const LAS unsigned char* p) { return __builtin_amdgcn_ds_read_tr16_b64_v4i16((LAS v4i16_t*)p); }
#define MFMA16(a, b, c) __builtin_amdgcn_mfma_f32_16x16x32_bf16((a), (b), (c), 0, 0, 0)

#define AT_CNT4(n_, c_, k0_, k1_, k2_, k3_) do { unsigned long long t0_, t1_, t2_, t3_; \
    asm volatile("v_cmp_le_u32_e64 %1, %5, %6\n\tv_cmp_le_u32_e64 %2, %5, %7\n\tv_cmp_le_u32_e64 %3, %5, %8\n\tv_cmp_le_u32_e64 %4, %5, %9\n\t" \
                 "v_addc_co_u32_e64 %0, %1, 0, %0, %1\n\tv_addc_co_u32_e64 %0, %2, 0, %0, %2\n\tv_addc_co_u32_e64 %0, %3, 0, %0, %3\n\tv_addc_co_u32_e64 %0, %4, 0, %0, %4" \
                 : "+v"(n_), "=&s"(t0_), "=&s"(t1_), "=&s"(t2_), "=&s"(t3_) : "s"(c_), "v"(k0_), "v"(k1_), "v"(k2_), "v"(k3_)); } while (0)
template <bool DUMMY> __device__ __forceinline__ void attn_unit(Frame& F, int b, int qb, int tid_in) {
    int tid = tid_in; asm volatile("" : "+v"(tid));
    int lane = tid & 63, w = __builtin_amdgcn_readfirstlane(tid >> 6), g = lane >> 4, n = lane & 15;
    bf16* proj = (bf16*)(F.ws + WS_PROJ);
    const int t0 = qb * 16; const size_t rowb = (size_t)b * SEQ;
    LAS unsigned char* L = F.lds;
    LAS unsigned* SC = (LAS unsigned*)(L + AT_SC); LAS unsigned* MASK = (LAS unsigned*)(L + AT_MASK); const LAS float* BIAS = (const LAS float*)(L + AT_BIAS);
    if (!DUMMY || (ATDSEL & 1)) {
        bf16x8 Aq[4][2][2];
#pragma unroll
        for (int p = 0; p < 4; ++p)
#pragma unroll
            for (int j = 0; j < 2; ++j)
#pragma unroll
                for (int ks = 0; ks < 2; ++ks) { const int q = 4 * p + (n >> 2), head = 4 * j + (n & 3);
                    Aq[p][j][ks] = *(const GAS bf16x8*)(proj + (rowb + t0 + q) * DINP + P_IQ + head * 64 + 32 * ks + 8 * g); }
        float wq[4][8];
#pragma unroll
        for (int p = 0; p < 4; ++p) { const v4u x = *(const GAS v4u*)(proj + (rowb + t0 + 4 * p + g) * DINP + P_IW); const unsigned xs[4] = {x.x, x.y, x.z, x.w};
#pragma unroll
          for (int i = 0; i < 4; ++i) { wq[p][2 * i] = bflo(xs[i]) * 0.044194173824159216f; wq[p][2 * i + 1] = bfhi(xs[i]) * 0.044194173824159216f; } }
        const bf16* kbase = proj + rowb * DINP + P_IK + 8 * g;
        bf16x8 Bc[4][2];
#define AT_LDB(dst, i0_) do { _Pragma("unroll") for (int k_ = 0; k_ < 4; ++k_) { int i_ = (i0_) + 8 * k_; i_ = i_ > qb ? qb : i_; \
            const GAS bf16x8* kp_ = (const GAS bf16x8*)(kbase + (size_t)(16 * i_ + n) * DINP); dst[k_][0] = kp_[0]; dst[k_][1] = kp_[4]; } } while (0)
        for (int i0 = w; i0 <= qb; i0 += 32) {
            AT_LDB(Bc, i0);
#pragma unroll
            for (int k = 0; k < 4; ++k) { const int i = i0 + 8 * k;
                if (i <= qb) {
                    const int key = 16 * i + n;
#pragma unroll
                    for (int p = 0; p < 4; ++p) {
                        f32x4 a0 = (f32x4){0.f, 0.f, 0.f, 0.f}, a1 = (f32x4){0.f, 0.f, 0.f, 0.f};
                        a0 = MFMA16(Aq[p][0][0], Bc[k][0], a0); a0 = MFMA16(Aq[p][0][1], Bc[k][1], a0);
                        a1 = MFMA16(Aq[p][1][0], Bc[k][0], a1); a1 = MFMA16(Aq[p][1][1], Bc[k][1], a1);
                        float sc = 0.f;
#pragma unroll
                        for (int e = 0; e < 4; ++e) { sc += wq[p][e] * fmaxf(a0[e], 0.f); sc += wq[p][4 + e] * fmaxf(a1[e], 0.f); }
                        SC[(4 * p + g) * 2048 + key] = (key <= t0 + 4 * p + g) ? sortable_key(sc + 0.0f) : 0u;
                    }
                } }
        }
#undef AT_LDB
    }
    LDS_WAIT(); __syncthreads();
    asm volatile("" : "+v"(tid)); lane = tid & 63; g = lane >> 4; n = lane & 15;
    bf16x8 Qf[8]; const bf16* lsrc; unsigned ldsw0;
    const int nt32 = (DUMMY && ATNT1) ? 1 : (qb >> 1) + 1;
#define AT_GLDS(gsrc_, dst_) do { unsigned keep_; asm volatile("s_mov_b32 %0, m0\n\ts_mov_b32 m0, %2\n\ts_nop 0\n\tglobal_load_lds_dwordx4 %1, off\n\ts_mov_b32 m0, %0" : "=&s"(keep_) : "v"(gsrc_), "s"(dst_) : "memory"); } while (0)
#define AT_LOAD(it_, buf_) do { const bf16* s_ = lsrc + (size_t)(it_) * 32 * DINP; const unsigned d_ = (unsigned)__builtin_amdgcn_readfirstlane(ldsw0 + (unsigned)(buf_) * AT_KVBUF); \
        AT_GLDS(s_, d_); AT_GLDS(s_ + 128, d_ + 8192u); } while (0)
#define AT_TILE(i_) ((i_) < nt32 ? (i_) : nt32 - 1)
#define AT_RING_START() do { { const bf16* qr_ = proj + (rowb + t0 + 2 * w + (n >> 3)) * DINP + P_AQ + (n & 7) * RK; _Pragma("unroll") for (int ks = 0; ks < 8; ++ks) Qf[ks] = *(const GAS bf16x8*)(qr_ + 32 * ks + 8 * g); } \
        const int lrow_ = 8 * (w >> 1) + ((lane >> 2) & 7), lch_ = 4 * (((w & 1) << 1) | (lane >> 5)) + ((lane & 3) ^ ((lrow_ >> 2) & 3)); \
        lsrc = proj + (rowb + lrow_) * DINP + P_CKV + lch_ * 8; ldsw0 = (unsigned)(size_t)(L + AT_KV) + (unsigned)w * 1024u; \
        _Pragma("unroll") for (int i = 0; i < 7; ++i) if (!(DUMMY && ATNODMA)) AT_LOAD(AT_TILE(i), i); } while (0)
    if (!DUMMY || (ATDSEL & 2)) {
        const bool all = (t0 + 16 <= TOPK);
        const unsigned long long lt_mask = (lane == 0) ? 0ull : (~0ull >> (64 - lane));
        const int jn = (t0 + 16 + 63) >> 6;
        const int qa = 2 * w, ta = t0 + qa, tb_ = ta + 1;
        unsigned ka[32], kb2[32];
#pragma unroll
        for (int j = 0; j < 32; ++j) { const int s = lane + 64 * j; ka[j] = (j < jn && s <= ta) ? SC[qa * 2048 + s] : 0u; kb2[j] = (j < jn && s <= tb_) ? SC[(qa + 1) * 2048 + s] : 0u; }
        LDS_WAIT(); __syncthreads();
        if (!DUMMY || (ATDSEL & 4)) AT_RING_START();
        unsigned Ta = 0u, Tb = 0u; bool exa = false, exb = false;
        if (!all) {
            for (int bit = 31; bit >= 0 && !(exa && exb); --bit) {
                const unsigned ca = Ta | (1u << bit), cb = Tb | (1u << bit); int na = 0, nb = 0;
#pragma unroll
                for (int c8 = 0; c8 < 4; ++c8) if (8 * c8 < jn) {
#pragma unroll
                    for (int j = 8 * c8; j < 8 * c8 + 8; j += 4) { AT_CNT4(na, ca, ka[j], ka[j + 1], ka[j + 2], ka[j + 3]); AT_CNT4(nb, cb, kb2[j], kb2[j + 1], kb2[j + 2], kb2[j + 3]); } }
                na = wave_sum_dpp(na); nb = wave_sum_dpp(nb);
                if (!exa) { if (na >= TOPK) Ta = ca; exa = (na == TOPK); }
                if (!exb) { if (nb >= TOPK) Tb = cb; exb = (nb == TOPK); }
            }
        }
#pragma unroll
        for (int qq = 0; qq < 2; ++qq) {
            const int q = qa + qq, t = t0 + q; const unsigned T = qq ? Tb : Ta; const bool ex = qq ? exb : exa;
            int need_eq = 0;
            if (!all && !ex) { int cg = 0;
#pragma unroll
                for (int j = 0; j < 32; ++j) cg += ((qq ? kb2[j] : ka[j]) > T) ? 1 : 0;
                need_eq = TOPK - wave_sum_dpp(cg); }
            int eq_seen = 0;
#pragma unroll
            for (int j = 0; j < 32; ++j) {
                const int s = lane + 64 * j; const unsigned kk = qq ? kb2[j] : ka[j]; bool sel;
                if (all) sel = (s <= t);
                else if (ex) sel = (kk >= T);
                else { const bool eq = (kk == T); const unsigned long long em = __ballot(eq); const int rank = eq_seen + __popcll(em & lt_mask); sel = (kk > T) || (eq && rank < need_eq); eq_seen += __popcll(em); }
                const unsigned long long sm = __ballot(sel);
                if (lane == 0) { MASK[q * 64 + 2 * j] = (unsigned)sm; MASK[q * 64 + 2 * j + 1] = (unsigned)(sm >> 32); }
            }
        }
    }
    LDS_WAIT(); __syncthreads();
    asm volatile("" : "+v"(tid)); lane = tid & 63; g = lane >> 4; n = lane & 15;
    if (!DUMMY || (ATDSEL & 4)) {
        const int q = 2 * w + (n >> 3), hh = n & 7, t = t0 + q;
        bf16* qrow = proj + (rowb + t) * DINP + P_AQ + hh * RK;
        if (DUMMY && !(ATDSEL & 2)) AT_RING_START();
        f32x4 O[16]; f32x4 OL = (f32x4){0.f, 0.f, 0.f, 0.f};
        const float b31 = BIAS[128 * 8 + hh];
        int rbase[2], tbase[2][2];
#pragma unroll
        for (int tt = 0; tt < 2; ++tt) { const int row = 8 * (n >> 2) + 4 * tt + (n & 3); rbase[tt] = 2048 * (row >> 3) + 64 * (row & 7) + 16 * (g ^ ((row >> 2) & 3)); }
#pragma unroll
        for (int tt = 0; tt < 2; ++tt)
#pragma unroll
            for (int od = 0; od < 2; ++od) { const int qq = n >> 2, p = n & 3; const int x = (((od ^ (g & 1)) << 1) | ((p >> 1) ^ tt));
                tbase[tt][od] = 2048 * g + 64 * (4 * tt + qq) + 16 * x + 8 * (p & 1); }
        {
#pragma unroll
        for (int mt = 0; mt < 16; ++mt) O[mt] = (f32x4){0.f, 0.f, 0.f, 0.f};
        asm volatile("s_waitcnt vmcnt(12)" ::: "memory"); __syncthreads();
        bf16x8 fa[2][8]; f32x4 sa[2], cin[2]; v4i16_t va[8][2], vb[8][2]; unsigned bitsw; bf16x8 Pf;
        const bf16x8 ONES = (bf16x8){0x3F80, 0x3F80, 0x3F80, 0x3F80, 0x3F80, 0x3F80, 0x3F80, 0x3F80};
        const unsigned b31u = __builtin_bit_cast(unsigned, b31);
#define AT_CINIT(i_) do { const unsigned bits_ = bitsw >> (8 * g); \
            if ((t0 - (32 * (i_) + 31)) >= 128) { \
                _Pragma("unroll") for (int j = 0; j < 8; ++j) { const unsigned m_ = (unsigned)__builtin_amdgcn_sbfe((int)bits_, j, 1); cin[j >> 2][j & 3] = __builtin_bit_cast(float, (m_ & b31u) | (~m_ & 0xF149F2CAu)); } \
            } else { const int kb = 32 * (i_) + 8 * g; \
                _Pragma("unroll") for (int j = 0; j < 8; ++j) { int dist = t - (kb + j); dist = dist < 0 ? 0 : (dist > 128 ? 128 : dist); const unsigned bv_ = __builtin_bit_cast(unsigned, BIAS[dist * 8 + hh]); \
                    const unsigned m_ = (unsigned)__builtin_amdgcn_sbfe((int)bits_, j, 1); cin[j >> 2][j & 3] = __builtin_bit_cast(float, (m_ & bv_) | (~m_ & 0xF149F2CAu)); } } } while (0)
#define AT_FA(tt_, b_) do { _Pragma("unroll") for (int ks = 0; ks < 8; ++ks) fa[tt_][ks] = lds_rd128((b_) + rbase[tt_] + (ks >> 2) * 8192 + 512 * (ks & 3)); } while (0)
#define AT_S(tt_) do { asm volatile("" : "+v"(fa[tt_][0]), "+v"(fa[tt_][1]), "+v"(fa[tt_][2]), "+v"(fa[tt_][3]), "+v"(fa[tt_][4]), "+v"(fa[tt_][5]), "+v"(fa[tt_][6]), "+v"(fa[tt_][7]));        \
            sa[tt_] = cin[tt_]; _Pragma("unroll") for (int ks = 0; ks < 8; ++ks) sa[tt_] = MFMA16(fa[tt_][ks], Qf[ks], sa[tt_]); } while (0)
#define AT_TR(b_) do { _Pragma("unroll") for (int mt = 0; mt < 8; ++mt) { const int off = 512 * (mt >> 1); va[mt][0] = lds_tr64((b_) + tbase[0][mt & 1] + off); va[mt][1] = lds_tr64((b_) + tbase[1][mt & 1] + off); } \
            _Pragma("unroll") for (int mt = 0; mt < 8; ++mt) { const int off = 8192 + 512 * (mt >> 1); vb[mt][0] = lds_tr64((b_) + tbase[0][mt & 1] + off); vb[mt][1] = lds_tr64((b_) + tbase[1][mt & 1] + off); } } while (0)
#define AT_SOFTMAX(i_) do { v4u pw; pw.x = pk2(__builtin_amdgcn_exp2f(sa[0][0]), __builtin_amdgcn_exp2f(sa[0][1])); pw.y = pk2(__builtin_amdgcn_exp2f(sa[0][2]), __builtin_amdgcn_exp2f(sa[0][3])); \
            pw.z = pk2(__builtin_amdgcn_exp2f(sa[1][0]), __builtin_amdgcn_exp2f(sa[1][1])); pw.w = pk2(__builtin_amdgcn_exp2f(sa[1][2]), __builtin_amdgcn_exp2f(sa[1][3])); Pf = __builtin_bit_cast(bf16x8, pw); } while (0)
#define AT_PV(vx_, o0_) do { _Pragma("unroll") for (int mt = 0; mt < 8; ++mt) { const bf16x8 a = (bf16x8){vx_[mt][0][0], vx_[mt][0][1], vx_[mt][0][2], vx_[mt][0][3], vx_[mt][1][0], vx_[mt][1][1], vx_[mt][1][2], vx_[mt][1][3]}; \
            O[(o0_) + mt] = MFMA16(a, Pf, O[(o0_) + mt]); } } while (0)
#define AT_SB() __builtin_amdgcn_sched_barrier(0)
#define AT_LOOP(ROT_) do { AT_FA(0, L + AT_KV); AT_FA(1, L + AT_KV); bitsw = MASK[q * 64]; AT_SB(); AT_CINIT(0); AT_S(0); AT_S(1); AT_SB(); AT_TR(L + AT_KV); AT_SB(); if (!(ROT_)) { AT_SOFTMAX(0); AT_SB(); } \
        for (int it = 0; it < nt32; ++it) { \
            const LAS unsigned char* nbuf = L + AT_KV + ((it + 1) & 7) * AT_KVBUF; \
              \
            if (DUMMY && ATNOBAR) asm volatile("s_waitcnt vmcnt(10)" ::: "memory"); else if (ROT_) asm volatile("s_waitcnt vmcnt(10)\n\ts_barrier" ::: "memory"); else asm volatile("s_waitcnt vmcnt(10) lgkmcnt(0)\n\ts_barrier" ::: "memory"); \
            if (ROT_) { AT_SOFTMAX(it); AT_SB(); } \
            { const unsigned mw_ = MASK[q * 64 + it + 1]; bitsw = (it + 1 < nt32) ? mw_ : 0u; }        \
            if (!(DUMMY && ATNODMA)) AT_LOAD(AT_TILE(it + 7), (it + 7) & 7); \
            AT_FA(0, nbuf); AT_SB(); AT_PV(va, 0); OL = MFMA16(ONES, Pf, OL); AT_SB(); AT_CINIT(it + 1); AT_SB(); AT_FA(1, nbuf); AT_SB(); AT_S(0); AT_SB(); AT_PV(vb, 8); AT_SB(); AT_S(1); AT_SB(); \
            AT_TR(nbuf); AT_SB(); \
            if (!(ROT_)) { AT_SOFTMAX(it + 1); AT_SB(); } \
        } } while (0)
        if (w < 4) { asm volatile("; order A" ::: "memory"); AT_LOOP(false); } else { asm volatile("; order B" ::: "memory"); AT_LOOP(true); }
#undef AT_LOOP
#undef AT_FA
#undef AT_S
#undef AT_TR
#undef AT_SOFTMAX
#undef AT_CINIT
#undef AT_PV
#undef AT_SB
        asm volatile("s_waitcnt vmcnt(0)" ::: "memory"); __syncthreads();
        }
#undef AT_LOAD
#undef AT_GLDS
#undef AT_TILE
        const float inv = 1.0f / OL[0];
#pragma unroll
        for (int k = 0; k < 8; ++k) {
            unsigned ax = pk2(O[2 * k][0] * inv, O[2 * k][1] * inv), ay = pk2(O[2 * k][2] * inv, O[2 * k][3] * inv);
            unsigned bx = pk2(O[2 * k + 1][0] * inv, O[2 * k + 1][1] * inv), by = pk2(O[2 * k + 1][2] * inv, O[2 * k + 1][3] * inv);
            { const auto r_ = __builtin_amdgcn_permlane16_swap(ax, bx, false, false); ax = r_[0]; bx = r_[1]; }
            { const auto r_ = __builtin_amdgcn_permlane16_swap(ay, by, false, false); ay = r_[0]; by = r_[1]; }
            const v4u o = {ax, ay, bx, by};
            const int d0 = (g & 1) ? 32 * k + 16 + 4 * (g - 1) : 32 * k + 4 * g;
            if (DUMMY) *(GAS v4u*)((bf16*)(F.ws + WS_HM) + (rowb + t) * D + hh * RK + d0) = o; else *(GAS v4u*)(qrow + d0) = o; }
    }
    __syncthreads();
}
template <bool DUMMY> __device__ __forceinline__ void p_attn(Frame& F_, const float* relb) {
    Frame F = F_; const int tid = fresh_tid(F.wave);
    LAS float* BIAS = (LAS float*)(F.lds + AT_BIAS);
    for (int i = tid; i < 129 * 8; i += NWAVES * 64) { const int nn = i >> 3, hh = i & 7; BIAS[i] = relb[t5_bucket_dev(nn) * AH + hh] * 1.4426950408889634f; }
    __syncthreads();
    for (int k = 0; k < 4; ++k) { const int pi = 2 * F.vcu + (k >> 1); if (pi >= BATCH * 64) break; const int b = pi >> 6, x = pi & 63; attn_unit<DUMMY>(F, b, (k & 1) ? (127 - x) : x, tid); }
}

constexpr int ML_Q = 0, ML_K = 16384, ML_V = 32768, ML_VW = 49152, ML_P = 65536, ML_PSTR = 144, ML_BC = ML_P + 64 * ML_PSTR, ML_AV = ML_BC + 8192, ML_PM = ML_AV + 8192,
              ML_MST = ML_PM + 8192, ML_NV = ML_MST + 256, ML_DINV = ML_NV + 512, ML_END = ML_DINV + 256;
static_assert(ML_END <= RING_BYTES, "mLSTM LDS");
__device__ __forceinline__ int img_off(int row, int ch) { const int r = row & 31; return 8192 * (row >> 5) + 2048 * (r >> 3) + 512 * (ch >> 2) + 64 * (r & 7) + 16 * ((ch & 3) ^ ((r >> 2) & 3)); }

__device__ __forceinline__ void mlstm_unit(Frame& F, const float* igb_, const float* fgb_, int l, int b, int hh, int half, int tid) {
    const int lane = tid & 63, w = __builtin_amdgcn_readfirstlane(tid >> 6), g = lane >> 4, n = lane & 15;
    const bf16* proj = (const bf16*)(F.ws + WS_PROJ); const bf16* mqk = (const bf16*)(F.ws + WS_MQK); bf16* hraw = (bf16*)(F.ws + WS_HRAW);
    LAS unsigned char* L = F.lds;
    LAS float* BC = (LAS float*)(L + ML_BC); LAS float* AV = (LAS float*)(L + ML_AV); LAS float* PM = (LAS float*)(L + ML_PM); LAS float* MST = (LAS float*)(L + ML_MST);
    LAS float* NV = (LAS float*)(L + ML_NV); LAS float* DINV = (LAS float*)(L + ML_DINV);
    const size_t rowb = (size_t)b * SEQ;
    {
        const float igb = igb_[l * MH + hh], fgb = fgb_[l * MH + hh];
        for (int cc = 0; cc < 4; ++cc) { const int tok = (4 * w + cc) * 64 + lane;
            const float ig = bf2f(proj[(rowb + tok) * DINP + P_MI + hh]) + igb;
            const float fp = bf2f(proj[(rowb + tok) * DINP + P_MF + hh]) + fgb;
            const float lf = fminf(fp, 0.f) - log1pf(__expf(-fabsf(fp)));
            float bc = lf;
#pragma unroll
            for (int o = 1; o < 64; o <<= 1) { const float v = __shfl_up(bc, o); if (lane >= o) bc += v; }
            const float a = ig - bc; float pm = a;
#pragma unroll
            for (int o = 1; o < 64; o <<= 1) { const float v = __shfl_up(pm, o); if (lane >= o) pm = fmaxf(pm, v); }
            BC[tok] = bc; AV[tok] = a; PM[tok] = pm; }
        if (tid < 128) NV[tid] = 0.f;
        for (int i = tid; i < 64 * ML_PSTR / 4; i += 512) ((LAS unsigned*)(L + ML_P))[i] = 0u;
    }
    LDS_WAIT(); __syncthreads();
    if (tid == 0) { float m = 0.f; MST[0] = 0.f; for (int c = 0; c < NCHUNK; ++c) { m = BC[64 * c + 63] + fmaxf(m, PM[64 * c + 63]); MST[c + 1] = m; } }
    int ld_off[2]; const bf16* ld_q[2]; const bf16* ld_v[2];
#pragma unroll
    for (int i = 0; i < 2; ++i) { const int idx = tid + 512 * i, r = idx >> 4, ch = idx & 15; ld_off[i] = img_off(r, ch);
        ld_q[i] = mqk + (rowb + r) * 1024 + hh * DK + ch * 8; ld_v[i] = proj + (rowb + r) * DINP + P_MV + hh * DV + half * 128 + ch * 8; }
    const int rr_base = img_off(n, g);
    int tb[2][2];
#pragma unroll
    for (int tt = 0; tt < 2; ++tt)
#pragma unroll
        for (int od = 0; od < 2; ++od) { const int qq = n >> 2, p = n & 3; const int x = (((od ^ (g & 1)) << 1) | ((p >> 1) ^ tt)); tb[tt][od] = 2048 * g + 64 * (4 * tt + qq) + 16 * x + 8 * (p & 1); }
#define ML_TR(img, ks, c, tt) lds_tr64(L + (img) + 8192 * (ks) + 512 * ((c) >> 1) + tb[tt][(c) & 1])
    f32x4 Cacc[8];
#pragma unroll
    for (int mt = 0; mt < 8; ++mt) Cacc[mt] = (f32x4){0.f, 0.f, 0.f, 0.f};
    v4u rq[2], rk[2], rv[2];
#pragma unroll
    for (int i = 0; i < 2; ++i) { rq[i] = *(const GAS v4u*)(ld_q[i]); rk[i] = *(const GAS v4u*)(ld_q[i] + 512); rv[i] = *(const GAS v4u*)(ld_v[i]); }
    __syncthreads();
    for (int c = 0; c < NCHUNK; ++c) {
        const float mst = MST[c], mnew = MST[c + 1], blast = BC[64 * c + 63];
#pragma unroll
        for (int i = 0; i < 2; ++i) { const int idx = tid + 512 * i, r = idx >> 4;
            *(LAS v4u*)(L + ML_Q + ld_off[i]) = rq[i]; *(LAS v4u*)(L + ML_K + ld_off[i]) = rk[i]; *(LAS v4u*)(L + ML_V + ld_off[i]) = rv[i];
            const float wk = __expf(blast + AV[64 * c + r] - mnew);
            v4u vw; vw.x = pk2(bflo(rv[i].x) * wk, bfhi(rv[i].x) * wk); vw.y = pk2(bflo(rv[i].y) * wk, bfhi(rv[i].y) * wk); vw.z = pk2(bflo(rv[i].z) * wk, bfhi(rv[i].z) * wk); vw.w = pk2(bflo(rv[i].w) * wk, bfhi(rv[i].w) * wk);
            *(LAS v4u*)(L + ML_VW + ld_off[i]) = vw; }
        LDS_WAIT(); __syncthreads();
        if (c + 1 < NCHUNK) {
#pragma unroll
            for (int i = 0; i < 2; ++i) { const size_t adv = (size_t)(c + 1) * 64; rq[i] = *(const GAS v4u*)(ld_q[i] + adv * 1024); rk[i] = *(const GAS v4u*)(ld_q[i] + adv * 1024 + 512); rv[i] = *(const GAS v4u*)(ld_v[i] + adv * DINP); } }
        for (int ti = w; ti < 10; ti += 8) {
            const int kt = (int)((0x3221110000ull >> (4 * ti)) & 15ull), nt = (int)((0x3323213210ull >> (4 * ti)) & 15ull);
            bf16x8 fa[4], fb[4];
#pragma unroll
            for (int ks = 0; ks < 4; ++ks) { fa[ks] = lds_rd128(L + ML_K + img_off(16 * kt + n, 4 * ks + g)); fb[ks] = lds_rd128(L + ML_Q + img_off(16 * nt + n, 4 * ks + g)); }
            const int j = 16 * nt + n; const float pmj = PM[64 * c + j];
            const f32x4 av = *(const LAS f32x4*)(AV + 64 * c + 16 * kt + 4 * g);
            __builtin_amdgcn_sched_barrier(0);
            f32x4 s = (f32x4){0.f, 0.f, 0.f, 0.f};
#pragma unroll
            for (int ks = 0; ks < 4; ++ks) s = MFMA16(fa[ks], fb[ks], s);
            const float mx = fmaxf(mst, pmj);
            float pv[4];
#pragma unroll
            for (int e = 0; e < 4; ++e) { const int sk = 16 * kt + 4 * g + e; pv[e] = (sk <= j) ? s[e] * __expf(av[e] - mx) : 0.f; }
            v2u pw; pw.x = pk2(pv[0], pv[1]); pw.y = pk2(pv[2], pv[3]);
            *(LAS v2u*)(L + ML_P + j * ML_PSTR + (16 * kt + 4 * g) * 2) = pw;
        }
        f32x4 dacc = (f32x4){0.f, 0.f, 0.f, 0.f};
        if (w < 4) {
            f32x4 n0[4], n1[4]; bf16x8 bqd[4];
#pragma unroll
            for (int ks = 0; ks < 4; ++ks) { n0[ks] = *(const LAS f32x4*)(NV + 32 * ks + 8 * g); n1[ks] = *(const LAS f32x4*)(NV + 32 * ks + 8 * g + 4); bqd[ks] = lds_rd128(L + ML_Q + img_off(16 * w + n, 4 * ks + g)); }
            __builtin_amdgcn_sched_barrier(0);
#pragma unroll
            for (int ks = 0; ks < 4; ++ks) {
                v4u aw; aw.x = pk2(n0[ks][0], n0[ks][1]); aw.y = pk2(n0[ks][2], n0[ks][3]); aw.z = pk2(n1[ks][0], n1[ks][1]); aw.w = pk2(n1[ks][2], n1[ks][3]);
                if (n != 0) { aw.x = 0u; aw.y = 0u; aw.z = 0u; aw.w = 0u; }
                dacc = MFMA16(__builtin_bit_cast(bf16x8, aw), bqd[ks], dacc); }
        }
        LDS_WAIT(); __syncthreads();
        const float mxw = fmaxf(mst, PM[64 * c + 16 * (w & 3) + n]);
        bf16x8 bpd[2];
        if (w < 4) {
#pragma unroll
            for (int ks = 0; ks < 2; ++ks) bpd[ks] = lds_rd128(L + ML_P + (16 * w + n) * ML_PSTR + (32 * ks + 8 * g) * 2);
        }
        f32x4 avn[2][2]; v4i16_t klo[2], khi[2];
#pragma unroll
        for (int ks = 0; ks < 2; ++ks) { avn[ks][0] = *(const LAS f32x4*)(AV + 64 * c + 32 * ks + 8 * g); avn[ks][1] = *(const LAS f32x4*)(AV + 64 * c + 32 * ks + 8 * g + 4); klo[ks] = ML_TR(ML_K, ks, w, 0); khi[ks] = ML_TR(ML_K, ks, w, 1); }
        v2u qb0[4][4], qb1[4][4]; float pmn[4];
#pragma unroll
        for (int nt = 0; nt < 4; ++nt) { const int row = 16 * nt + n; pmn[nt] = PM[64 * c + row];
#pragma unroll
            for (int s4 = 0; s4 < 4; ++s4) { qb0[nt][s4] = *(const LAS v2u*)(L + ML_Q + img_off(row, 4 * s4 + (g >> 1)) + 8 * (g & 1)); qb1[nt][s4] = *(const LAS v2u*)(L + ML_Q + img_off(row, 4 * s4 + 2 + (g >> 1)) + 8 * (g & 1)); } }
        const float nvold = (g == 0) ? NV[16 * w + n] : 0.f;
        __builtin_amdgcn_sched_barrier(0);
        if (w < 4) {
            const float wint = __expf(mst - mxw);
            dacc = dacc * wint;
            v4u ow; ow.x = (n == 0) ? 0x3f803f80u : 0u; ow.y = ow.x; ow.z = ow.x; ow.w = ow.x;
#pragma unroll
            for (int ks = 0; ks < 2; ++ks) dacc = MFMA16(__builtin_bit_cast(bf16x8, ow), bpd[ks], dacc);
            if (g == 0) { const float den = dacc[0]; const float mrow = BC[64 * c + 16 * w + n] + mxw; DINV[16 * w + n] = 1.0f / fmaxf(fabsf(den), __expf(-mrow)); }
        }
        {
            f32x4 nacc = (f32x4){0.f, 0.f, 0.f, 0.f};
#pragma unroll
            for (int ks = 0; ks < 2; ++ks) {
                float wkv[8];
#pragma unroll
                for (int jj = 0; jj < 8; ++jj) wkv[jj] = __expf(blast + avn[ks][jj >> 2][jj & 3] - mnew);
                v4u aw; aw.x = pk2(wkv[0], wkv[1]); aw.y = pk2(wkv[2], wkv[3]); aw.z = pk2(wkv[4], wkv[5]); aw.w = pk2(wkv[6], wkv[7]);
                if (n != 0) { aw.x = 0u; aw.y = 0u; aw.z = 0u; aw.w = 0u; }
                const bf16x8 bk = (bf16x8){klo[ks][0], klo[ks][1], klo[ks][2], klo[ks][3], khi[ks][0], khi[ks][1], khi[ks][2], khi[ks][3]};
                nacc = MFMA16(__builtin_bit_cast(bf16x8, aw), bk, nacc); }
            if (g == 0) { const float decay = __expf(blast + mst - mnew); NV[16 * w + n] = decay * nvold + nacc[0]; }
        }
        f32x4 Hacc[4];
        {
            v4u awc[4];
#pragma unroll
            for (int s4 = 0; s4 < 4; ++s4) { awc[s4].x = pk2(Cacc[2 * s4][0], Cacc[2 * s4][1]); awc[s4].y = pk2(Cacc[2 * s4][2], Cacc[2 * s4][3]); awc[s4].z = pk2(Cacc[2 * s4 + 1][0], Cacc[2 * s4 + 1][1]); awc[s4].w = pk2(Cacc[2 * s4 + 1][2], Cacc[2 * s4 + 1][3]); }
#pragma unroll
            for (int nt = 0; nt < 4; ++nt) {
                f32x4 h = (f32x4){0.f, 0.f, 0.f, 0.f};
#pragma unroll
                for (int s4 = 0; s4 < 4; ++s4) { v4u bw; bw.x = qb0[nt][s4].x; bw.y = qb0[nt][s4].y; bw.z = qb1[nt][s4].x; bw.w = qb1[nt][s4].y;
                    h = MFMA16(__builtin_bit_cast(bf16x8, awc[s4]), __builtin_bit_cast(bf16x8, bw), h); }
                const float wint = __expf(mst - fmaxf(mst, pmn[nt]));
                Hacc[nt] = h * wint;
            }
        }
        __builtin_amdgcn_sched_barrier(0);
        v4i16_t vlo2[2], vhi2[2], wlo2[2], whi2[2]; bf16x8 bpp[2][4]; v4i16_t alo[2][8], ahi[2][8];
#pragma unroll
        for (int ks = 0; ks < 2; ++ks) { vlo2[ks] = ML_TR(ML_V, ks, w, 0); vhi2[ks] = ML_TR(ML_V, ks, w, 1);
#pragma unroll
            for (int nt = 0; nt < 4; ++nt) bpp[ks][nt] = lds_rd128(L + ML_P + (16 * nt + n) * ML_PSTR + (32 * ks + 8 * g) * 2); }
#define ML_STATE_READS(ks_) do { wlo2[ks_] = ML_TR(ML_VW, ks_, w, 0); whi2[ks_] = ML_TR(ML_VW, ks_, w, 1); \
            _Pragma("unroll") for (int mt = 0; mt < 8; ++mt) { alo[ks_][mt] = ML_TR(ML_K, ks_, mt, 0); ahi[ks_][mt] = ML_TR(ML_K, ks_, mt, 1); } } while (0)
#define ML_STATE_MMA(ks_) do { const bf16x8 bv = (bf16x8){wlo2[ks_][0], wlo2[ks_][1], wlo2[ks_][2], wlo2[ks_][3], whi2[ks_][0], whi2[ks_][1], whi2[ks_][2], whi2[ks_][3]}; \
            _Pragma("unroll") for (int mt = 0; mt < 8; ++mt) { const bf16x8 ak = (bf16x8){alo[ks_][mt][0], alo[ks_][mt][1], alo[ks_][mt][2], alo[ks_][mt][3], ahi[ks_][mt][0], ahi[ks_][mt][1], ahi[ks_][mt][2], ahi[ks_][mt][3]}; \
                Cacc[mt] = MFMA16(ak, bv, Cacc[mt]); } } while (0)
        ML_STATE_READS(0);
        __builtin_amdgcn_sched_barrier(0);
#pragma unroll
        for (int ks = 0; ks < 2; ++ks) {
            const bf16x8 av = (bf16x8){vlo2[ks][0], vlo2[ks][1], vlo2[ks][2], vlo2[ks][3], vhi2[ks][0], vhi2[ks][1], vhi2[ks][2], vhi2[ks][3]};
#pragma unroll
            for (int nt = 0; nt < 4; ++nt) Hacc[nt] = MFMA16(av, bpp[ks][nt], Hacc[nt]);
        }
        __builtin_amdgcn_sched_barrier(0);
        ML_STATE_READS(1);
        __builtin_amdgcn_sched_barrier(0);
        {
            const float decay = __expf(blast + mst - mnew);
#pragma unroll
            for (int mt = 0; mt < 8; ++mt) Cacc[mt] = Cacc[mt] * decay;
            ML_STATE_MMA(0); ML_STATE_MMA(1);
        }
#undef ML_STATE_READS
#undef ML_STATE_MMA
        LDS_WAIT(); __syncthreads();
#pragma unroll
        for (int nt = 0; nt < 4; ++nt) { const int j = 16 * nt + n; const float di = DINV[j];
            v2u o; o.x = pk2(Hacc[nt][0] * di, Hacc[nt][1] * di); o.y = pk2(Hacc[nt][2] * di, Hacc[nt][3] * di);
            *(GAS v2u*)(hraw + (rowb + 64 * c + j) * 1024 + hh * DV + half * 128 + 16 * w + 4 * g) = o; }
    }
#undef ML_TR
    __syncthreads();
}
#ifndef CVPROBE
#define CVPROBE 0
#endif
#if CVPROBE
#define CVPROBE_DUP(k_) convert_item(F, l + 1, ((int)ct_ * 4 + (k_)) * 8 + F.wave, fresh_tid(F.wave) & 63);
#else
#define CVPROBE_DUP(k_)
#endif
#ifndef MIX_NCONV
#define MIX_NCONV 96
#endif
constexpr int MIX_CONV0 = 64;
static_assert(CV_ITEMS % 32 == 0, "conversion tickets are four workgroup items");
__device__ __forceinline__ void p_mix(Frame& F_, const float* relb, const float* igb_, const float* fgb_, int l) {
    Frame F = F_; const int tid = fresh_tid(F.wave);
    LAS float* BIAS = (LAS float*)(F.lds + AT_BIAS);
    for (int i = tid; i < 129 * 8; i += NWAVES * 64) { const int nn = i >> 3, hh = i & 7; BIAS[i] = relb[t5_bucket_dev(nn) * AH + hh] * 1.4426950408889634f; }
    __syncthreads();
    int bid_ = (int)blockIdx.x; asm volatile("" : "+s"(bid_));
    const int grp_ = bid_ & 7, rank_ = bid_ >> 3;
    if (rank_ < MH * 2) mlstm_unit(F, igb_, fgb_, l, grp_, rank_ >> 1, rank_ & 1, tid);
    const int tid2 = fresh_tid(F.wave);
    unsigned* ctr = (unsigned*)(F.ctl + CW_ATK + 64 * (8 * l + grp_));
    unsigned* ctrc = (unsigned*)(F.ctl + CW_CVT + 64 * l);
    volatile LAS unsigned* tk = F.MISC + 20;
    const bool has_conv = (l + 1 < DEPTH);
    const bool conv_first = has_conv && bid_ >= MIX_CONV0 && bid_ < MIX_CONV0 + MIX_NCONV;
#define MIX_CONVERT() do { for (;;) { if (tid2 == 0) tk[0] = __hip_atomic_fetch_add(ctrc, 1u, __ATOMIC_RELAXED, __HIP_MEMORY_SCOPE_AGENT); __syncthreads(); const unsigned ct_ = tk[0]; __syncthreads(); \
        if (ct_ >= (unsigned)(CV_ITEMS / 32)) break; \
        { const int ln_ = fresh_tid(F.wave) & 63; LAS unsigned* scr_ = (LAS unsigned*)(F.lds + RING_OFF + F.wave * 16384); f32x4 va_[16], vb_[16]; \
          CvItem ia_ = cv_item(F, l + 1, ((int)ct_ * 4 + 0) * 8 + F.wave, ln_); cv_load(ia_, va_); \
          CvItem ib_ = cv_item(F, l + 1, ((int)ct_ * 4 + 1) * 8 + F.wave, ln_); cv_load(ib_, vb_); cv_finish(ia_, va_, scr_, ln_); \
          ia_ = cv_item(F, l + 1, ((int)ct_ * 4 + 2) * 8 + F.wave, ln_); cv_load(ia_, va_); cv_finish(ib_, vb_, scr_, ln_); \
          ib_ = cv_item(F, l + 1, ((int)ct_ * 4 + 3) * 8 + F.wave, ln_); cv_load(ib_, vb_); cv_finish(ia_, va_, scr_, ln_); cv_finish(ib_, vb_, scr_, ln_); } } } while (0)
    if (conv_first) MIX_CONVERT();
    unsigned mine = 0u;
    if (tid2 == 0) mine = __hip_atomic_fetch_add(ctr, 1u, __ATOMIC_RELAXED, __HIP_MEMORY_SCOPE_AGENT);
    for (;;) {
        if (tid2 == 0) tk[0] = mine;
        __syncthreads();
        const unsigned ticket = tk[0];
        __syncthreads();
        if (ticket >= 128u) break;
        if (tid2 == 0) mine = __hip_atomic_fetch_add(ctr, 1u, __ATOMIC_RELAXED, __HIP_MEMORY_SCOPE_AGENT);
        attn_unit<false>(F, grp_, 127 - (int)ticket, tid2);
#if ATPROBE
        attn_unit<true>(F, grp_, 127 - (int)ticket, tid2);
#endif
    }
    if (has_conv && !conv_first) MIX_CONVERT();
#undef MIX_CONVERT
}

constexpr int PH_PER_LAYER = 12, N_PHASES = 1 + DEPTH * PH_PER_LAYER;
__global__ void __launch_bounds__(NWAVES * 64, 2) trunk_fwd(const Args A) {
    extern __shared__ __attribute__((aligned(16))) unsigned char lds[];
    Frame F;
    F.lds = (LAS unsigned char*)lds;
    F.MISC = (volatile LAS unsigned*)(F.lds + MISC_OFF);
    F.tid = threadIdx.x; F.lane = F.tid & 63; F.wave = __builtin_amdgcn_readfirstlane(F.tid >> 6);
    F.G = gridDim.x; { const int bx = blockIdx.x; F.vcu = (F.G % 8 == 0) ? (bx % 8) * (F.G / 8) + bx / 8 : bx; }
    F.ws = kargs()->ws; F.ctl = (gu32*)(kargs()->ws + WS_CTL); F.out = kargs()->out;
    for (int u = F.tid; u < (LDS_BYTES - LDSCTL_OFF) / 4; u += NWAVES * 64) ((LAS unsigned*)(F.lds + LDSCTL_OFF))[u] = 0u;
    __syncthreads();
    const int lo = kargs()->ph_lo, hi = kargs()->ph_hi;
    const bool multi = (hi - lo) > 1;
    XcdBarrier bar; bar.bar = (unsigned*)(F.ctl + CW_BAR); bar.x = 0; bar.st = nullptr;
    if (multi) bar = xcd_barrier_post((unsigned*)(F.ctl + CW_BAR), F.MISC + 8, (unsigned)gridDim.x);
    const int grp = (int)blockIdx.x & 7;
    XcdBarrier gbar; gbar.bar = (unsigned*)(F.ctl + CW_GBAR + 4096 * grp); gbar.x = 0; gbar.st = nullptr; gbar.G = GROUP_WG;
    if (multi) gbar = xcd_barrier_post((unsigned*)(F.ctl + CW_GBAR + 4096 * grp), F.MISC + 12, GROUP_WG);
    const int team = grp * 8 + (((int)blockIdx.x >> 3) & 7);
    XcdBarrier tbar; tbar.bar = (unsigned*)(F.ctl + CW_TBAR + 4096 * team); tbar.x = 0; tbar.st = nullptr; tbar.G = TEAM_WG;
    if (multi) tbar = xcd_barrier_post((unsigned*)(F.ctl + CW_TBAR + 4096 * team), F.MISC + 14, TEAM_WG);
#define IN(k) (lo <= (k) && (k) < hi)
    auto lbid = []() { int b_ = (int)blockIdx.x; asm volatile("" : "+s"(b_)); return b_; };
    const LAS float* RTAB = (const LAS float*)(F.lds + AT_MASK);
#define RSTD_TABLE(S_, pm0_) do { const int c_ = lbid(); pm0_ = 8 * (c_ & 7) + ((c_ >> 3) & 7);        \
        const int t_ = fresh_tid(F.wave); if (t_ < 256) { const float* p_ = SSQ + (size_t)(pm0_ * 256 + t_) * 32; float s_ = 0.f; \
        _Pragma("unroll") for (int i_ = 0; i_ < 8; ++i_) { const f32x4 a_ = *(const GAS f32x4*)(p_ + 4 * i_); s_ += (a_.x + a_.y) + (a_.z + a_.w); } \
        ((LAS float*)(F.lds + AT_MASK))[t_] = 1.0f / sqrtf(s_ * (1.0f / 2048.0f) + 1e-6f); } __syncthreads(); } while (0)
#define SEAM(k) do { if (IN(k) && IN((k) + 1)) { const int rel_ = ((k) - 1) % PH_PER_LAYER;        \
        if (rel_ == 0 || rel_ == 1 || rel_ >= 8) xcd_barrier(tbar, F.wave); else xcd_barrier(gbar, F.wave); } } while (0)
    if (IN(0)) { p_prologue(F); p_xprep(F, kargs()->in[IN_X], (bf16*)(F.ws + WS_XN), (float*)(F.ws + WS_PART)); if (IN(1)) xcd_barrier(bar, F.wave); }
#pragma unroll 1
    for (int l = 0; l < DEPTH; ++l) {
        const int pb = 1 + l * PH_PER_LAYER;
        { unsigned char* ws_ = kargs()->ws; float* out_ = kargs()->out; unsigned ldsb_ = 0u; asm volatile("" : "+s"(ws_), "+s"(out_), "+s"(ldsb_));
          F.ws = ws_; F.out = out_; F.ctl = (gu32*)(ws_ + WS_CTL); F.lds = (LAS unsigned char*)lds + ldsb_;
          }
        bf16* XN = (bf16*)(F.ws + WS_XN); bf16* PROJ = (bf16*)(F.ws + WS_PROJ); bf16* HMB = (bf16*)(F.ws + WS_HM); bf16* YB = (bf16*)(F.ws + WS_Y);
        float* SSQ = (float*)(F.ws + WS_PART);
        unsigned char* wl = F.ws + WS_W + (size_t)l * LAYER_W;
        if (l > 0 && multi) { if (fresh_tid(F.wave) == 0) { unsigned* cvd = (unsigned*)(F.ctl + CW_CVD + 64 * (l - 1)); unsigned sp_ = 0u;
                while (__hip_atomic_load(cvd, __ATOMIC_RELAXED, __HIP_MEMORY_SCOPE_AGENT) < (unsigned)NGROUP) { __builtin_amdgcn_s_sleep(2); if (++sp_ > (1u << 24)) break; }
                __builtin_amdgcn_fence(__ATOMIC_ACQUIRE, "agent"); }
            __syncthreads(); }
        if (IN(pb + 0)) { pg8::Gemm g{XN, (const bf16*)(wl + OW_GU1), M, FF2, D, D, F.wave}; pg8::StaticOrder S; S.init(M, FF2, F.G, lbid());
            int pm0; RSTD_TABLE(S, pm0); pg8::EpiSwiGLU E{PROJ, DINP, SSQ, RTAB, pm0}; pg8::gemm_phase<pg8::EpiSwiGLU, pg8::StaticOrder, true, true>(F.lds + RING_OFF, g, S, E); SEAM(pb + 0); }
        if (IN(pb + 1)) { pg8::Gemm g{PROJ, (const bf16*)(wl + OW_DN1), M, D, FF, DINP, F.wave}; pg8::StaticOrder S; S.init(M, D, F.G, lbid());
            pg8::EpiResid<false, 1> E{XN, D, SSQ, nullptr}; pg8::gemm_phase<pg8::EpiResid<false, 1>, pg8::StaticOrder, true, true>(F.lds + RING_OFF, g, S, E); SEAM(pb + 1); }
        if (IN(pb + 2)) { pg8::Gemm g{XN, (const bf16*)(wl + OW_IN), M, DINP, D, D, F.wave}; pg8::StaticOrder S; S.init(M, DINP, F.G, lbid());
            int pm0; RSTD_TABLE(S, pm0); pg8::EpiProj E{PROJ, DINP, RTAB, (LAS float*)(F.lds + AT_MASK + 1024), kargs()->in[IN_QN] + l * RK, kargs()->in[IN_KVN] + l * RK}; pg8::gemm_phase<pg8::EpiProj, pg8::StaticOrder, true, true>(F.lds + RING_OFF, g, S, E); SEAM(pb + 2); }
        if (IN(pb + 3)) { p_prep(F, l); SEAM(pb + 3); }
        if (IN(pb + 4)) { p_mix(F, kargs()->in[IN_RELB], kargs()->in[IN_IGB], kargs()->in[IN_FGB], l); if (IN(pb + 6)) xcd_barrier(gbar, F.wave);
            if (l + 1 < DEPTH && ((int)blockIdx.x >> 3) == 0 && fresh_tid(F.wave) == 0) __hip_atomic_fetch_add((unsigned*)(F.ctl + CW_CVD + 64 * l), 1u, __ATOMIC_RELAXED, __HIP_MEMORY_SCOPE_AGENT); }
        if (IN(pb + 6)) { p_mpost(F, l); SEAM(pb + 6); }
        if (IN(pb + 7)) { pg8::Gemm g{PROJ + P_AQ, (const bf16*)(wl + OW_AO), M, D, D, DINP, F.wave}; pg8::StaticOrder S; S.init(M, D, F.G, lbid());
            pg8::EpiGate<0> E{YB, D, PROJ + P_GA, DINP}; pg8::gemm_phase<pg8::EpiGate<0>, pg8::StaticOrder, true, true>(F.lds + RING_OFF, g, S, E); if (!IN(pb + 8)) {} else __syncthreads(); }
        if (IN(pb + 8)) { pg8::Gemm g{HMB, (const bf16*)(wl + OW_MO), M, D, 1024, 1024, F.wave}; pg8::StaticOrder S; S.init(M, D, F.G, lbid());
            pg8::EpiGate<1> E{YB, D, PROJ + P_GM, DINP}; pg8::gemm_phase<pg8::EpiGate<1>, pg8::StaticOrder, true, true>(F.lds + RING_OFF, g, S, E); SEAM(pb + 8); }
        if (IN(pb + 9)) { pg8::Gemm g{YB, (const bf16*)(wl + OW_WO), M, D, D, D, F.wave}; pg8::StaticOrder S; S.init(M, D, F.G, lbid());
            pg8::EpiResid<false, 2> E{XN, D, SSQ, nullptr}; pg8::gemm_phase<pg8::EpiResid<false, 2>, pg8::StaticOrder, true, true>(F.lds + RING_OFF, g, S, E); SEAM(pb + 9); }
        if (IN(pb + 10)) { pg8::Gemm g{XN, (const bf16*)(wl + OW_GU2), M, FF2, D, D, F.wave}; pg8::StaticOrder S; S.init(M, FF2, F.G, lbid());
            int pm0; RSTD_TABLE(S, pm0); pg8::EpiSwiGLU E{PROJ, DINP, SSQ, RTAB, pm0}; pg8::gemm_phase<pg8::EpiSwiGLU, pg8::StaticOrder, true, true>(F.lds + RING_OFF, g, S, E); SEAM(pb + 10); }
        if (IN(pb + 11)) { pg8::Gemm g{PROJ, (const bf16*)(wl + OW_DN2), M, D, FF, DINP, F.wave}; pg8::StaticOrder S; S.init(M, D, F.G, lbid());
            if (l + 1 < DEPTH) { pg8::EpiResid<false, 1> E{XN, D, SSQ, nullptr}; pg8::gemm_phase<pg8::EpiResid<false, 1>, pg8::StaticOrder, true, true>(F.lds + RING_OFF, g, S, E); }
            else { pg8::EpiResid<true, 1> E{XN, D, SSQ, F.out}; pg8::gemm_phase<pg8::EpiResid<true, 1>, pg8::StaticOrder, true, true>(F.lds + RING_OFF, g, S, E); }
            SEAM(pb + 11); }
    }
#undef IN
#undef SEAM
}

#ifndef N_LAUNCH_MODE
#define N_LAUNCH_MODE 1
#endif
extern "C" void kernel_launch(void* const* d_in, const int* in_sizes, int n_in, void* d_out, int out_size, void* d_ws, size_t ws_size, hipStream_t stream) {
    static int grid = 0;
    if (grid == 0) {
        if (n_in != 20 || in_sizes[0] != M * D || out_size != M * D || ws_size < WS_END) { fprintf(stderr, "kernel_launch: unexpected shapes / workspace (n_in %d, ws %zu, need %zu)\n", n_in, ws_size, (size_t)WS_END); grid = -1; return; }
        int dev = 0, cus = 0, per_cu = 0;
        if (hipGetDevice(&dev) != hipSuccess || hipDeviceGetAttribute(&cus, hipDeviceAttributeMultiprocessorCount, dev) != hipSuccess) { grid = -1; return; }
        if (hipFuncSetAttribute((const void*)trunk_fwd, hipFuncAttributeMaxDynamicSharedMemorySize, LDS_BYTES) != hipSuccess) { fprintf(stderr, "kernel_launch: hipFuncSetAttribute failed\n"); grid = -1; return; }
        if (hipOccupancyMaxActiveBlocksPerMultiprocessor(&per_cu, (const void*)trunk_fwd, NWAVES * 64, LDS_BYTES) != hipSuccess || per_cu < 1)
            fprintf(stderr, "kernel_launch: note: occupancy query reports %d workgroups per CU\n", per_cu);
        (void)hipGetLastError();
        grid = cus;
    }
    if (grid < 0) return;
    if (hipMemsetAsync((char*)d_ws + WS_CTL, 0, CTL_ZERO_BYTES, stream) != hipSuccess) return;
    Args a{};
    for (int i = 0; i < 20; ++i) a.in[i] = (const float*)d_in[i];
    a.out = (float*)d_out; a.ws = (unsigned char*)d_ws;
    if (N_LAUNCH_MODE == 1) {
        a.ph_lo = 0; a.ph_hi = N_PHASES;
        hipLaunchKernelGGL(trunk_fwd, dim3(grid), dim3(NWAVES * 64), LDS_BYTES, stream, a);
    } else {
        for (int p = 0; p < N_PHASES; ++p) {
            a.ph_lo = p; a.ph_hi = p + 1; hipLaunchKernelGGL(trunk_fwd, dim3(grid), dim3(NWAVES * 64), LDS_BYTES, stream, a); }
    }
}
```

```cpp
#include <hip/hip_runtime.h>
#include <cstdio>
#include <cstdint>
#include <cmath>

#define GAS __attribute__((address_space(1)))
#define LAS __attribute__((address_space(3)))
typedef unsigned short bf16;
typedef unsigned v4u __attribute__((ext_vector_type(4)));
typedef unsigned v2u __attribute__((ext_vector_type(2)));
typedef float f32x4 __attribute__((ext_vector_type(4)));
typedef float f32x2 __attribute__((ext_vector_type(2)));
typedef short bf16x8 __attribute__((ext_vector_type(8)));
typedef GAS unsigned gu32;

constexpr int BATCH = 8, SEQ = 2048, D = 2048, DEPTH = 4, M = BATCH * SEQ;
constexpr int AH = 8, RK = 256, IH = 8, IDIM = 64, TOPK = 256;
constexpr int MH = 4, DK = 128, DV = 256, CHUNK = 64, NCHUNK = SEQ / CHUNK;
constexpr int FF = 5504, FF2 = 2 * FF;
constexpr int DIN = 10064, DINP = 10240;
constexpr float EPS = 1e-6f;
constexpr int P_AQ = 0, P_CKV = 2048, P_IQ = 2304, P_IK = 2816, P_MQK = 2880, P_MV = 3904, P_MO = 4928, P_GA = 5952, P_GM = 8000, P_IW = 10048, P_MI = 10056, P_MF = 10060;
__host__ __device__ __forceinline__ int win_src_of_dest(int d) {
    if (d < 2880) return d;
    if (d < 5952) return d + 8;
    if (d < 10048) return d + 16;
    if (d < 10056) return 2880 + (d - 10048);
    if (d < 10064) return 5960 + (d - 10056);
    return -1;
}
__host__ __device__ __forceinline__ int gu_src_of_dest(int d) { const int pn = d >> 8, r = d & 255; return (r < 128) ? (pn * 128 + r) : (FF + pn * 128 + (r - 128)); }

constexpr size_t MiB = 1u << 20;
constexpr size_t WS_CTL = 0, CTL_ZERO_BYTES = 1 * MiB;
constexpr size_t SZ_GU = (size_t)FF2 * D * 2, SZ_DN = (size_t)D * FF * 2, SZ_IN = (size_t)DINP * D * 2, SZ_AO = (size_t)D * D * 2, SZ_MO = (size_t)D * 1024 * 2, SZ_WO = (size_t)D * D * 2;
constexpr size_t LAYER_W = 2 * SZ_GU + 2 * SZ_DN + SZ_IN + SZ_AO + SZ_MO + SZ_WO;
constexpr size_t OW_GU1 = 0, OW_DN1 = OW_GU1 + SZ_GU, OW_IN = OW_DN1 + SZ_DN, OW_AO = OW_IN + SZ_IN, OW_MO = OW_AO + SZ_AO, OW_WO = OW_MO + SZ_MO, OW_GU2 = OW_WO + SZ_WO, OW_DN2 = OW_GU2 + SZ_GU;
constexpr size_t WS_W = 1 * MiB;
constexpr size_t WS_XN = WS_W + DEPTH * LAYER_W;
constexpr size_t WS_PROJ = WS_XN + (size_t)M * D * 2;
constexpr size_t WS_MQK = WS_PROJ + (size_t)M * DINP * 2;
constexpr size_t WS_HRAW = WS_MQK + (size_t)M * 1024 * 2;
constexpr size_t WS_HM = WS_HRAW + (size_t)M * 1024 * 2;
constexpr size_t WS_Y = WS_HM + (size_t)M * 1024 * 2;
constexpr size_t WS_PART = WS_Y + (size_t)M * D * 2;
constexpr size_t WS_END = WS_PART + (size_t)M * 32 * 4;
static_assert(WS_END <= (size_t)1440 * 1000 * 1000, "workspace map must fit 4x the largest input tensor");
static_assert((LAYER_W % 256) == 0, "alignment");

constexpr int CW_TMO = 0, CW_CODE = 1;
constexpr int CW_BAR = 4096;
constexpr int CW_TICKET = 8192;
constexpr int CW_CVT = 8192 + 1024;
constexpr int CW_ATK = 12288;
constexpr int CW_CVD = 14336;
constexpr int CW_GBAR = 16384;
constexpr int NGROUP = 8, GROUP_WG = 32;

constexpr int RING_OFF = 0, RING_BYTES = 131072;
constexpr int LDSCTL_OFF = RING_BYTES, MISC_OFF = LDSCTL_OFF + 320;
constexpr int LDS_BYTES = 147456;
constexpr int NWAVES = 8;

#define RLX_AGENT __ATOMIC_RELAXED, __HIP_MEMORY_SCOPE_AGENT
#define LDS_WAIT() asm volatile("s_waitcnt lgkmcnt(0)" ::: "memory")
#define VM_WAIT() asm volatile("s_waitcnt vmcnt(0)" ::: "memory")
__device__ __forceinline__ unsigned f2bf(float f) { unsigned u = __builtin_bit_cast(unsigned, f); return (u + 0x7fffu + ((u >> 16) & 1u)) >> 16; }
typedef __bf16 bf16x2_hw __attribute__((ext_vector_type(2)));
__device__ __forceinline__ unsigned pk2(float lo, float hi) { const f32x2 v = {lo, hi}; const bf16x2_hw b = __builtin_convertvector(v, bf16x2_hw); return __builtin_bit_cast(unsigned, b); }
__device__ __forceinline__ float bflo(unsigned w) { return __builtin_bit_cast(float, w << 16); }
__device__ __forceinline__ float bfhi(unsigned w) { return __builtin_bit_cast(float, w & 0xffff0000u); }
__device__ __forceinline__ float bf2f(bf16 b) { return __builtin_bit_cast(float, ((unsigned)b) << 16); }
__device__ __forceinline__ float silu_f(float g) { return g * __builtin_amdgcn_rcpf(1.0f + __expf(-g)); }
__device__ __forceinline__ float sigm_f(float g) { return __builtin_amdgcn_rcpf(1.0f + __expf(-g)); }
__device__ __forceinline__ float wave_sum(float v) {
#pragma unroll
    for (int o = 1; o < 64; o <<= 1) v += __shfl_xor(v, o);
    return v;
}
__device__ __forceinline__ float wave_max(float v) {
#pragma unroll
    for (int o = 1; o < 64; o <<= 1) v = fmaxf(v, __shfl_xor(v, o));
    return v;
}
__device__ __forceinline__ unsigned sortable_key(float f) { const unsigned u = __builtin_bit_cast(unsigned, f); return (u & 0x80000000u) ? ~u : (u | 0x80000000u); }
__device__ __forceinline__ int t5_bucket_dev(int n) {
    if (n < 16) return n;
    const float v = logf((float)n / 16.0f) / 2.0794415416798357f * 16.0f;
    int large = 16 + (int)v; return large < 31 ? large : 31;
}
__device__ __forceinline__ int wave_sum_dpp(int v) {
    v += __builtin_amdgcn_update_dpp(0, v, 0xB1, 0xF, 0xF, true);
    v += __builtin_amdgcn_update_dpp(0, v, 0x4E, 0xF, 0xF, true);
    v += __builtin_amdgcn_update_dpp(0, v, 0x141, 0xF, 0xF, true);
    v += __builtin_amdgcn_update_dpp(0, v, 0x140, 0xF, 0xF, true);
    v += __builtin_amdgcn_update_dpp(0, v, 0x142, 0xA, 0xF, true);
    v += __builtin_amdgcn_update_dpp(0, v, 0x143, 0xC, 0xF, true);
    return __builtin_amdgcn_readlane(v, 63);
}
__device__ __forceinline__ int fresh_tid(int wave) { int w_ = wave; asm volatile("" : "+s"(w_)); unsigned m_ = ~0u; asm volatile("" : "+s"(m_)); const int l_ = (int)__builtin_amdgcn_mbcnt_hi(m_, __builtin_amdgcn_mbcnt_lo(m_, 0u));     return w_ * 64 + l_; }

namespace pg8 {
#define PG8_LAS __attribute__((address_space(3)))
typedef unsigned short bf16_t;
typedef short bf16x8 __attribute__((ext_vector_type(8)));
typedef float f32x4 __attribute__((ext_vector_type(4)));
typedef unsigned u32x4 __attribute__((ext_vector_type(4)));
constexpr int BM = 256, BK = 64, HALF = 128, HTB = HALF * BK * 2  , STAGE_BYTES = 8 * HTB, NXCD = 8, WGM = 8;

__host__ __device__ __forceinline__ int lds_byte(int r, int c) { const int st = (r >> 4) * 2 + (c >> 5), rr = r & 15, cc = c & 31, ob = rr * 64 + cc * 2; return st * 1024 + (ob ^ (((ob >> 9) & 1) << 5)); }
__host__ __device__ __forceinline__ void stage_rc(int b, int& R, int& C) { const int st = b / 1024, sb = b % 1024, swz = sb ^ (((sb >> 9) & 1) << 5); R = (st >> 1) * 16 + swz / 64; C = (st & 1) * 32 + (swz % 64) / 2; }
__host__ __device__ __forceinline__ int perm32(int rho) { const int n = rho >> 4, i = rho & 15; return 8 * (i >> 2) + 4 * n + (i & 3); }

struct Unit { int pm, pn; };
struct Gemm { const bf16_t* A; const bf16_t* Bt; int M, N, K, lda, wave; };

struct StaticOrder {
    int nM, nN, nwg, G, c;
    __host__ __device__ void init(int M, int N, int G_, int c_) { nM = M / BM; nN = N / BM; nwg = nM * nN; G = G_; c = c_; }
    __host__ __device__ bool next(int i, Unit& u) const {
        const long L = (long)i * G + c; if (L >= nwg) return false;
        int wgid = (int)L; { const int q = nwg / NXCD, r = nwg % NXCD, xcd = wgid % NXCD, off = wgid / NXCD; wgid = (xcd < r ? xcd * (q + 1) : r * (q + 1) + (xcd - r) * q) + off; }
        const int nig = WGM * nN, gid = wgid / nig, fm = gid * WGM, gsz = (nM - fm) < WGM ? (nM - fm) : WGM;
        u.pm = fm + ((wgid % nig) % gsz); u.pn = (wgid % nig) / gsz; return true;
    }
    __device__ __forceinline__ void a_ready(const Unit&) const {}
    __device__ __forceinline__ void done(const Unit&) const {}
};

__device__ __forceinline__ unsigned cvt_pk_bf16(float lo, float hi) { return pk2(lo, hi); }

__device__ __forceinline__ void rows_rstd(float (&rs)[2][4], const float* part, int row0, int fq) {
    f32x4 a[2][4], b[2][4];
#pragma unroll
    for (int ai = 0; ai < 2; ++ai)
#pragma unroll
        for (int m = 0; m < 4; ++m) { const float* p = part + (size_t)(row0 + ai * HALF + m * 16) * 32 + 8 * fq; a[ai][m] = *(const __attribute__((address_space(1))) f32x4*)p; b[ai][m] = *(const __attribute__((address_space(1))) f32x4*)(p + 4); }
#pragma unroll
    for (int ai = 0; ai < 2; ++ai)
#pragma unroll
        for (int m = 0; m < 4; ++m) { float s = ((a[ai][m][0] + a[ai][m][1]) + (a[ai][m][2] + a[ai][m][3])) + ((b[ai][m][0] + b[ai][m][1]) + (b[ai][m][2] + b[ai][m][3]));
            s += __shfl_xor(s, 16); s += __shfl_xor(s, 32); rs[ai][m] = 1.0f / sqrtf(s * (1.0f / 2048.0f) + 1e-6f); }
}
struct EpiBf16 {
    static constexpr bool PERM = true, AFTER_DRAIN = false;
    bf16_t* O; int ldc; const float* ssq; const PG8_LAS float* rtab; int pm0;
    __device__ __forceinline__ void operator()(const f32x4 (&acc)[2][2][4][2], const Unit& u, int wr, int wc, int fr, int fq) const {
        const int row0 = u.pm * BM + wr * 64 + fr; const int col0 = u.pn * BM + wc * 32 + 8 * fq;
#pragma unroll
        for (int ai = 0; ai < 2; ++ai)
#pragma unroll
            for (int m = 0; m < 4; ++m) { const int row = row0 + ai * HALF + m * 16; bf16_t* rowp = O + (size_t)row * ldc + col0;
                const float rs = rtab[wr * 64 + fr + ai * HALF + m * 16];
#pragma unroll
                for (int bj = 0; bj < 2; ++bj) { const f32x4 v0 = acc[ai][bj][m][0] * rs, v1 = acc[ai][bj][m][1] * rs;
                    u32x4 w; w.x = cvt_pk_bf16(v0[0], v0[1]); w.y = cvt_pk_bf16(v0[2], v0[3]); w.z = cvt_pk_bf16(v1[0], v1[1]); w.w = cvt_pk_bf16(v1[2], v1[3]);
                    *(__attribute__((address_space(1))) u32x4*)(rowp + bj * HALF) = w; } }
    }
};
struct EpiProj {
    static constexpr bool PERM = true, AFTER_DRAIN = false;
    bf16_t* O; int ldc; const PG8_LAS float* rtab; PG8_LAS float* tab2; const float* qg; const float* kg;
    __device__ __forceinline__ void operator()(const f32x4 (&acc)[2][2][4][2], const Unit& u, int wr, int wc, int fr, int fq) const {
        typedef __attribute__((address_space(1))) u32x4 gu4; typedef __attribute__((address_space(1))) const f32x4 gcf4;
        const int row0 = u.pm * BM + wr * 64 + fr; const int col0 = u.pn * BM + wc * 32 + 8 * fq;
        if (u.pn <= 8) {
#pragma unroll
            for (int ai = 0; ai < 2; ++ai)
#pragma unroll
                for (int m = 0; m < 4; ++m) { const int rl = wr * 64 + fr + ai * HALF + m * 16; const float rs = rtab[rl]; float s = 0.f;
#pragma unroll
                    for (int bj = 0; bj < 2; ++bj)
#pragma unroll
                        for (int n = 0; n < 2; ++n) { const f32x4 v = acc[ai][bj][m][n] * rs; s += (v[0] * v[0] + v[1] * v[1]) + (v[2] * v[2] + v[3] * v[3]); }
                    s += __shfl_xor(s, 16); s += __shfl_xor(s, 32);
                    if (fq == 0) tab2[rl * 4 + wc] = s; }
            asm volatile("s_waitcnt lgkmcnt(0)\n\ts_barrier" ::: "memory");
            const float* gp = (u.pn < 8 ? qg : kg) + wc * 32 + 8 * fq;
            const float qsc = (u.pn < 8) ? 0.0625f * 1.4426950408889634f : 1.0f;
            f32x4 gv[2][2];
#pragma unroll
            for (int bj = 0; bj < 2; ++bj)
#pragma unroll
                for (int n = 0; n < 2; ++n) gv[bj][n] = *(gcf4*)(gp + bj * HALF + 4 * n);
#pragma unroll
            for (int ai = 0; ai < 2; ++ai)
#pragma unroll
                for (int m = 0; m < 4; ++m) { const int rl = wr * 64 + fr + ai * HALF + m * 16; bf16_t* rowp = O + (size_t)(row0 + ai * HALF + m * 16) * ldc + col0;
                    const f32x4 t4 = *(const PG8_LAS f32x4*)(tab2 + rl * 4);
                    const float rs = qsc * rtab[rl] / sqrtf(((t4[0] + t4[1]) + (t4[2] + t4[3])) * (1.0f / 256.0f) + 1e-6f);
#pragma unroll
                    for (int bj = 0; bj < 2; ++bj) { const f32x4 v0 = acc[ai][bj][m][0] * rs * gv[bj][0], v1 = acc[ai][bj][m][1] * rs * gv[bj][1];
                        u32x4 w; w.x = cvt_pk_bf16(v0[0], v0[1]); w.y = cvt_pk_bf16(v0[2], v0[3]); w.z = cvt_pk_bf16(v1[0], v1[1]); w.w = cvt_pk_bf16(v1[2], v1[3]);
                        *(gu4*)(rowp + bj * HALF) = w; } }
            asm volatile("s_waitcnt lgkmcnt(0)\n\ts_barrier" ::: "memory");
        } else {
#pragma unroll
            for (int ai = 0; ai < 2; ++ai)
#pragma unroll
                for (int m = 0; m < 4; ++m) { bf16_t* rowp = O + (size_t)(row0 + ai * HALF + m * 16) * ldc + col0;
                    const float rs = rtab[wr * 64 + fr + ai * HALF + m * 16];
#pragma unroll
                    for (int bj = 0; bj < 2; ++bj) { const f32x4 v0 = acc[ai][bj][m][0] * rs, v1 = acc[ai][bj][m][1] * rs;
                        u32x4 w; w.x = cvt_pk_bf16(v0[0], v0[1]); w.y = cvt_pk_bf16(v0[2], v0[3]); w.z = cvt_pk_bf16(v1[0], v1[1]); w.w = cvt_pk_bf16(v1[2], v1[3]);
                        *(gu4*)(rowp + bj * HALF) = w; } }
        }
    }
};
struct EpiSwiGLU {
    static constexpr bool PERM = true, AFTER_DRAIN = false;
    bf16_t* O; int ldc; const float* ssq; const PG8_LAS float* rtab; int pm0;
    __device__ __forceinline__ void operator()(const f32x4 (&acc)[2][2][4][2], const Unit& u, int wr, int wc, int fr, int fq) const {
        const int row0 = u.pm * BM + wr * 64 + fr; const int col0 = u.pn * HALF + wc * 32 + 8 * fq;
#pragma unroll
        for (int ai = 0; ai < 2; ++ai)
#pragma unroll
            for (int m = 0; m < 4; ++m) { const int row = row0 + ai * HALF + m * 16; bf16_t* rowp = O + (size_t)row * ldc + col0;
                const float rs = rtab[wr * 64 + fr + ai * HALF + m * 16];
                f32x4 v0, v1;
                {
                    const float nrs_ = rs * -1.4426950408889634f, rsq_ = rs * rs; const f32x2 nrs2 = {nrs_, nrs_}, rsq2 = {rsq_, rsq_}, one2 = {1.0f, 1.0f};
#pragma unroll
                    for (int h = 0; h < 2; ++h) {
                        const f32x2 g0 = {acc[ai][0][m][0][2 * h], acc[ai][0][m][0][2 * h + 1]}, u0 = {acc[ai][1][m][0][2 * h], acc[ai][1][m][0][2 * h + 1]};
                        const f32x2 g1 = {acc[ai][0][m][1][2 * h], acc[ai][0][m][1][2 * h + 1]}, u1 = {acc[ai][1][m][1][2 * h], acc[ai][1][m][1][2 * h + 1]};
                        const f32x2 a0 = g0 * nrs2, a1 = g1 * nrs2; const f32x2 t0 = (g0 * u0) * rsq2, t1 = (g1 * u1) * rsq2;
                        const f32x2 e0 = {__builtin_amdgcn_exp2f(a0.x), __builtin_amdgcn_exp2f(a0.y)}, e1 = {__builtin_amdgcn_exp2f(a1.x), __builtin_amdgcn_exp2f(a1.y)};
                        const f32x2 d0 = e0 + one2, d1 = e1 + one2;
                        const f32x2 r0 = {__builtin_amdgcn_rcpf(d0.x), __builtin_amdgcn_rcpf(d0.y)}, r1 = {__builtin_amdgcn_rcpf(d1.x), __builtin_amdgcn_rcpf(d1.y)};
                        const f32x2 o0 = t0 * r0, o1 = t1 * r1;
                        v0[2 * h] = o0.x; v0[2 * h + 1] = o0.y; v1[2 * h] = o1.x; v1[2 * h + 1] = o1.y; } }
                u32x4 w; w.x = cvt_pk_bf16(v0[0], v0[1]); w.y = cvt_pk_bf16(v0[2], v0[3]); w.z = cvt_pk_bf16(v1[0], v1[1]); w.w = cvt_pk_bf16(v1[2], v1[3]);
                *(__attribute__((address_space(1))) u32x4*)(rowp) = w; }
    }
};
template <bool FINAL, int ALPHA2> struct EpiResid {
    static constexpr bool PERM = true, AFTER_DRAIN = false;
    bf16_t* H; int ldc; float* ssq; float* outf;
    __device__ __forceinline__ void operator()(const f32x4 (&acc)[2][2][4][2], const Unit& u, int wr, int wc, int fr, int fq) const {
        typedef __attribute__((address_space(1))) const u32x4 gcu4; typedef __attribute__((address_space(1))) f32x4 gf4; typedef __attribute__((address_space(1))) u32x4 gu4; typedef __attribute__((address_space(1))) float gf1;
        const int row0 = u.pm * BM + wr * 64 + fr, col0 = u.pn * BM + wc * 32 + 8 * fq;
#pragma unroll
        for (int ai = 0; ai < 2; ++ai) {
            u32x4 hb[4][2];
#pragma unroll
            for (int m = 0; m < 4; ++m)
#pragma unroll
                for (int bj = 0; bj < 2; ++bj) hb[m][bj] = *(gcu4*)(H + (size_t)(row0 + ai * HALF + m * 16) * ldc + col0 + bj * HALF);
#pragma unroll
            for (int m = 0; m < 4; ++m) { const size_t off = (size_t)(row0 + ai * HALF + m * 16) * ldc + col0; float s = 0.f;
#pragma unroll
                for (int bj = 0; bj < 2; ++bj) { const u32x4 h4 = hb[m][bj];
                    f32x4 v0, v1;
                    v0[0] = __builtin_bit_cast(float, h4.x << 16); v0[1] = __builtin_bit_cast(float, h4.x & 0xffff0000u); v0[2] = __builtin_bit_cast(float, h4.y << 16); v0[3] = __builtin_bit_cast(float, h4.y & 0xffff0000u);
                    v1[0] = __builtin_bit_cast(float, h4.z << 16); v1[1] = __builtin_bit_cast(float, h4.z & 0xffff0000u); v1[2] = __builtin_bit_cast(float, h4.w << 16); v1[3] = __builtin_bit_cast(float, h4.w & 0xffff0000u);
                    v0 = v0 + acc[ai][bj][m][0] * (0.5f * (float)ALPHA2); v1 = v1 + acc[ai][bj][m][1] * (0.5f * (float)ALPHA2);
                    if (FINAL) { *(gf4*)(outf + off + bj * HALF) = v0; *(gf4*)(outf + off + bj * HALF + 4) = v1; }
                    else { s += ((v0[0] * v0[0] + v0[1] * v0[1]) + (v0[2] * v0[2] + v0[3] * v0[3])) + ((v1[0] * v1[0] + v1[1] * v1[1]) + (v1[2] * v1[2] + v1[3] * v1[3]));
                        u32x4 w; w.x = cvt_pk_bf16(v0[0], v0[1]); w.y = cvt_pk_bf16(v0[2], v0[3]); w.z = cvt_pk_bf16(v1[0], v1[1]); w.w = cvt_pk_bf16(v1[2], v1[3]);
                        *(gu4*)(H + off + bj * HALF) = w; } }
                if (!FINAL) { s += __shfl_xor(s, 16); s += __shfl_xor(s, 32);
                    if (fq == 0) *(gf1*)(ssq + (size_t)(row0 + ai * HALF + m * 16) * 32 + u.pn * 4 + wc) = s; } }
        }
    }
};
template <int MODE> struct EpiGate {
    static constexpr bool PERM = true, AFTER_DRAIN = false;
    bf16_t* Y; int ldc; const bf16_t* gate; int ldg;
    __device__ __forceinline__ void operator()(const f32x4 (&acc)[2][2][4][2], const Unit& u, int wr, int wc, int fr, int fq) const {
        typedef __attribute__((address_space(1))) const u32x4 gcu4; typedef __attribute__((address_space(1))) u32x4 gu4;
        const int row0 = u.pm * BM + wr * 64 + fr; const int col0 = u.pn * BM + wc * 32 + 8 * fq;
#pragma unroll
        for (int ai = 0; ai < 2; ++ai) {
            u32x4 gw[4][2], yw[4][2];
#pragma unroll
            for (int m = 0; m < 4; ++m)
#pragma unroll
                for (int bj = 0; bj < 2; ++bj) { const int row = row0 + ai * HALF + m * 16; gw[m][bj] = *(gcu4*)(gate + (size_t)row * ldg + col0 + bj * HALF);
                    if (MODE == 1) yw[m][bj] = *(gcu4*)(Y + (size_t)row * ldc + col0 + bj * HALF); }
#pragma unroll
            for (int m = 0; m < 4; ++m) { const int row = row0 + ai * HALF + m * 16; bf16_t* rowp = Y + (size_t)row * ldc + col0;
#pragma unroll
                for (int bj = 0; bj < 2; ++bj) { const u32x4 g4 = gw[m][bj];
                    float gv[8]; gv[0] = __builtin_bit_cast(float, g4.x << 16); gv[1] = __builtin_bit_cast(float, g4.x & 0xffff0000u); gv[2] = __builtin_bit_cast(float, g4.y << 16); gv[3] = __builtin_bit_cast(float, g4.y & 0xffff0000u);
                    gv[4] = __builtin_bit_cast(float, g4.z << 16); gv[5] = __builtin_bit_cast(float, g4.z & 0xffff0000u); gv[6] = __builtin_bit_cast(float, g4.w << 16); gv[7] = __builtin_bit_cast(float, g4.w & 0xffff0000u);
                    float o[8];
#pragma unroll
                    for (int j = 0; j < 4; ++j) { o[j] = sigm_f(gv[j]) * acc[ai][bj][m][0][j]; o[4 + j] = sigm_f(gv[4 + j]) * acc[ai][bj][m][1][j]; }
                    if (MODE == 1) { const u32x4 y4 = yw[m][bj];
                        o[0] += __builtin_bit_cast(float, y4.x << 16); o[1] += __builtin_bit_cast(float, y4.x & 0xffff0000u); o[2] += __builtin_bit_cast(float, y4.y << 16); o[3] += __builtin_bit_cast(float, y4.y & 0xffff0000u);
                        o[4] += __builtin_bit_cast(float, y4.z << 16); o[5] += __builtin_bit_cast(float, y4.z & 0xffff0000u); o[6] += __builtin_bit_cast(float, y4.w << 16); o[7] += __builtin_bit_cast(float, y4.w & 0xffff0000u); }
                    u32x4 w; w.x = cvt_pk_bf16(o[0], o[1]); w.y = cvt_pk_bf16(o[2], o[3]); w.z = cvt_pk_bf16(o[4], o[5]); w.w = cvt_pk_bf16(o[6], o[7]);
                    *(gu4*)(rowp + bj * HALF) = w; } }
        }
    }
};

template <class Epi, class Sched, bool ALIGN_EPI = false, bool SP2 = false>
__device__ __forceinline__ void gemm_phase(PG8_LAS unsigned char* lds, const Gemm g, const Sched& S, const Epi& E) {
    const int tid_ = fresh_tid(g.wave);
    const int tid = tid_, wid = __builtin_amdgcn_readfirstlane(tid >> 6), lane = tid & 63, wr = wid >> 2, wc = wid & 3, fr = lane & 15, fq = lane >> 4;
    const int K = g.K, nt = K / BK;
    unsigned voffA[2], voffB[2];
#pragma unroll
    for (int i = 0; i < 2; ++i) { int R, C; stage_rc(tid * 16 + i * 8192, R, C); const int Rb = Epi::PERM ? ((R & ~31) + perm32(R & 31)) : R;
        voffA[i] = (unsigned)(R * g.lda + C) * 2u; voffB[i] = (unsigned)(Rb * K + C) * 2u; }
    const size_t kstep = (size_t)(BK * 2);
    const size_t hstepB = (size_t)HALF * K * 2, hstepA = (size_t)HALF * g.lda * 2;
    const size_t tstepB = 2 * hstepB, tstepA = 2 * hstepA;
    const unsigned ldsw = (unsigned)wid * 1024u;
    const int aoff = lds_byte(wr * 64 + fr, fq * 8), boff = lds_byte(wc * 32 + fr, fq * 8);
#define PG8_SA(b, h) (((b) * 2 + (h)) * HTB)
#define PG8_SB(b, h) ((4 + (b) * 2 + (h)) * HTB)
#define PG8_STAGE(bufoff, gbase, voff) do { _Pragma("unroll") for (int _i = 0; _i < 2; ++_i) \
        __builtin_amdgcn_global_load_lds((const unsigned*)((const char*)(gbase) + (voff)[_i]), (PG8_LAS unsigned*)(lds + (bufoff) + ldsw + _i * 8192), 16, 0, 0); } while (0)
#define PG8_LDA(dst, b, h) do { _Pragma("unroll") for (int m = 0; m < 4; ++m) _Pragma("unroll") for (int k = 0; k < 2; ++k) dst[m][k] = *(const PG8_LAS bf16x8*)(lds + PG8_SA(b, h) + aoff + m * 2048 + k * 1024); } while (0)
#define PG8_LDB(dst, b, h) do { _Pragma("unroll") for (int n = 0; n < 2; ++n) _Pragma("unroll") for (int k = 0; k < 2; ++k) dst[n][k] = *(const PG8_LAS bf16x8*)(lds + PG8_SB(b, h) + boff + n * 2048 + k * 1024); } while (0)
#define PG8_MMA(ai, bj, At, Bt) do { __builtin_amdgcn_s_setprio(1); _Pragma("unroll") for (int m = 0; m < 4; ++m) _Pragma("unroll") for (int n = 0; n < 2; ++n) _Pragma("unroll") for (int k = 0; k < 2; ++k) \
        acc[ai][bj][m][n] = __builtin_amdgcn_mfma_f32_16x16x32_bf16(Bt[n][k], At[m][k], acc[ai][bj][m][n], 0, 0, 0); __builtin_amdgcn_s_setprio(0); } while (0)
#define PG8_WAIT_V(n) asm volatile("s_waitcnt vmcnt(" #n ")" ::: "memory")
#define PG8_WAIT_L(n) asm volatile("s_waitcnt lgkmcnt(" #n ")" ::: "memory")
#define PG8_BAR __builtin_amdgcn_s_barrier()
#define PG8_SCHED __builtin_amdgcn_sched_barrier(0)
    Unit cur, nxt; int ui = 0;
    if (!S.next(0, cur)) return;
    f32x4 acc[2][2][4][2];
#pragma unroll
    for (int a = 0; a < 2; ++a)
#pragma unroll
        for (int b = 0; b < 2; ++b)
#pragma unroll
            for (int m = 0; m < 4; ++m)
#pragma unroll
                for (int n = 0; n < 2; ++n) acc[a][b][m][n] = (f32x4){0.f, 0.f, 0.f, 0.f};
    bf16x8 At[4][2], B0[2][2], B1[2][2];
    const char* cA = (const char*)g.A + (size_t)cur.pm * tstepA; const char* cB = (const char*)g.Bt + (size_t)cur.pn * tstepB;
    S.a_ready(cur);
    if constexpr (SP2) {
        PG8_STAGE(PG8_SB(0, 0), cB, voffB); PG8_STAGE(PG8_SB(0, 1), cB + hstepB, voffB); PG8_STAGE(PG8_SA(0, 0), cA, voffA); PG8_STAGE(PG8_SA(0, 1), cA + hstepA, voffA);
        if (wr == 1) PG8_BAR;
        PG8_WAIT_V(2); PG8_BAR;
        PG8_STAGE(PG8_SB(1, 0), cB + kstep, voffB); PG8_STAGE(PG8_SA(1, 0), cA + kstep, voffA); PG8_STAGE(PG8_SB(1, 1), cB + hstepB + kstep, voffB);
        PG8_WAIT_V(6); PG8_BAR;
    } else {
        PG8_STAGE(PG8_SB(0, 0), cB, voffB); PG8_STAGE(PG8_SA(0, 0), cA, voffA); PG8_STAGE(PG8_SB(0, 1), cB + hstepB, voffB); PG8_STAGE(PG8_SA(0, 1), cA + hstepA, voffA);
        if (wr == 1) PG8_BAR;
        PG8_WAIT_V(4); PG8_BAR;
        PG8_STAGE(PG8_SB(1, 0), cB + kstep, voffB); PG8_STAGE(PG8_SA(1, 0), cA + kstep, voffA); PG8_STAGE(PG8_SB(1, 1), cB + hstepB + kstep, voffB);
        PG8_WAIT_V(6); PG8_BAR;
    }
    for (;;) {
        const bool has_next = S.next(ui + 1, nxt);
        const char* nA = has_next ? (const char*)g.A + (size_t)nxt.pm * tstepA : cA; const char* nB = has_next ? (const char*)g.Bt + (size_t)nxt.pn * tstepB : cB;
        for (int t = 0; t < nt; t += 2) {
            const bool last = (t == nt - 2);
            const char* a1 = cA + (size_t)(t + 1) * kstep;
            const char* a2 = last ? nA : cA + (size_t)(t + 2) * kstep; const char* b2 = last ? nB : cB + (size_t)(t + 2) * kstep;
            const char* a3 = a2 + kstep; const char* b3 = b2 + kstep;
            if (last && has_next) S.a_ready(nxt);
            if constexpr (SP2) {
            PG8_LDB(B0, 0, 0); PG8_LDB(B1, 0, 1); PG8_SCHED; PG8_LDA(At, 0, 0); PG8_STAGE(PG8_SA(1, 1), a1 + hstepA, voffA);
            PG8_WAIT_V(8); PG8_WAIT_L(0); PG8_BAR; PG8_MMA(0, 0, At, B0); PG8_MMA(0, 1, At, B1); PG8_BAR; PG8_SCHED;
            PG8_LDA(At, 0, 1); PG8_STAGE(PG8_SB(0, 0), b2, voffB); PG8_STAGE(PG8_SB(0, 1), b2 + hstepB, voffB); PG8_STAGE(PG8_SA(0, 0), a2, voffA);
            PG8_WAIT_V(8); PG8_WAIT_L(0); PG8_BAR; PG8_MMA(1, 0, At, B0); PG8_MMA(1, 1, At, B1); PG8_BAR; PG8_SCHED;
            PG8_LDB(B0, 1, 0); PG8_LDB(B1, 1, 1); PG8_SCHED; PG8_LDA(At, 1, 0); PG8_STAGE(PG8_SA(0, 1), a2 + hstepA, voffA);
            PG8_WAIT_V(8); PG8_WAIT_L(0); PG8_BAR; PG8_MMA(0, 0, At, B0); PG8_MMA(0, 1, At, B1); PG8_BAR; PG8_SCHED;
            PG8_LDA(At, 1, 1); PG8_STAGE(PG8_SB(1, 0), b3, voffB); PG8_STAGE(PG8_SB(1, 1), b3 + hstepB, voffB); PG8_STAGE(PG8_SA(1, 0), a3, voffA);
            PG8_WAIT_V(8); PG8_WAIT_L(0); PG8_BAR; PG8_MMA(1, 0, At, B0); PG8_MMA(1, 1, At, B1); PG8_BAR; PG8_SCHED;
            } else {
            PG8_LDB(B0, 0, 0); PG8_SCHED; PG8_LDA(At, 0, 0); PG8_STAGE(PG8_SA(1, 1), a1 + hstepA, voffA);
            PG8_WAIT_L(8); PG8_BAR; PG8_WAIT_L(0); PG8_MMA(0, 0, At, B0); PG8_BAR; PG8_SCHED;
            PG8_LDB(B1, 0, 1); PG8_STAGE(PG8_SB(0, 0), b2, voffB);
            PG8_BAR; PG8_WAIT_L(0); PG8_MMA(0, 1, At, B1); PG8_BAR;
            PG8_LDA(At, 0, 1); PG8_STAGE(PG8_SA(0, 0), a2, voffA);
            PG8_BAR; PG8_WAIT_L(0); PG8_MMA(1, 0, At, B0); PG8_BAR; PG8_SCHED;
            PG8_STAGE(PG8_SB(0, 1), b2 + hstepB, voffB);
            PG8_WAIT_V(6); PG8_BAR; PG8_MMA(1, 1, At, B1); PG8_BAR;
            PG8_LDB(B0, 1, 0); PG8_SCHED; PG8_LDA(At, 1, 0); PG8_STAGE(PG8_SA(0, 1), a2 + hstepA, voffA);
            PG8_WAIT_L(8); PG8_BAR; PG8_WAIT_L(0); PG8_MMA(0, 0, At, B0); PG8_BAR; PG8_SCHED;
            PG8_LDB(B1, 1, 1); PG8_STAGE(PG8_SB(1, 0), b3, voffB);
            PG8_BAR; PG8_WAIT_L(0); PG8_MMA(0, 1, At, B1); PG8_BAR;
            PG8_LDA(At, 1, 1); PG8_STAGE(PG8_SA(1, 0), a3, voffA);
            PG8_BAR; PG8_WAIT_L(0); PG8_MMA(1, 0, At, B0); PG8_BAR; PG8_SCHED;
            PG8_STAGE(PG8_SB(1, 1), b3 + hstepB, voffB);
            PG8_WAIT_V(6); PG8_BAR; PG8_MMA(1, 1, At, B1); PG8_BAR;
            }
        }
        if constexpr (ALIGN_EPI) { if (wr == 0) PG8_BAR; }
        if constexpr (!Epi::AFTER_DRAIN) { E(acc, cur, wr, wc, fr, fq); S.done(cur); }
        if (!has_next) break;
#pragma unroll
        for (int a = 0; a < 2; ++a)
#pragma unroll
            for (int b = 0; b < 2; ++b)
#pragma unroll
                for (int m = 0; m < 4; ++m)
#pragma unroll
                    for (int n = 0; n < 2; ++n) acc[a][b][m][n] = (f32x4){0.f, 0.f, 0.f, 0.f};
        cur = nxt; cA = nA; cB = nB; ++ui;
        if constexpr (ALIGN_EPI) { if (wr == 1) PG8_BAR; }
    }
    PG8_WAIT_V(0);
    if constexpr (!ALIGN_EPI) { if (wr == 0) PG8_BAR; }
    PG8_BAR;
    if constexpr (Epi::AFTER_DRAIN) { E.fused(acc, cur, wr, wc, fr, fq, lds, wid, lane); S.done(cur); }
#undef PG8_SA
#undef PG8_SB
#undef PG8_STAGE
#undef PG8_LDA
#undef PG8_LDB
#undef PG8_MMA
#undef PG8_WAIT_V
#undef PG8_WAIT_L
#undef PG8_BAR
#undef PG8_SCHED
}
}


#define XB_TMO      128
#define XB_XCNT(j)  (256  + 64 * (j))
#define XB_XSUB(j)  (1280 + 64 * (j))
#define XB_XGEN(j)  (2304 + 64 * (j))
#define XB_TOP      3328
#define XB_TOPGEN   3392
#define XCD_BAR_WORDS 3456
#define XB_SPIN_CAP (1u << 18)

__device__ __forceinline__ unsigned xb_ld(unsigned* p)              { return __hip_atomic_load(p, __ATOMIC_RELAXED, __HIP_MEMORY_SCOPE_AGENT); }
__device__ __forceinline__ unsigned xb_add(unsigned* p, unsigned v) { return __hip_atomic_fetch_add(p, v, __ATOMIC_RELAXED, __HIP_MEMORY_SCOPE_AGENT); }
__device__ __forceinline__ unsigned xb_xcc_id() { return (unsigned)__builtin_amdgcn_s_getreg((3 << 11) | 20) & 0xFu; }
#define XB_SPIN(cond, bar) do { unsigned _sp = 0; while (cond) { __builtin_amdgcn_s_sleep(1); \
    if ((++_sp & 255u) == 0u) { if (xb_ld(&(bar)[XB_TMO])) break; if (_sp > XB_SPIN_CAP) { atomicAdd(&(bar)[XB_TMO], 1u); break; } } } } while (0)

struct XcdBarrier {
    unsigned* bar; unsigned x; unsigned G;
    volatile LAS unsigned* st;
};
__device__ __forceinline__ XcdBarrier xcd_barrier_post(unsigned* bar, volatile LAS unsigned* st, unsigned members) {
    XcdBarrier b; b.bar = bar; b.x = xb_xcc_id(); b.st = st; b.G = members;
    if (threadIdx.x == 0) (void)xb_add(&bar[XB_XCNT(b.x)], 1u);
    return b;
}
__device__ __forceinline__ void xcd_barrier_complete(unsigned* bar, unsigned x, unsigned G, unsigned& nloc, unsigned& nx) {
    unsigned sum, cnt, mine, sp = 0u;
    for (;;) {
        sum = 0u; cnt = 0u; mine = 0u;
#pragma unroll
        for (unsigned j = 0; j < 16; ++j) { const unsigned c = xb_ld(&bar[XB_XCNT(j)]); sum += c; cnt += (c > 0u) ? 1u : 0u; mine = (j == x) ? c : mine; }
        if (sum == G) break;
        __builtin_amdgcn_s_sleep(1);
        if ((++sp & 255u) == 0u) { if (xb_ld(&bar[XB_TMO])) break; if (sp > XB_SPIN_CAP) { atomicAdd(&bar[XB_TMO], 1u); break; } }
    }
    nloc = mine > 0u ? mine : 1u; nx = cnt > 0u ? cnt : 1u;
}
__device__ __forceinline__ void xcd_barrier(const XcdBarrier& b, int wave) {
    asm volatile("s_waitcnt vmcnt(0)" ::: "memory");
    __syncthreads();
    if (fresh_tid(wave) == 0) {
        unsigned* bar = b.bar; asm volatile("" : "+s"(bar));
        __builtin_amdgcn_s_waitcnt(0);
        unsigned nloc = b.st[0], nx = b.st[1];
        if (nloc == 0u) { xcd_barrier_complete(bar, b.x, b.G, nloc, nx); b.st[0] = nloc; b.st[1] = nx; }
        const unsigned old = xb_add(&bar[XB_XSUB(b.x)], 1u);
        const unsigned gen = old / nloc;
        if (old + 1u == (gen + 1u) * nloc) {
            __builtin_amdgcn_fence(__ATOMIC_RELEASE, "agent");
            asm volatile("s_waitcnt vmcnt(0)" ::: "memory");
            if (nx > 1u) {
            const unsigned og = xb_add(&bar[XB_TOP], 1u);
            const unsigned tg = og / nx;
            if (og + 1u == (tg + 1u) * nx) xb_add(&bar[XB_TOPGEN], 1u);
            else XB_SPIN(xb_ld(&bar[XB_TOPGEN]) == tg, bar);
            }
            xb_add(&bar[XB_XGEN(b.x)], 1u);
            __builtin_amdgcn_fence(__ATOMIC_ACQUIRE, "agent");
            asm volatile("s_waitcnt vmcnt(0)" ::: "memory");
        } else {
            XB_SPIN(xb_ld(&bar[XB_XGEN(b.x)]) == gen, bar);
            __builtin_amdgcn_fence(__ATOMIC_ACQUIRE, "agent");
            asm volatile("s_waitcnt vmcnt(0)" ::: "memory");
        }
    }
    __syncthreads();
}

struct Frame {
    LAS unsigned char* lds;
    volatile LAS unsigned* MISC;
    gu32* ctl;
    int tid, lane, wave;
    int vcu, G;
    unsigned char* ws;
    float* out;
};
struct Args { const float* in[20]; float* out; unsigned char* ws; int ph_lo, ph_hi; };
typedef const __attribute__((address_space(4))) Args* KArgs;
__device__ __forceinline__ KArgs kargs() { KArgs p = (KArgs)__builtin_amdgcn_kernarg_segment_ptr(); asm volatile("" : "+s"(p)); return p; }
enum { IN_X = 0, IN_RELB, IN_F1N, IN_F1GU, IN_F1DN, IN_MIXN, IN_WIN, IN_QN, IN_KVN, IN_CONVW, IN_CONVB, IN_IGB, IN_FGB, IN_MON, IN_WAO, IN_WMO, IN_WOUT, IN_F2N, IN_F2GU, IN_F2DN };

template <class SrcMap>
__device__ __forceinline__ void transpose_item(const float* W, int K, int Nsrc, bf16* WT, LAS unsigned* scr, int kb, int db, int lane, const SrcMap& src, const float* gk) {
    const int k0 = 64 * kb, d0 = 64 * db, nq = lane & 15, kq2 = lane >> 4; const int sc = src(d0 + 4 * nq);
    f32x4 v[16];
    const float* wp = W + (size_t)(k0 + 2 * kq2) * Nsrc + (sc >= 0 ? sc : 0);
#pragma unroll
    for (int i = 0; i < 8; ++i) { v[2 * i] = *(const GAS f32x4*)(wp + (size_t)(8 * i) * Nsrc); v[2 * i + 1] = *(const GAS f32x4*)(wp + (size_t)(8 * i + 1) * Nsrc); }
    if (sc < 0) {
#pragma unroll
        for (int i = 0; i < 16; ++i) v[i] = (f32x4){0.f, 0.f, 0.f, 0.f}; }
    if (gk) {
#pragma unroll
        for (int i = 0; i < 8; ++i) { const f32x2 g2 = *(const GAS f32x2*)(gk + k0 + 2 * kq2 + 8 * i); v[2 * i] = v[2 * i] * g2.x; v[2 * i + 1] = v[2 * i + 1] * g2.y; } }
#pragma unroll
    for (int i = 0; i < 8; ++i)
#pragma unroll
        for (int j = 0; j < 4; ++j) scr[(4 * nq + j) * 33 + 4 * i + kq2] = pk2(v[2 * i][j], v[2 * i + 1][j]);
    LDS_WAIT(); asm volatile("" ::: "memory");
    const int c = lane & 7;
#pragma unroll
    for (int r = 0; r < 8; ++r) { const int nn = 8 * r + (lane >> 3); const LAS unsigned* s = scr + nn * 33 + 4 * c;
        v4u o; o.x = s[0]; o.y = s[1]; o.z = s[2]; o.w = s[3];
        *(GAS v4u*)(WT + (size_t)(d0 + nn) * K + k0 + 8 * c) = o; }
    LDS_WAIT(); asm volatile("" ::: "memory");
}
struct SrcIdent { __device__ __forceinline__ int operator()(int d) const { return d; } };
struct SrcGU { __device__ __forceinline__ int operator()(int d) const { return gu_src_of_dest(d); } };
struct SrcWin { __device__ __forceinline__ int operator()(int d) const { return win_src_of_dest(d); } };

template <class SrcMap>
__device__ __forceinline__ void transpose_matrix(Frame& F, const float* W, int K, int Nsrc, int Ndst, bf16* WT, const SrcMap& src, const float* gk = nullptr) {
    const int lane_ = fresh_tid(F.wave) & 63;
    LAS unsigned* scr = (LAS unsigned*)(F.lds + RING_OFF + F.wave * 16384);
    const int gw = F.vcu * NWAVES + F.wave, NGW = F.G * NWAVES;
    const int nkb = K / 64, ndb = Ndst / 64, nit = nkb * ndb;
    for (int it = gw; it < nit; it += NGW) { const int kb = it / ndb, db = it % ndb; transpose_item(W, K, Nsrc, WT, scr, kb, db, lane_, src, gk); }
}
constexpr int CV_GU = (D / 64) * (FF2 / 64), CV_DN = (FF / 64) * (D / 64), CV_IN = (D / 64) * (DINP / 64), CV_AO = (D / 64) * (D / 64), CV_MO = (1024 / 64) * (D / 64), CV_WO = CV_AO;
constexpr int CV_ITEMS = 2 * CV_GU + 2 * CV_DN + CV_IN + CV_AO + CV_MO + CV_WO;
static_assert(CV_ITEMS % 8 == 0, "conversion items are dealt eight (one per wave) at a time");
__device__ __forceinline__ void convert_item(Frame& F, int l, int item, int lane) {
    LAS unsigned* scr = (LAS unsigned*)(F.lds + RING_OFF + F.wave * 16384);
    unsigned char* wl = F.ws + WS_W + (size_t)l * LAYER_W;
    int r = item;
    if (r < CV_GU) { constexpr int ndb = FF2 / 64; transpose_item(kargs()->in[IN_F1GU] + (size_t)l * D * FF2, D, FF2, (bf16*)(wl + OW_GU1), scr, r / ndb, r % ndb, lane, SrcGU(), kargs()->in[IN_F1N] + (size_t)l * D); return; } r -= CV_GU;
    if (r < CV_DN) { constexpr int ndb = D / 64; transpose_item(kargs()->in[IN_F1DN] + (size_t)l * FF * D, FF, D, (bf16*)(wl + OW_DN1), scr, r / ndb, r % ndb, lane, SrcIdent(), nullptr); return; } r -= CV_DN;
    if (r < CV_IN) { constexpr int ndb = DINP / 64; transpose_item(kargs()->in[IN_WIN] + (size_t)l * D * DIN, D, DIN, (bf16*)(wl + OW_IN), scr, r / ndb, r % ndb, lane, SrcWin(), kargs()->in[IN_MIXN] + (size_t)l * D); return; } r -= CV_IN;
    if (r < CV_AO) { constexpr int ndb = D / 64; transpose_item(kargs()->in[IN_WAO] + (size_t)l * D * D, D, D, (bf16*)(wl + OW_AO), scr, r / ndb, r % ndb, lane, SrcIdent(), nullptr); return; } r -= CV_AO;
    if (r < CV_MO) { constexpr int ndb = D / 64; transpose_item(kargs()->in[IN_WMO] + (size_t)l * 1024 * D, 1024, D, (bf16*)(wl + OW_MO), scr, r / ndb, r % ndb, lane, SrcIdent(), nullptr); return; } r -= CV_MO;
    if (r < CV_WO) { constexpr int ndb = D / 64; transpose_item(kargs()->in[IN_WOUT] + (size_t)l * D * D, D, D, (bf16*)(wl + OW_WO), scr, r / ndb, r % ndb, lane, SrcIdent(), nullptr); return; } r -= CV_WO;
    if (r < CV_GU) { constexpr int ndb = FF2 / 64; transpose_item(kargs()->in[IN_F2GU] + (size_t)l * D * FF2, D, FF2, (bf16*)(wl + OW_GU2), scr, r / ndb, r % ndb, lane, SrcGU(), kargs()->in[IN_F2N] + (size_t)l * D); return; } r -= CV_GU;
    { constexpr int ndb = D / 64; transpose_item(kargs()->in[IN_F2DN] + (size_t)l * FF * D, FF, D, (bf16*)(wl + OW_DN2), scr, r / ndb, r % ndb, lane, SrcIdent(), nullptr); }
}
struct CvItem { const float* wp; const float* gk; bf16* out; int Nsrc, K, sc; };
template <class SrcMap>
__device__ __forceinline__ CvItem cv_make(const float* W, int K, int Nsrc, bf16* WT, int kb, int db, int lane, const SrcMap& src, const float* gk) {
    const int k0 = 64 * kb, d0 = 64 * db, nq = lane & 15, kq2 = lane >> 4; const int sc = src(d0 + 4 * nq);
    CvItem it; it.wp = W + (size_t)(k0 + 2 * kq2) * Nsrc + (sc >= 0 ? sc : 0); it.gk = gk ? gk + k0 + 2 * kq2 : nullptr; it.out = WT + (size_t)d0 * K + k0; it.Nsrc = Nsrc; it.K = K; it.sc = sc; return it;
}
__device__ __forceinline__ CvItem cv_item(Frame& F, int l, int item, int lane) {
    unsigned char* wl = F.ws + WS_W + (size_t)l * LAYER_W;
    int r = item;
    if (r < CV_GU) { constexpr int ndb = FF2 / 64; return cv_make(kargs()->in[IN_F1GU] + (size_t)l * D * FF2, D, FF2, (bf16*)(wl + OW_GU1), r / ndb, r % ndb, lane, SrcGU(), kargs()->in[IN_F1N] + (size_t)l * D); } r -= CV_GU;
    if (r < CV_DN) { constexpr int ndb = D / 64; return cv_make(kargs()->in[IN_F1DN] + (size_t)l * FF * D, FF, D, (bf16*)(wl + OW_DN1), r / ndb, r % ndb, lane, SrcIdent(), nullptr); } r -= CV_DN;
    if (r < CV_IN) { constexpr int ndb = DINP / 64; return cv_make(kargs()->in[IN_WIN] + (size_t)l * D * DIN, D, DIN, (bf16*)(wl + OW_IN), r / ndb, r % ndb, lane, SrcWin(), kargs()->in[IN_MIXN] + (size_t)l * D); } r -= CV_IN;
    if (r < CV_AO) { constexpr int ndb = D / 64; return cv_make(kargs()->in[IN_WAO] + (size_t)l * D * D, D, D, (bf16*)(wl + OW_AO), r / ndb, r % ndb, lane, SrcIdent(), nullptr); } r -= CV_AO;
    if (r < CV_MO) { constexpr int ndb = D / 64; return cv_make(kargs()->in[IN_WMO] + (size_t)l * 1024 * D, 1024, D, (bf16*)(wl + OW_MO), r / ndb, r % ndb, lane, SrcIdent(), nullptr); } r -= CV_MO;
    if (r < CV_WO) { constexpr int ndb = D / 64; return cv_make(kargs()->in[IN_WOUT] + (size_t)l * D * D, D, D, (bf16*)(wl + OW_WO), r / ndb, r % ndb, lane, SrcIdent(), nullptr); } r -= CV_WO;
    if (r < CV_GU) { constexpr int ndb = FF2 / 64; return cv_make(kargs()->in[IN_F2GU] + (size_t)l * D * FF2, D, FF2, (bf16*)(wl + OW_GU2), r / ndb, r % ndb, lane, SrcGU(), kargs()->in[IN_F2N] + (size_t)l * D); } r -= CV_GU;
    { constexpr int ndb = D / 64; return cv_make(kargs()->in[IN_F2DN] + (size_t)l * FF * D, FF, D, (bf16*)(wl + OW_DN2), r / ndb, r % ndb, lane, SrcIdent(), nullptr); }
}
__device__ __forceinline__ void cv_load(const CvItem& it, f32x4 (&v)[16]) {
#pragma unroll
    for (int i = 0; i < 8; ++i) { v[2 * i] = *(const GAS f32x4*)(it.wp + (size_t)(8 * i) * it.Nsrc); v[2 * i + 1] = *(const GAS f32x4*)(it.wp + (size_t)(8 * i + 1) * it.Nsrc); }
}
__device__ __forceinline__ void cv_finish(const CvItem& it, f32x4 (&v)[16], LAS unsigned* scr, int lane) {
    const int nq = lane & 15, kq2 = lane >> 4;
    if (it.sc < 0) {
#pragma unroll
        for (int i = 0; i < 16; ++i) v[i] = (f32x4){0.f, 0.f, 0.f, 0.f}; }
    if (it.gk) {
#pragma unroll
        for (int i = 0; i < 8; ++i) { const f32x2 g2 = *(const GAS f32x2*)(it.gk + 8 * i); v[2 * i] = v[2 * i] * g2.x; v[2 * i + 1] = v[2 * i + 1] * g2.y; } }
#pragma unroll
    for (int i = 0; i < 8; ++i)
#pragma unroll
        for (int j = 0; j < 4; ++j) scr[(4 * nq + j) * 33 + 4 * i + kq2] = pk2(v[2 * i][j], v[2 * i + 1][j]);
    LDS_WAIT(); asm volatile("" ::: "memory");
    const int c = lane & 7;
#pragma unroll
    for (int r = 0; r < 8; ++r) { const int nn = 8 * r + (lane >> 3); const LAS unsigned* s = scr + nn * 33 + 4 * c;
        v4u o; o.x = s[0]; o.y = s[1]; o.z = s[2]; o.w = s[3];
        *(GAS v4u*)(it.out + (size_t)nn * it.K + 8 * c) = o; }
    LDS_WAIT(); asm volatile("" ::: "memory");
}
__device__ __forceinline__ void p_prologue(Frame& F) {
    const int lane_ = fresh_tid(F.wave) & 63;
    const int gw = F.vcu * NWAVES + F.wave, NGW = F.G * NWAVES;
    for (int it = gw; it < CV_ITEMS; it += NGW) convert_item(F, 0, it, lane_);
}

__device__ __forceinline__ void p_xprep(Frame& F_, const float* h, bf16* hb, float* ssq) {
    Frame F = F_; F.lane = fresh_tid(F.wave) & 63;
    const int gw = F.vcu * NWAVES + F.wave, NGW = F.G * NWAVES;
    for (int m = gw; m < M; m += NGW) {
        const GAS f32x4* xr = (const GAS f32x4*)(h + (size_t)m * D) + F.lane;
        f32x4 v[8]; float s = 0.f;
#pragma unroll
        for (int j = 0; j < 8; ++j) { v[j] = xr[64 * j]; s += (v[j].x * v[j].x + v[j].y * v[j].y) + (v[j].z * v[j].z + v[j].w * v[j].w); }
        s = wave_sum(s); if (F.lane < 32) ssq[(size_t)m * 32 + F.lane] = (F.lane == 0) ? s : 0.f;
        GAS v2u* o8 = (GAS v2u*)(hb + (size_t)m * D) + F.lane;
#pragma unroll
        for (int j = 0; j < 8; ++j) { v2u o; o.x = pk2(v[j].x, v[j].y); o.y = pk2(v[j].z, v[j].w); o8[64 * j] = o; }
    }
}

__device__ __forceinline__ void p_prep(Frame& F, int l) {
    const int lane = fresh_tid(F.wave) & 63;
    const int gw = F.vcu * NWAVES + F.wave, NGW = F.G * NWAVES;
    bf16* proj = (bf16*)(F.ws + WS_PROJ); bf16* mqk = (bf16*)(F.ws + WS_MQK);
    const float* qg = kargs()->in[IN_QN] + l * RK; const float* kg = kargs()->in[IN_KVN] + l * RK;
    const float* cw = kargs()->in[IN_CONVW] + (size_t)l * 4 * 1024; const float* cb = kargs()->in[IN_CONVB] + (size_t)l * 1024;
    const f32x4 qgv = *((const GAS f32x4*)qg + lane), kgv = *((const GAS f32x4*)kg + lane);
    float w[4][16], cbv[16];
#pragma unroll
    for (int k = 0; k < 4; ++k)
#pragma unroll
        for (int q = 0; q < 4; ++q) { const f32x4 t = *((const GAS f32x4*)(cw + k * 1024 + 16 * lane) + q); w[k][4 * q] = t.x; w[k][4 * q + 1] = t.y; w[k][4 * q + 2] = t.z; w[k][4 * q + 3] = t.w; }
#pragma unroll
    for (int q = 0; q < 4; ++q) { const f32x4 t = *((const GAS f32x4*)(cb + 16 * lane) + q); cbv[4 * q] = t.x; cbv[4 * q + 1] = t.y; cbv[4 * q + 2] = t.z; cbv[4 * q + 3] = t.w; }
    const float kscale = (lane >= 32) ? 0.08838834764831845f : 1.0f;
    for (int j8 = 0; j8 < 8; ++j8) { const int m = (gw >> 8) * SEQ + (gw & 255) + 256 * j8;
        bf16* row = proj + (size_t)m * DINP;
        const int t = m % SEQ;
        float acc[16];
#pragma unroll
        for (int i = 0; i < 16; ++i) acc[i] = cbv[i];
#pragma unroll
        for (int k = 0; k < 4; ++k) { const int tt = t - 3 + k;
            if (tt >= 0) { const GAS v4u* p = (const GAS v4u*)(proj + (size_t)(m - 3 + k) * DINP + P_MQK + 16 * lane); const v4u x0 = p[0], x1 = p[1];
                const unsigned xs[8] = {x0.x, x0.y, x0.z, x0.w, x1.x, x1.y, x1.z, x1.w};
#pragma unroll
                for (int i = 0; i < 8; ++i) { acc[2 * i] += w[k][2 * i] * bflo(xs[i]); acc[2 * i + 1] += w[k][2 * i + 1] * bfhi(xs[i]); } } }
        v4u o0, o1;
#pragma unroll
        for (int i = 0; i < 16; ++i) acc[i] = silu_f(acc[i]) * kscale;
        o0.x = pk2(acc[0], acc[1]); o0.y = pk2(acc[2], acc[3]); o0.z = pk2(acc[4], acc[5]); o0.w = pk2(acc[6], acc[7]);
        o1.x = pk2(acc[8], acc[9]); o1.y = pk2(acc[10], acc[11]); o1.z = pk2(acc[12], acc[13]); o1.w = pk2(acc[14], acc[15]);
        GAS v4u* po = (GAS v4u*)(mqk + (size_t)m * 1024 + 16 * lane); po[0] = o0; po[1] = o1;
    }
}

__device__ __forceinline__ void p_mpost(Frame& F, int l) {
    const int lane = fresh_tid(F.wave) & 63;
    const int gw = F.vcu * NWAVES + F.wave, NGW = F.G * NWAVES;
    const bf16* proj = (const bf16*)(F.ws + WS_PROJ); const bf16* hraw = (const bf16*)(F.ws + WS_HRAW); bf16* hm = (bf16*)(F.ws + WS_HM);
    const float* gn = kargs()->in[IN_MON] + (size_t)l * MH * DV;
    for (int j8 = 0; j8 < 8; ++j8) { const int m = (gw >> 8) * SEQ + (gw & 255) + 256 * j8;
#pragma unroll
        for (int hh = 0; hh < MH; ++hh) {
            const v2u x = *((const GAS v2u*)(hraw + (size_t)m * 1024 + hh * DV) + lane);
            const v2u og = *((const GAS v2u*)(proj + (size_t)m * DINP + P_MO + hh * DV) + lane);
            const f32x4 g = *((const GAS f32x4*)(gn + hh * DV) + lane);
            const float a = bflo(x.x), b = bfhi(x.x), c = bflo(x.y), d = bfhi(x.y);
            const float rstd = 1.0f / sqrtf(wave_sum(a * a + b * b + c * c + d * d) * (1.f / DV) + EPS);
            v2u o; o.x = pk2(a * rstd * g.x * sigm_f(bflo(og.x)), b * rstd * g.y * sigm_f(bfhi(og.x))); o.y = pk2(c * rstd * g.z * sigm_f(bflo(og.y)), d * rstd * g.w * sigm_f(bfhi(og.y)));
            *((GAS v2u*)(hm + (size_t)m * 1024 + hh * DV) + lane) = o;
        }
    }
}

#ifndef ATPROBE
#define ATPROBE 0
#endif
#ifndef ATDSEL
#define ATDSEL 7
#endif
#ifndef ATNT1
#define ATNT1 0
#endif
#ifndef ATNODMA
#define ATNODMA 0
#endif
#ifndef ATNOBAR
#define ATNOBAR 0
#endif
#ifndef ATP1
#define ATP1 1
#endif
#ifndef ATP1B
#define ATP1B 1
#endif
#ifndef ATP2
#define ATP2 1
#endif
constexpr int AT_SC = 0, AT_KV = 0, AT_KVBUF = 16384, AT_NBUF = 8;
constexpr int AT_MASK = 131072 + 512, AT_BIAS = AT_MASK + 4096, AT_THR = AT_BIAS + 4160;
static_assert(AT_THR + 256 <= LDS_BYTES, "attention LDS");
typedef short v4i16_t __attribute__((ext_vector_type(4)));
__device__ __forceinline__ bf16x8 lds_rd128(const LAS unsigned char* p) { return *(const LAS bf16x8*)p; }
__device__ __forceinline__ v4i16_t lds_tr64(const LAS unsigned char* p) { return __builtin_amdgcn_ds_read_tr16_b64_v4i16((LAS v4i16_t*)p); }
#define MFMA16(a, b, c) __builtin_amdgcn_mfma_f32_16x16x32_bf16((a), (b), (c), 0, 0, 0)

#define AT_CNT4(n_, c_, k0_, k1_, k2_, k3_) do { unsigned long long t0_, t1_, t2_, t3_; \
    asm volatile("v_cmp_le_u32_e64 %1, %5, %6\n\tv_cmp_le_u32_e64 %2, %5, %7\n\tv_cmp_le_u32_e64 %3, %5, %8\n\tv_cmp_le_u32_e64 %4, %5, %9\n\t" \
                 "v_addc_co_u32_e64 %0, %1, 0, %0, %1\n\tv_addc_co_u32_e64 %0, %2, 0, %0, %2\n\tv_addc_co_u32_e64 %0, %3, 0, %0, %3\n\tv_addc_co_u32_e64 %0, %4, 0, %0, %4" \
                 : "+v"(n_), "=&s"(t0_), "=&s"(t1_), "=&s"(t2_), "=&s"(t3_) : "s"(c_), "v"(k0_), "v"(k1_), "v"(k2_), "v"(k3_)); } while (0)
template <bool DUMMY> __device__ __forceinline__ void attn_unit(Frame& F, int b, int qb, int tid_in) {
    int tid = tid_in; asm volatile("" : "+v"(tid));
    int lane = tid & 63, w = __builtin_amdgcn_readfirstlane(tid >> 6), g = lane >> 4, n = lane & 15;
    bf16* proj = (bf16*)(F.ws + WS_PROJ);
    const int t0 = qb * 16; const size_t rowb = (size_t)b * SEQ;
    LAS unsigned char* L = F.lds;
    LAS unsigned* SC = (LAS unsigned*)(L + AT_SC); LAS unsigned* MASK = (LAS unsigned*)(L + AT_MASK); const LAS float* BIAS = (const LAS float*)(L + AT_BIAS);
    if (!DUMMY || (ATDSEL & 1)) {
        bf16x8 Aq[4][2][2];
#pragma unroll
        for (int p = 0; p < 4; ++p)
#pragma unroll
            for (int j = 0; j < 2; ++j)
#pragma unroll
                for (int ks = 0; ks < 2; ++ks) { const int q = 4 * p + (n >> 2), head = 4 * j + (n & 3);
                    Aq[p][j][ks] = *(const GAS bf16x8*)(proj + (rowb + t0 + q) * DINP + P_IQ + head * 64 + 32 * ks + 8 * g); }
        float wq[4][8];
#pragma unroll
        for (int p = 0; p < 4; ++p) { const v4u x = *(const GAS v4u*)(proj + (rowb + t0 + 4 * p + g) * DINP + P_IW); const unsigned xs[4] = {x.x, x.y, x.z, x.w};
#pragma unroll
          for (int i = 0; i < 4; ++i) { wq[p][2 * i] = bflo(xs[i]) * 0.044194173824159216f; wq[p][2 * i + 1] = bfhi(xs[i]) * 0.044194173824159216f; } }
        const bf16* kbase = proj + rowb * DINP + P_IK + 8 * g;
        bf16x8 Bc[4][2];
#define AT_LDB(dst, i0_) do { _Pragma("unroll") for (int k_ = 0; k_ < 4; ++k_) { int i_ = (i0_) + 8 * k_; i_ = i_ > qb ? qb : i_; \
            const GAS bf16x8* kp_ = (const GAS bf16x8*)(kbase + (size_t)(16 * i_ + n) * DINP); dst[k_][0] = kp_[0]; dst[k_][1] = kp_[4]; } } while (0)
        for (int i0 = w; i0 <= qb; i0 += 32) {
            AT_LDB(Bc, i0);
#pragma unroll
            for (int k = 0; k < 4; ++k) { const int i = i0 + 8 * k;
                if (i <= qb) {
                    const int key = 16 * i + n;
#pragma unroll
                    for (int p = 0; p < 4; ++p) {
                        f32x4 a0 = (f32x4){0.f, 0.f, 0.f, 0.f}, a1 = (f32x4){0.f, 0.f, 0.f, 0.f};
                        a0 = MFMA16(Aq[p][0][0], Bc[k][0], a0); a0 = MFMA16(Aq[p][0][1], Bc[k][1], a0);
                        a1 = MFMA16(Aq[p][1][0], Bc[k][0], a1); a1 = MFMA16(Aq[p][1][1], Bc[k][1], a1);
                        float sc = 0.f;
#pragma unroll
                        for (int e = 0; e < 4; ++e) { sc += wq[p][e] * fmaxf(a0[e], 0.f); sc += wq[p][4 + e] * fmaxf(a1[e], 0.f); }
                        SC[(4 * p + g) * 2048 + key] = (key <= t0 + 4 * p + g) ? sortable_key(sc + 0.0f) : 0u;
                    }
                } }
        }
#undef AT_LDB
    }
    LDS_WAIT(); __syncthreads();
    asm volatile("" : "+v"(tid)); lane = tid & 63; g = lane >> 4; n = lane & 15;
    bf16x8 Qf[8]; const bf16* lsrc; unsigned ldsw0;
    const int nt32 = (DUMMY && ATNT1) ? 1 : (qb >> 1) + 1;
#define AT_GLDS(gsrc_, dst_) do { unsigned keep_; asm volatile("s_mov_b32 %0, m0\n\ts_mov_b32 m0, %2\n\ts_nop 0\n\tglobal_load_lds_dwordx4 %1, off\n\ts_mov_b32 m0, %0" : "=&s"(keep_) : "v"(gsrc_), "s"(dst_) : "memory"); } while (0)
#define AT_LOAD(it_, buf_) do { const bf16* s_ = lsrc + (size_t)(it_) * 32 * DINP; const unsigned d_ = (unsigned)__builtin_amdgcn_readfirstlane(ldsw0 + (unsigned)(buf_) * AT_KVBUF); \
        AT_GLDS(s_, d_); AT_GLDS(s_ + 128, d_ + 8192u); } while (0)
#define AT_TILE(i_) ((i_) < nt32 ? (i_) : nt32 - 1)
#define AT_RING_START() do { { const bf16* qr_ = proj + (rowb + t0 + 2 * w + (n >> 3)) * DINP + P_AQ + (n & 7) * RK; _Pragma("unroll") for (int ks = 0; ks < 8; ++ks) Qf[ks] = *(const GAS bf16x8*)(qr_ + 32 * ks + 8 * g); } \
        const int lrow_ = 8 * (w >> 1) + ((lane >> 2) & 7), lch_ = 4 * (((w & 1) << 1) | (lane >> 5)) + ((lane & 3) ^ ((lrow_ >> 2) & 3)); \
        lsrc = proj + (rowb + lrow_) * DINP + P_CKV + lch_ * 8; ldsw0 = (unsigned)(size_t)(L + AT_KV) + (unsigned)w * 1024u; \
        _Pragma("unroll") for (int i = 0; i < 7; ++i) if (!(DUMMY && ATNODMA)) AT_LOAD(AT_TILE(i), i); } while (0)
    if (!DUMMY || (ATDSEL & 2)) {
        const bool all = (t0 + 16 <= TOPK);
        const unsigned long long lt_mask = (lane == 0) ? 0ull : (~0ull >> (64 - lane));
        const int jn = (t0 + 16 + 63) >> 6;
        const int qa = 2 * w, ta = t0 + qa, tb_ = ta + 1;
        unsigned ka[32], kb2[32];
#pragma unroll
        for (int j = 0; j < 32; ++j) { const int s = lane + 64 * j; ka[j] = (j < jn && s <= ta) ? SC[qa * 2048 + s] : 0u; kb2[j] = (j < jn && s <= tb_) ? SC[(qa + 1) * 2048 + s] : 0u; }
        LDS_WAIT(); __syncthreads();
        if (!DUMMY || (ATDSEL & 4)) AT_RING_START();
        unsigned Ta = 0u, Tb = 0u; bool exa = false, exb = false;
        if (!all) {
            for (int bit = 31; bit >= 0 && !(exa && exb); --bit) {
                const unsigned ca = Ta | (1u << bit), cb = Tb | (1u << bit); int na = 0, nb = 0;
#pragma unroll
                for (int c8 = 0; c8 < 4; ++c8) if (8 * c8 < jn) {
#pragma unroll
                    for (int j = 8 * c8; j < 8 * c8 + 8; j += 4) { AT_CNT4(na, ca, ka[j], ka[j + 1], ka[j + 2], ka[j + 3]); AT_CNT4(nb, cb, kb2[j], kb2[j + 1], kb2[j + 2], kb2[j + 3]); } }
                na = wave_sum_dpp(na); nb = wave_sum_dpp(nb);
                if (!exa) { if (na >= TOPK) Ta = ca; exa = (na == TOPK); }
                if (!exb) { if (nb >= TOPK) Tb = cb; exb = (nb == TOPK); }
            }
        }
#pragma unroll
        for (int qq = 0; qq < 2; ++qq) {
            const int q = qa + qq, t = t0 + q; const unsigned T = qq ? Tb : Ta; const bool ex = qq ? exb : exa;
            int need_eq = 0;
            if (!all && !ex) { int cg = 0;
#pragma unroll
                for (int j = 0; j < 32; ++j) cg += ((qq ? kb2[j] : ka[j]) > T) ? 1 : 0;
                need_eq = TOPK - wave_sum_dpp(cg); }
            int eq_seen = 0;
#pragma unroll
            for (int j = 0; j < 32; ++j) {
                const int s = lane + 64 * j; const unsigned kk = qq ? kb2[j] : ka[j]; bool sel;
                if (all) sel = (s <= t);
                else if (ex) sel = (kk >= T);
                else { const bool eq = (kk == T); const unsigned long long em = __ballot(eq); const int rank = eq_seen + __popcll(em & lt_mask); sel = (kk > T) || (eq && rank < need_eq); eq_seen += __popcll(em); }
                const unsigned long long sm = __ballot(sel);
                if (lane == 0) { MASK[q * 64 + 2 * j] = (unsigned)sm; MASK[q * 64 + 2 * j + 1] = (unsigned)(sm >> 32); }
            }
        }
    }
    LDS_WAIT(); __syncthreads();
    asm volatile("" : "+v"(tid)); lane = tid & 63; g = lane >> 4; n = lane & 15;
    if (!DUMMY || (ATDSEL & 4)) {
        const int q = 2 * w + (n >> 3), hh = n & 7, t = t0 + q;
        bf16* qrow = proj + (rowb + t) * DINP + P_AQ + hh * RK;
        if (DUMMY && !(ATDSEL & 2)) AT_RING_START();
        f32x4 O[16]; f32x4 OL = (f32x4){0.f, 0.f, 0.f, 0.f};
        const float b31 = BIAS[128 * 8 + hh];
        int rbase[2], tbase[2][2];
#pragma unroll
        for (int tt = 0; tt < 2; ++tt) { const int row = 8 * (n >> 2) + 4 * tt + (n & 3); rbase[tt] = 2048 * (row >> 3) + 64 * (row & 7) + 16 * (g ^ ((row >> 2) & 3)); }
#pragma unroll
        for (int tt = 0; tt < 2; ++tt)
#pragma unroll
            for (int od = 0; od < 2; ++od) { const int qq = n >> 2, p = n & 3; const int x = (((od ^ (g & 1)) << 1) | ((p >> 1) ^ tt));
                tbase[tt][od] = 2048 * g + 64 * (4 * tt + qq) + 16 * x + 8 * (p & 1); }
        {
#pragma unroll
        for (int mt = 0; mt < 16; ++mt) O[mt] = (f32x4){0.f, 0.f, 0.f, 0.f};
        asm volatile("s_waitcnt vmcnt(12)" ::: "memory"); __syncthreads();
        bf16x8 fa[2][8]; f32x4 sa[2], cin[2]; v4i16_t va[8][2], vb[8][2]; unsigned bitsw; bf16x8 Pf;
        const bf16x8 ONES = (bf16x8){0x3F80, 0x3F80, 0x3F80, 0x3F80, 0x3F80, 0x3F80, 0x3F80, 0x3F80};
        const unsigned b31u = __builtin_bit_cast(unsigned, b31);
#define AT_CINIT(i_) do { const unsigned bits_ = bitsw >> (8 * g); \
            if ((t0 - (32 * (i_) + 31)) >= 128) { \
                _Pragma("unroll") for (int j = 0; j < 8; ++j) { const unsigned m_ = (unsigned)__builtin_amdgcn_sbfe((int)bits_, j, 1); cin[j >> 2][j & 3] = __builtin_bit_cast(float, (m_ & b31u) | (~m_ & 0xF149F2CAu)); } \
            } else { const int kb = 32 * (i_) + 8 * g; \
                _Pragma("unroll") for (int j = 0; j < 8; ++j) { int dist = t - (kb + j); dist = dist < 0 ? 0 : (dist > 128 ? 128 : dist); const unsigned bv_ = __builtin_bit_cast(unsigned, BIAS[dist * 8 + hh]); \
                    const unsigned m_ = (unsigned)__builtin_amdgcn_sbfe((int)bits_, j, 1); cin[j >> 2][j & 3] = __builtin_bit_cast(float, (m_ & bv_) | (~m_ & 0xF149F2CAu)); } } } while (0)
#define AT_FA(tt_, b_) do { _Pragma("unroll") for (int ks = 0; ks < 8; ++ks) fa[tt_][ks] = lds_rd128((b_) + rbase[tt_] + (ks >> 2) * 8192 + 512 * (ks & 3)); } while (0)
#define AT_S(tt_) do { asm volatile("" : "+v"(fa[tt_][0]), "+v"(fa[tt_][1]), "+v"(fa[tt_][2]), "+v"(fa[tt_][3]), "+v"(fa[tt_][4]), "+v"(fa[tt_][5]), "+v"(fa[tt_][6]), "+v"(fa[tt_][7]));        \
            __builtin_amdgcn_s_setprio(1); sa[tt_] = cin[tt_]; _Pragma("unroll") for (int ks = 0; ks < 8; ++ks) sa[tt_] = MFMA16(fa[tt_][ks], Qf[ks], sa[tt_]); __builtin_amdgcn_s_setprio(0); } while (0)
#define AT_TR(b_) do { _Pragma("unroll") for (int mt = 0; mt < 8; ++mt) { const int off = 512 * (mt >> 1); va[mt][0] = lds_tr64((b_) + tbase[0][mt & 1] + off); va[mt][1] = lds_tr64((b_) + tbase[1][mt & 1] + off); } \
            _Pragma("unroll") for (int mt = 0; mt < 8; ++mt) { const int off = 8192 + 512 * (mt >> 1); vb[mt][0] = lds_tr64((b_) + tbase[0][mt & 1] + off); vb[mt][1] = lds_tr64((b_) + tbase[1][mt & 1] + off); } } while (0)
#define AT_SOFTMAX(i_) do { v4u pw; pw.x = pk2(__builtin_amdgcn_exp2f(sa[0][0]), __builtin_amdgcn_exp2f(sa[0][1])); pw.y = pk2(__builtin_amdgcn_exp2f(sa[0][2]), __builtin_amdgcn_exp2f(sa[0][3])); \
            pw.z = pk2(__builtin_amdgcn_exp2f(sa[1][0]), __builtin_amdgcn_exp2f(sa[1][1])); pw.w = pk2(__builtin_amdgcn_exp2f(sa[1][2]), __builtin_amdgcn_exp2f(sa[1][3])); Pf = __builtin_bit_cast(bf16x8, pw); } while (0)
#define AT_PV(vx_, o0_) do { __builtin_amdgcn_s_setprio(1); _Pragma("unroll") for (int mt = 0; mt < 8; ++mt) { const bf16x8 a = (bf16x8){vx_[mt][0][0], vx_[mt][0][1], vx_[mt][0][2], vx_[mt][0][3], vx_[mt][1][0], vx_[mt][1][1], vx_[mt][1][2], vx_[mt][1][3]}; \
            O[(o0_) + mt] = MFMA16(a, Pf, O[(o0_) + mt]); } __builtin_amdgcn_s_setprio(0); } while (0)
#define AT_SB() __builtin_amdgcn_sched_barrier(0)
#define AT_LOOP(ROT_) do { AT_FA(0, L + AT_KV); AT_FA(1, L + AT_KV); bitsw = MASK[q * 64]; AT_SB(); AT_CINIT(0); AT_S(0); AT_S(1); AT_SB(); AT_TR(L + AT_KV); AT_SB(); if (!(ROT_)) { AT_SOFTMAX(0); AT_SB(); } \
        for (int it = 0; it < nt32; ++it) { \
            const LAS unsigned char* nbuf = L + AT_KV + ((it + 1) & 7) * AT_KVBUF; \
              \
            if (DUMMY && ATNOBAR) asm volatile("s_waitcnt vmcnt(10)" ::: "memory"); else if (ROT_) asm volatile("s_waitcnt vmcnt(10)\n\ts_barrier" ::: "memory"); else asm volatile("s_waitcnt vmcnt(10) lgkmcnt(0)\n\ts_barrier" ::: "memory"); \
            if (ROT_) { AT_SOFTMAX(it); AT_SB(); } \
            { const unsigned mw_ = MASK[q * 64 + it + 1]; bitsw = (it + 1 < nt32) ? mw_ : 0u; }        \
            if (!(DUMMY && ATNODMA)) AT_LOAD(AT_TILE(it + 7), (it + 7) & 7); \
            AT_FA(0, nbuf); AT_SB(); AT_PV(va, 0); OL = MFMA16(ONES, Pf, OL); AT_SB(); AT_CINIT(it + 1); AT_SB(); AT_FA(1, nbuf); AT_SB(); AT_S(0); AT_SB(); AT_PV(vb, 8); AT_SB(); AT_S(1); AT_SB(); \
            AT_TR(nbuf); AT_SB(); \
            if (!(ROT_)) { AT_SOFTMAX(it + 1); AT_SB(); } \
        } } while (0)
        if (w < 4) { asm volatile("; order A" ::: "memory"); AT_LOOP(false); } else { asm volatile("; order B" ::: "memory"); AT_LOOP(true); }
#undef AT_LOOP
#undef AT_FA
#undef AT_S
#undef AT_TR
#undef AT_SOFTMAX
#undef AT_CINIT
#undef AT_PV
#undef AT_SB
        asm volatile("s_waitcnt vmcnt(0)" ::: "memory"); __syncthreads();
        }
#undef AT_LOAD
#undef AT_GLDS
#undef AT_TILE
        const float inv = 1.0f / OL[0];
#pragma unroll
        for (int k = 0; k < 8; ++k) {
            unsigned ax = pk2(O[2 * k][0] * inv, O[2 * k][1] * inv), ay = pk2(O[2 * k][2] * inv, O[2 * k][3] * inv);
            unsigned bx = pk2(O[2 * k + 1][0] * inv, O[2 * k + 1][1] * inv), by = pk2(O[2 * k + 1][2] * inv, O[2 * k + 1][3] * inv);
            { const auto r_ = __builtin_amdgcn_permlane16_swap(ax, bx, false, false); ax = r_[0]; bx = r_[1]; }
            { const auto r_ = __builtin_amdgcn_permlane16_swap(ay, by, false, false); ay = r_[0]; by = r_[1]; }
            const v4u o = {ax, ay, bx, by};
            const int d0 = (g & 1) ? 32 * k + 16 + 4 * (g - 1) : 32 * k + 4 * g;
            if (DUMMY) *(GAS v4u*)((bf16*)(F.ws + WS_HM) + (rowb + t) * D + hh * RK + d0) = o; else *(GAS v4u*)(qrow + d0) = o; }
    }
    __syncthreads();
}
template <bool DUMMY> __device__ __forceinline__ void p_attn(Frame& F_, const float* relb) {
    Frame F = F_; const int tid = fresh_tid(F.wave);
    LAS float* BIAS = (LAS float*)(F.lds + AT_BIAS);
    for (int i = tid; i < 129 * 8; i += NWAVES * 64) { const int nn = i >> 3, hh = i & 7; BIAS[i] = relb[t5_bucket_dev(nn) * AH + hh] * 1.4426950408889634f; }
    __syncthreads();
    for (int k = 0; k < 4; ++k) { const int pi = 2 * F.vcu + (k >> 1); if (pi >= BATCH * 64) break; const int b = pi >> 6, x = pi & 63; attn_unit<DUMMY>(F, b, (k & 1) ? (127 - x) : x, tid); }
}

constexpr int ML_Q = 0, ML_K = 16384, ML_V = 32768, ML_VW = 49152, ML_P = 65536, ML_PSTR = 144, ML_BC = ML_P + 64 * ML_PSTR, ML_AV = ML_BC + 8192, ML_PM = ML_AV + 8192,
              ML_MST = ML_PM + 8192, ML_NV = ML_MST + 256, ML_DINV = ML_NV + 512, ML_END = ML_DINV + 256;
static_assert(ML_END <= RING_BYTES, "mLSTM LDS");
__device__ __forceinline__ int img_off(int row, int ch) { const int r = row & 31; return 8192 * (row >> 5) + 2048 * (r >> 3) + 512 * (ch >> 2) + 64 * (r & 7) + 16 * ((ch & 3) ^ ((r >> 2) & 3)); }

__device__ __forceinline__ void mlstm_unit(Frame& F, const float* igb_, const float* fgb_, int l, int b, int hh, int half, int tid) {
    const int lane = tid & 63, w = __builtin_amdgcn_readfirstlane(tid >> 6), g = lane >> 4, n = lane & 15;
    const bf16* proj = (const bf16*)(F.ws + WS_PROJ); const bf16* mqk = (const bf16*)(F.ws + WS_MQK); bf16* hraw = (bf16*)(F.ws + WS_HRAW);
    LAS unsigned char* L = F.lds;
    LAS float* BC = (LAS float*)(L + ML_BC); LAS float* AV = (LAS float*)(L + ML_AV); LAS float* PM = (LAS float*)(L + ML_PM); LAS float* MST = (LAS float*)(L + ML_MST);
    LAS float* NV = (LAS float*)(L + ML_NV); LAS float* DINV = (LAS float*)(L + ML_DINV);
    const size_t rowb = (size_t)b * SEQ;
    {
        const float igb = igb_[l * MH + hh], fgb = fgb_[l * MH + hh];
        for (int cc = 0; cc < 4; ++cc) { const int tok = (4 * w + cc) * 64 + lane;
            const float ig = bf2f(proj[(rowb + tok) * DINP + P_MI + hh]) + igb;
            const float fp = bf2f(proj[(rowb + tok) * DINP + P_MF + hh]) + fgb;
            const float lf = fminf(fp, 0.f) - log1pf(__expf(-fabsf(fp)));
            float bc = lf;
#pragma unroll
            for (int o = 1; o < 64; o <<= 1) { const float v = __shfl_up(bc, o); if (lane >= o) bc += v; }
            const float a = ig - bc; float pm = a;
#pragma unroll
            for (int o = 1; o < 64; o <<= 1) { const float v = __shfl_up(pm, o); if (lane >= o) pm = fmaxf(pm, v); }
            BC[tok] = bc; AV[tok] = a; PM[tok] = pm; }
        if (tid < 128) NV[tid] = 0.f;
        for (int i = tid; i < 64 * ML_PSTR / 4; i += 512) ((LAS unsigned*)(L + ML_P))[i] = 0u;
    }
    LDS_WAIT(); __syncthreads();
    if (tid == 0) { float m = 0.f; MST[0] = 0.f; for (int c = 0; c < NCHUNK; ++c) { m = BC[64 * c + 63] + fmaxf(m, PM[64 * c + 63]); MST[c + 1] = m; } }
    int ld_off[2]; const bf16* ld_q[2]; const bf16* ld_v[2];
#pragma unroll
    for (int i = 0; i < 2; ++i) { const int idx = tid + 512 * i, r = idx >> 4, ch = idx & 15; ld_off[i] = img_off(r, ch);
        ld_q[i] = mqk + (rowb + r) * 1024 + hh * DK + ch * 8; ld_v[i] = proj + (rowb + r) * DINP + P_MV + hh * DV + half * 128 + ch * 8; }
    const int rr_base = img_off(n, g);
    int tb[2][2];
#pragma unroll
    for (int tt = 0; tt < 2; ++tt)
#pragma unroll
        for (int od = 0; od < 2; ++od) { const int qq = n >> 2, p = n & 3; const int x = (((od ^ (g & 1)) << 1) | ((p >> 1) ^ tt)); tb[tt][od] = 2048 * g + 64 * (4 * tt + qq) + 16 * x + 8 * (p & 1); }
#define ML_TR(img, ks, c, tt) lds_tr64(L + (img) + 8192 * (ks) + 512 * ((c) >> 1) + tb[tt][(c) & 1])
    f32x4 Cacc[8];
#pragma unroll
    for (int mt = 0; mt < 8; ++mt) Cacc[mt] = (f32x4){0.f, 0.f, 0.f, 0.f};
    v4u rq[2], rk[2], rv[2];
#pragma unroll
    for (int i = 0; i < 2; ++i) { rq[i] = *(const GAS v4u*)(ld_q[i]); rk[i] = *(const GAS v4u*)(ld_q[i] + 512); rv[i] = *(const GAS v4u*)(ld_v[i]); }
    __syncthreads();
    for (int c = 0; c < NCHUNK; ++c) {
        const float mst = MST[c], mnew = MST[c + 1], blast = BC[64 * c + 63];
#pragma unroll
        for (int i = 0; i < 2; ++i) { const int idx = tid + 512 * i, r = idx >> 4;
            *(LAS v4u*)(L + ML_Q + ld_off[i]) = rq[i]; *(LAS v4u*)(L + ML_K + ld_off[i]) = rk[i]; *(LAS v4u*)(L + ML_V + ld_off[i]) = rv[i];
            const float wk = __expf(blast + AV[64 * c + r] - mnew);
            v4u vw; vw.x = pk2(bflo(rv[i].x) * wk, bfhi(rv[i].x) * wk); vw.y = pk2(bflo(rv[i].y) * wk, bfhi(rv[i].y) * wk); vw.z = pk2(bflo(rv[i].z) * wk, bfhi(rv[i].z) * wk); vw.w = pk2(bflo(rv[i].w) * wk, bfhi(rv[i].w) * wk);
            *(LAS v4u*)(L + ML_VW + ld_off[i]) = vw; }
        LDS_WAIT(); __syncthreads();
        if (c + 1 < NCHUNK) {
#pragma unroll
            for (int i = 0; i < 2; ++i) { const size_t adv = (size_t)(c + 1) * 64; rq[i] = *(const GAS v4u*)(ld_q[i] + adv * 1024); rk[i] = *(const GAS v4u*)(ld_q[i] + adv * 1024 + 512); rv[i] = *(const GAS v4u*)(ld_v[i] + adv * DINP); } }
        for (int ti = w; ti < 10; ti += 8) {
            const int kt = (int)((0x3221110000ull >> (4 * ti)) & 15ull), nt = (int)((0x3323213210ull >> (4 * ti)) & 15ull);
            bf16x8 fa[4], fb[4];
#pragma unroll
            for (int ks = 0; ks < 4; ++ks) { fa[ks] = lds_rd128(L + ML_K + img_off(16 * kt + n, 4 * ks + g)); fb[ks] = lds_rd128(L + ML_Q + img_off(16 * nt + n, 4 * ks + g)); }
            const int j = 16 * nt + n; const float pmj = PM[64 * c + j];
            const f32x4 av = *(const LAS f32x4*)(AV + 64 * c + 16 * kt + 4 * g);
            __builtin_amdgcn_sched_barrier(0);
            f32x4 s = (f32x4){0.f, 0.f, 0.f, 0.f};
#pragma unroll
            for (int ks = 0; ks < 4; ++ks) s = MFMA16(fa[ks], fb[ks], s);
            const float mx = fmaxf(mst, pmj);
            float pv[4];
#pragma unroll
            for (int e = 0; e < 4; ++e) { const int sk = 16 * kt + 4 * g + e; pv[e] = (sk <= j) ? s[e] * __expf(av[e] - mx) : 0.f; }
            v2u pw; pw.x = pk2(pv[0], pv[1]); pw.y = pk2(pv[2], pv[3]);
            *(LAS v2u*)(L + ML_P + j * ML_PSTR + (16 * kt + 4 * g) * 2) = pw;
        }
        f32x4 dacc = (f32x4){0.f, 0.f, 0.f, 0.f};
        if (w < 4) {
            f32x4 n0[4], n1[4]; bf16x8 bqd[4];
#pragma unroll
            for (int ks = 0; ks < 4; ++ks) { n0[ks] = *(const LAS f32x4*)(NV + 32 * ks + 8 * g); n1[ks] = *(const LAS f32x4*)(NV + 32 * ks + 8 * g + 4); bqd[ks] = lds_rd128(L + ML_Q + img_off(16 * w + n, 4 * ks + g)); }
            __builtin_amdgcn_sched_barrier(0);
#pragma unroll
            for (int ks = 0; ks < 4; ++ks) {
                v4u aw; aw.x = pk2(n0[ks][0], n0[ks][1]); aw.y = pk2(n0[ks][2], n0[ks][3]); aw.z = pk2(n1[ks][0], n1[ks][1]); aw.w = pk2(n1[ks][2], n1[ks][3]);
                if (n != 0) { aw.x = 0u; aw.y = 0u; aw.z = 0u; aw.w = 0u; }
                dacc = MFMA16(__builtin_bit_cast(bf16x8, aw), bqd[ks], dacc); }
        }
        LDS_WAIT(); __syncthreads();
        const float mxw = fmaxf(mst, PM[64 * c + 16 * (w & 3) + n]);
        bf16x8 bpd[2];
        if (w < 4) {
#pragma unroll
            for (int ks = 0; ks < 2; ++ks) bpd[ks] = lds_rd128(L + ML_P + (16 * w + n) * ML_PSTR + (32 * ks + 8 * g) * 2);
        }
        f32x4 avn[2][2]; v4i16_t klo[2], khi[2];
#pragma unroll
        for (int ks = 0; ks < 2; ++ks) { avn[ks][0] = *(const LAS f32x4*)(AV + 64 * c + 32 * ks + 8 * g); avn[ks][1] = *(const LAS f32x4*)(AV + 64 * c + 32 * ks + 8 * g + 4); klo[ks] = ML_TR(ML_K, ks, w, 0); khi[ks] = ML_TR(ML_K, ks, w, 1); }
        v2u qb0[4][4], qb1[4][4]; float pmn[4];
#pragma unroll
        for (int nt = 0; nt < 4; ++nt) { const int row = 16 * nt + n; pmn[nt] = PM[64 * c + row];
#pragma unroll
            for (int s4 = 0; s4 < 4; ++s4) { qb0[nt][s4] = *(const LAS v2u*)(L + ML_Q + img_off(row, 4 * s4 + (g >> 1)) + 8 * (g & 1)); qb1[nt][s4] = *(const LAS v2u*)(L + ML_Q + img_off(row, 4 * s4 + 2 + (g >> 1)) + 8 * (g & 1)); } }
        const float nvold = (g == 0) ? NV[16 * w + n] : 0.f;
        __builtin_amdgcn_sched_barrier(0);
        if (w < 4) {
            const float wint = __expf(mst - mxw);
            dacc = dacc * wint;
            v4u ow; ow.x = (n == 0) ? 0x3f803f80u : 0u; ow.y = ow.x; ow.z = ow.x; ow.w = ow.x;
#pragma unroll
            for (int ks = 0; ks < 2; ++ks) dacc = MFMA16(__builtin_bit_cast(bf16x8, ow), bpd[ks], dacc);
            if (g == 0) { const float den = dacc[0]; const float mrow = BC[64 * c + 16 * w + n] + mxw; DINV[16 * w + n] = 1.0f / fmaxf(fabsf(den), __expf(-mrow)); }
        }
        {
            f32x4 nacc = (f32x4){0.f, 0.f, 0.f, 0.f};
#pragma unroll
            for (int ks = 0; ks < 2; ++ks) {
                float wkv[8];
#pragma unroll
                for (int jj = 0; jj < 8; ++jj) wkv[jj] = __expf(blast + avn[ks][jj >> 2][jj & 3] - mnew);
                v4u aw; aw.x = pk2(wkv[0], wkv[1]); aw.y = pk2(wkv[2], wkv[3]); aw.z = pk2(wkv[4], wkv[5]); aw.w = pk2(wkv[6], wkv[7]);
                if (n != 0) { aw.x = 0u; aw.y = 0u; aw.z = 0u; aw.w = 0u; }
                const bf16x8 bk = (bf16x8){klo[ks][0], klo[ks][1], klo[ks][2], klo[ks][3], khi[ks][0], khi[ks][1], khi[ks][2], khi[ks][3]};
                nacc = MFMA16(__builtin_bit_cast(bf16x8, aw), bk, nacc); }
            if (g == 0) { const float decay = __expf(blast + mst - mnew); NV[16 * w + n] = decay * nvold + nacc[0]; }
        }
        f32x4 Hacc[4];
        {
            v4u awc[4];
#pragma unroll
            for (int s4 = 0; s4 < 4; ++s4) { awc[s4].x = pk2(Cacc[2 * s4][0], Cacc[2 * s4][1]); awc[s4].y = pk2(Cacc[2 * s4][2], Cacc[2 * s4][3]); awc[s4].z = pk2(Cacc[2 * s4 + 1][0], Cacc[2 * s4 + 1][1]); awc[s4].w = pk2(Cacc[2 * s4 + 1][2], Cacc[2 * s4 + 1][3]); }
#pragma unroll
            for (int nt = 0; nt < 4; ++nt) {
                f32x4 h = (f32x4){0.f, 0.f, 0.f, 0.f};
#pragma unroll
                for (int s4 = 0; s4 < 4; ++s4) { v4u bw; bw.x = qb0[nt][s4].x; bw.y = qb0[nt][s4].y; bw.z = qb1[nt][s4].x; bw.w = qb1[nt][s4].y;
                    h = MFMA16(__builtin_bit_cast(bf16x8, awc[s4]), __builtin_bit_cast(bf16x8, bw), h); }
                const float wint = __expf(mst - fmaxf(mst, pmn[nt]));
                Hacc[nt] = h * wint;
            }
        }
        __builtin_amdgcn_sched_barrier(0);
        v4i16_t vlo2[2], vhi2[2], wlo2[2], whi2[2]; bf16x8 bpp[2][4]; v4i16_t alo[2][8], ahi[2][8];
#pragma unroll
        for (int ks = 0; ks < 2; ++ks) { vlo2[ks] = ML_TR(ML_V, ks, w, 0); vhi2[ks] = ML_TR(ML_V, ks, w, 1);
#pragma unroll
            for (int nt = 0; nt < 4; ++nt) bpp[ks][nt] = lds_rd128(L + ML_P + (16 * nt + n) * ML_PSTR + (32 * ks + 8 * g) * 2); }
#define ML_STATE_READS(ks_) do { wlo2[ks_] = ML_TR(ML_VW, ks_, w, 0); whi2[ks_] = ML_TR(ML_VW, ks_, w, 1); \
            _Pragma("unroll") for (int mt = 0; mt < 8; ++mt) { alo[ks_][mt] = ML_TR(ML_K, ks_, mt, 0); ahi[ks_][mt] = ML_TR(ML_K, ks_, mt, 1); } } while (0)
#define ML_STATE_MMA(ks_) do { const bf16x8 bv = (bf16x8){wlo2[ks_][0], wlo2[ks_][1], wlo2[ks_][2], wlo2[ks_][3], whi2[ks_][0], whi2[ks_][1], whi2[ks_][2], whi2[ks_][3]}; \
            _Pragma("unroll") for (int mt = 0; mt < 8; ++mt) { const bf16x8 ak = (bf16x8){alo[ks_][mt][0], alo[ks_][mt][1], alo[ks_][mt][2], alo[ks_][mt][3], ahi[ks_][mt][0], ahi[ks_][mt][1], ahi[ks_][mt][2], ahi[ks_][mt][3]}; \
                Cacc[mt] = MFMA16(ak, bv, Cacc[mt]); } } while (0)
        ML_STATE_READS(0);
        __builtin_amdgcn_sched_barrier(0);
#pragma unroll
        for (int ks = 0; ks < 2; ++ks) {
            const bf16x8 av = (bf16x8){vlo2[ks][0], vlo2[ks][1], vlo2[ks][2], vlo2[ks][3], vhi2[ks][0], vhi2[ks][1], vhi2[ks][2], vhi2[ks][3]};
#pragma unroll
            for (int nt = 0; nt < 4; ++nt) Hacc[nt] = MFMA16(av, bpp[ks][nt], Hacc[nt]);
        }
        __builtin_amdgcn_sched_barrier(0);
        ML_STATE_READS(1);
        __builtin_amdgcn_sched_barrier(0);
        {
            const float decay = __expf(blast + mst - mnew);
#pragma unroll
            for (int mt = 0; mt < 8; ++mt) Cacc[mt] = Cacc[mt] * decay;
            ML_STATE_MMA(0); ML_STATE_MMA(1);
        }
#undef ML_STATE_READS
#undef ML_STATE_MMA
        LDS_WAIT(); __syncthreads();
#pragma unroll
        for (int nt = 0; nt < 4; ++nt) { const int j = 16 * nt + n; const float di = DINV[j];
            v2u o; o.x = pk2(Hacc[nt][0] * di, Hacc[nt][1] * di); o.y = pk2(Hacc[nt][2] * di, Hacc[nt][3] * di);
            *(GAS v2u*)(hraw + (rowb + 64 * c + j) * 1024 + hh * DV + half * 128 + 16 * w + 4 * g) = o; }
    }
#undef ML_TR
    __syncthreads();
}
#ifndef CVPROBE
#define CVPROBE 0
#endif
#if CVPROBE
#define CVPROBE_DUP(k_) convert_item(F, l + 1, ((int)ct_ * 4 + (k_)) * 8 + F.wave, fresh_tid(F.wave) & 63);
#else
#define CVPROBE_DUP(k_)
#endif
#ifndef MIX_NCONV
#define MIX_NCONV 96
#endif
constexpr int MIX_CONV0 = 64;
static_assert(CV_ITEMS % 32 == 0, "conversion tickets are four workgroup items");
__device__ __forceinline__ void p_mix(Frame& F_, const float* relb, const float* igb_, const float* fgb_, int l) {
    Frame F = F_; const int tid = fresh_tid(F.wave);
    LAS float* BIAS = (LAS float*)(F.lds + AT_BIAS);
    for (int i = tid; i < 129 * 8; i += NWAVES * 64) { const int nn = i >> 3, hh = i & 7; BIAS[i] = relb[t5_bucket_dev(nn) * AH + hh] * 1.4426950408889634f; }
    __syncthreads();
    int bid_ = (int)blockIdx.x; asm volatile("" : "+s"(bid_));
    const int grp_ = bid_ & 7, rank_ = bid_ >> 3;
    if (rank_ < MH * 2) mlstm_unit(F, igb_, fgb_, l, grp_, rank_ >> 1, rank_ & 1, tid);
    const int tid2 = fresh_tid(F.wave);
    unsigned* ctr = (unsigned*)(F.ctl + CW_ATK + 64 * (8 * l + grp_));
    unsigned* ctrc = (unsigned*)(F.ctl + CW_CVT + 64 * l);
    volatile LAS unsigned* tk = F.MISC + 20;
    const bool has_conv = (l + 1 < DEPTH);
    const bool conv_first = has_conv && bid_ >= MIX_CONV0 && bid_ < MIX_CONV0 + MIX_NCONV;
#define MIX_CONVERT() do { for (;;) { if (tid2 == 0) tk[0] = __hip_atomic_fetch_add(ctrc, 1u, __ATOMIC_RELAXED, __HIP_MEMORY_SCOPE_AGENT); __syncthreads(); const unsigned ct_ = tk[0]; __syncthreads(); \
        if (ct_ >= (unsigned)(CV_ITEMS / 32)) break; \
        { const int ln_ = fresh_tid(F.wave) & 63; LAS unsigned* scr_ = (LAS unsigned*)(F.lds + RING_OFF + F.wave * 16384); f32x4 va_[16], vb_[16]; \
          CvItem ia_ = cv_item(F, l + 1, ((int)ct_ * 4 + 0) * 8 + F.wave, ln_); cv_load(ia_, va_); \
          CvItem ib_ = cv_item(F, l + 1, ((int)ct_ * 4 + 1) * 8 + F.wave, ln_); cv_load(ib_, vb_); cv_finish(ia_, va_, scr_, ln_); \
          ia_ = cv_item(F, l + 1, ((int)ct_ * 4 + 2) * 8 + F.wave, ln_); cv_load(ia_, va_); cv_finish(ib_, vb_, scr_, ln_); \
          ib_ = cv_item(F, l + 1, ((int)ct_ * 4 + 3) * 8 + F.wave, ln_); cv_load(ib_, vb_); cv_finish(ia_, va_, scr_, ln_); cv_finish(ib_, vb_, scr_, ln_); } } } while (0)
    if (conv_first) MIX_CONVERT();
    unsigned mine = 0u;
    if (tid2 == 0) mine = __hip_atomic_fetch_add(ctr, 1u, __ATOMIC_RELAXED, __HIP_MEMORY_SCOPE_AGENT);
    for (;;) {
        if (tid2 == 0) tk[0] = mine;
        __syncthreads();
        const unsigned ticket = tk[0];
        __syncthreads();
        if (ticket >= 128u) break;
        if (tid2 == 0) mine = __hip_atomic_fetch_add(ctr, 1u, __ATOMIC_RELAXED, __HIP_MEMORY_SCOPE_AGENT);
        attn_unit<false>(F, grp_, 127 - (int)ticket, tid2);
#if ATPROBE
        attn_unit<true>(F, grp_, 127 - (int)ticket, tid2);
#endif
    }
    if (has_conv && !conv_first) MIX_CONVERT();
#undef MIX_CONVERT
}

constexpr int PH_PER_LAYER = 12, N_PHASES = 1 + DEPTH * PH_PER_LAYER;
__global__ void __launch_bounds__(NWAVES * 64, 2) trunk_fwd(const Args A) {
    extern __shared__ __attribute__((aligned(16))) unsigned char lds[];
    Frame F;
    F.lds = (LAS unsigned char*)lds;
    F.MISC = (volatile LAS unsigned*)(F.lds + MISC_OFF);
    F.tid = threadIdx.x; F.lane = F.tid & 63; F.wave = __builtin_amdgcn_readfirstlane(F.tid >> 6);
    F.G = gridDim.x; { const int bx = blockIdx.x; F.vcu = (F.G % 8 == 0) ? (bx % 8) * (F.G / 8) + bx / 8 : bx; }
    F.ws = kargs()->ws; F.ctl = (gu32*)(kargs()->ws + WS_CTL); F.out = kargs()->out;
    for (int u = F.tid; u < (LDS_BYTES - LDSCTL_OFF) / 4; u += NWAVES * 64) ((LAS unsigned*)(F.lds + LDSCTL_OFF))[u] = 0u;
    __syncthreads();
    const int lo = kargs()->ph_lo, hi = kargs()->ph_hi;
    const bool multi = (hi - lo) > 1;
    XcdBarrier bar; bar.bar = (unsigned*)(F.ctl + CW_BAR); bar.x = 0; bar.st = nullptr;
    if (multi) bar = xcd_barrier_post((unsigned*)(F.ctl + CW_BAR), F.MISC + 8, (unsigned)gridDim.x);
    const int grp = (int)blockIdx.x & 7;
    XcdBarrier gbar; gbar.bar = (unsigned*)(F.ctl + CW_GBAR + 4096 * grp); gbar.x = 0; gbar.st = nullptr; gbar.G = GROUP_WG;
    if (multi) gbar = xcd_barrier_post((unsigned*)(F.ctl + CW_GBAR + 4096 * grp), F.MISC + 12, GROUP_WG);
#define IN(k) (lo <= (k) && (k) < hi)
    auto lbid = []() { int b_ = (int)blockIdx.x; asm volatile("" : "+s"(b_)); return b_; };
    const LAS float* RTAB = (const LAS float*)(F.lds + AT_MASK);
#define RSTD_TABLE(S_, pm0_) do { const int c_ = lbid(); pm0_ = 8 * (c_ & 7) + ((c_ >> 3) & 7);        \
        const int t_ = fresh_tid(F.wave); if (t_ < 256) { const float* p_ = SSQ + (size_t)(pm0_ * 256 + t_) * 32; float s_ = 0.f; \
        _Pragma("unroll") for (int i_ = 0; i_ < 8; ++i_) { const f32x4 a_ = *(const GAS f32x4*)(p_ + 4 * i_); s_ += (a_.x + a_.y) + (a_.z + a_.w); } \
        ((LAS float*)(F.lds + AT_MASK))[t_] = 1.0f / sqrtf(s_ * (1.0f / 2048.0f) + 1e-6f); } __syncthreads(); } while (0)
#define SEAM(k) do { if (IN(k) && IN((k) + 1)) xcd_barrier(gbar, F.wave); } while (0)
    if (IN(0)) { p_prologue(F); p_xprep(F, kargs()->in[IN_X], (bf16*)(F.ws + WS_XN), (float*)(F.ws + WS_PART)); if (IN(1)) xcd_barrier(bar, F.wave); }
#pragma unroll 1
    for (int l = 0; l < DEPTH; ++l) {
        const int pb = 1 + l * PH_PER_LAYER;
        { unsigned char* ws_ = kargs()->ws; float* out_ = kargs()->out; unsigned ldsb_ = 0u; asm volatile("" : "+s"(ws_), "+s"(out_), "+s"(ldsb_));
          F.ws = ws_; F.out = out_; F.ctl = (gu32*)(ws_ + WS_CTL); F.lds = (LAS unsigned char*)lds + ldsb_;
          }
        bf16* XN = (bf16*)(F.ws + WS_XN); bf16* PROJ = (bf16*)(F.ws + WS_PROJ); bf16* HMB = (bf16*)(F.ws + WS_HM); bf16* YB = (bf16*)(F.ws + WS_Y);
        float* SSQ = (float*)(F.ws + WS_PART);
        unsigned char* wl = F.ws + WS_W + (size_t)l * LAYER_W;
        if (l > 0 && multi) { if (fresh_tid(F.wave) == 0) { unsigned* cvd = (unsigned*)(F.ctl + CW_CVD + 64 * (l - 1)); unsigned sp_ = 0u;
                while (__hip_atomic_load(cvd, __ATOMIC_RELAXED, __HIP_MEMORY_SCOPE_AGENT) < (unsigned)NGROUP) { __builtin_amdgcn_s_sleep(2); if (++sp_ > (1u << 24)) break; }
                __builtin_amdgcn_fence(__ATOMIC_ACQUIRE, "agent"); }
            __syncthreads(); }
        if (IN(pb + 0)) { pg8::Gemm g{XN, (const bf16*)(wl + OW_GU1), M, FF2, D, D, F.wave}; pg8::StaticOrder S; S.init(M, FF2, F.G, lbid());
            int pm0; RSTD_TABLE(S, pm0); pg8::EpiSwiGLU E{PROJ, DINP, SSQ, RTAB, pm0}; pg8::gemm_phase<pg8::EpiSwiGLU, pg8::StaticOrder, true, true>(F.lds + RING_OFF, g, S, E); SEAM(pb + 0); }
        if (IN(pb + 1)) { pg8::Gemm g{PROJ, (const bf16*)(wl + OW_DN1), M, D, FF, DINP, F.wave}; pg8::StaticOrder S; S.init(M, D, F.G, lbid());
            pg8::EpiResid<false, 1> E{XN, D, SSQ, nullptr}; pg8::gemm_phase<pg8::EpiResid<false, 1>, pg8::StaticOrder, true, true>(F.lds + RING_OFF, g, S, E); SEAM(pb + 1); }
        if (IN(pb + 2)) { pg8::Gemm g{XN, (const bf16*)(wl + OW_IN), M, DINP, D, D, F.wave}; pg8::StaticOrder S; S.init(M, DINP, F.G, lbid());
            int pm0; RSTD_TABLE(S, pm0); pg8::EpiProj E{PROJ, DINP, RTAB, (LAS float*)(F.lds + AT_MASK + 1024), kargs()->in[IN_QN] + l * RK, kargs()->in[IN_KVN] + l * RK}; pg8::gemm_phase<pg8::EpiProj, pg8::StaticOrder, true, true>(F.lds + RING_OFF, g, S, E); SEAM(pb + 2); }
        if (IN(pb + 3)) { p_prep(F, l); SEAM(pb + 3); }
        if (IN(pb + 4)) { p_mix(F, kargs()->in[IN_RELB], kargs()->in[IN_IGB], kargs()->in[IN_FGB], l); if (IN(pb + 6)) xcd_barrier(gbar, F.wave);
            if (l + 1 < DEPTH && ((int)blockIdx.x >> 3) == 0 && fresh_tid(F.wave) == 0) __hip_atomic_fetch_add((unsigned*)(F.ctl + CW_CVD + 64 * l), 1u, __ATOMIC_RELAXED, __HIP_MEMORY_SCOPE_AGENT); }
        if (IN(pb + 6)) { p_mpost(F, l); SEAM(pb + 6); }
        if (IN(pb + 7)) { pg8::Gemm g{PROJ + P_AQ, (const bf16*)(wl + OW_AO), M, D, D, DINP, F.wave}; pg8::StaticOrder S; S.init(M, D, F.G, lbid());
            pg8::EpiGate<0> E{YB, D, PROJ + P_GA, DINP}; pg8::gemm_phase<pg8::EpiGate<0>, pg8::StaticOrder, true, true>(F.lds + RING_OFF, g, S, E); if (!IN(pb + 8)) {} else __syncthreads(); }
        if (IN(pb + 8)) { pg8::Gemm g{HMB, (const bf16*)(wl + OW_MO), M, D, 1024, 1024, F.wave}; pg8::StaticOrder S; S.init(M, D, F.G, lbid());
            pg8::EpiGate<1> E{YB, D, PROJ + P_GM, DINP}; pg8::gemm_phase<pg8::EpiGate<1>, pg8::StaticOrder, true, true>(F.lds + RING_OFF, g, S, E); SEAM(pb + 8); }
        if (IN(pb + 9)) { pg8::Gemm g{YB, (const bf16*)(wl + OW_WO), M, D, D, D, F.wave}; pg8::StaticOrder S; S.init(M, D, F.G, lbid());
            pg8::EpiResid<false, 2> E{XN, D, SSQ, nullptr}; pg8::gemm_phase<pg8::EpiResid<false, 2>, pg8::StaticOrder, true, true>(F.lds + RING_OFF, g, S, E); SEAM(pb + 9); }
        if (IN(pb + 10)) { pg8::Gemm g{XN, (const bf16*)(wl + OW_GU2), M, FF2, D, D, F.wave}; pg8::StaticOrder S; S.init(M, FF2, F.G, lbid());
            int pm0; RSTD_TABLE(S, pm0); pg8::EpiSwiGLU E{PROJ, DINP, SSQ, RTAB, pm0}; pg8::gemm_phase<pg8::EpiSwiGLU, pg8::StaticOrder, true, true>(F.lds + RING_OFF, g, S, E); SEAM(pb + 10); }
        if (IN(pb + 11)) { pg8::Gemm g{PROJ, (const bf16*)(wl + OW_DN2), M, D, FF, DINP, F.wave}; pg8::StaticOrder S; S.init(M, D, F.G, lbid());
            if (l + 1 < DEPTH) { pg8::EpiResid<false, 1> E{XN, D, SSQ, nullptr}; pg8::gemm_phase<pg8::EpiResid<false, 1>, pg8::StaticOrder, true, true>(F.lds + RING_OFF, g, S, E); }
            else { pg8::EpiResid<true, 1> E{XN, D, SSQ, F.out}; pg8::gemm_phase<pg8::EpiResid<true, 1>, pg8::StaticOrder, true, true>(F.lds + RING_OFF, g, S, E); }
            SEAM(pb + 11); }
    }
#undef IN
#undef SEAM
}

#ifndef N_LAUNCH_MODE
#define N_LAUNCH_MODE 1
#endif
extern "C" void kernel_launch(void* const* d_in, const int* in_sizes, int n_in, void* d_out, int out_size, void* d_ws, size_t ws_size, hipStream_t stream) {
    static int grid = 0;
    if (grid == 0) {
        if (n_in != 20 || in_sizes[0] != M * D || out_size != M * D || ws_size < WS_END) { fprintf(stderr, "kernel_launch: unexpected shapes / workspace (n_in %d, ws %zu, need %zu)\n", n_in, ws_size, (size_t)WS_END); grid = -1; return; }
        int dev = 0, cus = 0, per_cu = 0;
        if (hipGetDevice(&dev) != hipSuccess || hipDeviceGetAttribute(&cus, hipDeviceAttributeMultiprocessorCount, dev) != hipSuccess) { grid = -1; return; }
        if (hipFuncSetAttribute((const void*)trunk_fwd, hipFuncAttributeMaxDynamicSharedMemorySize, LDS_BYTES) != hipSuccess) { fprintf(stderr, "kernel_launch: hipFuncSetAttribute failed\n"); grid = -1; return; }
        if (hipOccupancyMaxActiveBlocksPerMultiprocessor(&per_cu, (const void*)trunk_fwd, NWAVES * 64, LDS_BYTES) != hipSuccess || per_cu < 1)
            fprintf(stderr, "kernel_launch: note: occupancy query reports %d workgroups per CU\n", per_cu);
        (void)hipGetLastError();
        grid = cus;
    }
    if (grid < 0) return;
    if (hipMemsetAsync((char*)d_ws + WS_CTL, 0, CTL_ZERO_BYTES, stream) != hipSuccess) return;
    Args a{};
    for (int i = 0; i < 20; ++i) a.in[i] = (const float*)d_in[i];
    a.out = (float*)d_out; a.ws = (unsigned char*)d_ws;
    if (N_LAUNCH_MODE == 1) {
        a.ph_lo = 0; a.ph_hi = N_PHASES;
        hipLaunchKernelGGL(trunk_fwd, dim3(grid), dim3(NWAVES * 64), LDS_BYTES, stream, a);
    } else {
        for (int p = 0; p < N_PHASES; ++p) {
            a.ph_lo = p; a.ph_hi = p + 1; hipLaunchKernelGGL(trunk_fwd, dim3(grid), dim3(NWAVES * 64), LDS_BYTES, stream, a); }
    }
}
```

```cpp
#include <hip/hip_runtime.h>
#include <cstdio>
#include <cstdint>
#include <cmath>

#define GAS __attribute__((address_space(1)))
#define LAS __attribute__((address_space(3)))
typedef unsigned short bf16;
typedef unsigned v4u __attribute__((ext_vector_type(4)));
typedef unsigned v2u __attribute__((ext_vector_type(2)));
typedef float f32x4 __attribute__((ext_vector_type(4)));
typedef float f32x2 __attribute__((ext_vector_type(2)));
typedef short bf16x8 __attribute__((ext_vector_type(8)));
typedef GAS unsigned gu32;

constexpr int BATCH = 8, SEQ = 2048, D = 2048, DEPTH = 4, M = BATCH * SEQ;
constexpr int AH = 8, RK = 256, IH = 8, IDIM = 64, TOPK = 256;
constexpr int MH = 4, DK = 128, DV = 256, CHUNK = 64, NCHUNK = SEQ / CHUNK;
constexpr int FF = 5504, FF2 = 2 * FF;
constexpr int DIN = 10064, DINP = 10240;
constexpr float EPS = 1e-6f;
constexpr int P_AQ = 0, P_CKV = 2048, P_IQ = 2304, P_IK = 2816, P_MQK = 2880, P_MV = 3904, P_MO = 4928, P_GA = 5952, P_GM = 8000, P_IW = 10048, P_MI = 10056, P_MF = 10060;
__host__ __device__ __forceinline__ int win_src_of_dest(int d) {
    if (d < 2880) return d;
    if (d < 5952) return d + 8;
    if (d < 10048) return d + 16;
    if (d < 10056) return 2880 + (d - 10048);
    if (d < 10064) return 5960 + (d - 10056);
    return -1;
}
__host__ __device__ __forceinline__ int gu_src_of_dest(int d) { const int pn = d >> 8, r = d & 255; return (r < 128) ? (pn * 128 + r) : (FF + pn * 128 + (r - 128)); }

constexpr size_t MiB = 1u << 20;
constexpr size_t WS_CTL = 0, CTL_ZERO_BYTES = 1 * MiB;
constexpr size_t SZ_GU = (size_t)FF2 * D * 2, SZ_DN = (size_t)D * FF * 2, SZ_IN = (size_t)DINP * D * 2, SZ_AO = (size_t)D * D * 2, SZ_MO = (size_t)D * 1024 * 2, SZ_WO = (size_t)D * D * 2;
constexpr size_t LAYER_W = 2 * SZ_GU + 2 * SZ_DN + SZ_IN + SZ_AO + SZ_MO + SZ_WO;
constexpr size_t OW_GU1 = 0, OW_DN1 = OW_GU1 + SZ_GU, OW_IN = OW_DN1 + SZ_DN, OW_AO = OW_IN + SZ_IN, OW_MO = OW_AO + SZ_AO, OW_WO = OW_MO + SZ_MO, OW_GU2 = OW_WO + SZ_WO, OW_DN2 = OW_GU2 + SZ_GU;
constexpr size_t WS_W = 1 * MiB;
constexpr size_t WS_XN = WS_W + DEPTH * LAYER_W;
constexpr size_t WS_PROJ = WS_XN + (size_t)M * D * 2;
constexpr size_t WS_MQK = WS_PROJ + (size_t)M * DINP * 2;
constexpr size_t WS_HRAW = WS_MQK + (size_t)M * 1024 * 2;
constexpr size_t WS_HM = WS_HRAW + (size_t)M * 1024 * 2;
constexpr size_t WS_Y = WS_HM + (size_t)M * 1024 * 2;
constexpr size_t WS_PART = WS_Y + (size_t)M * D * 2;
constexpr size_t WS_END = WS_PART + (size_t)M * 32 * 4;
static_assert(WS_END <= (size_t)1440 * 1000 * 1000, "workspace map must fit 4x the largest input tensor");
static_assert((LAYER_W % 256) == 0, "alignment");

constexpr int CW_TMO = 0, CW_CODE = 1;
constexpr int CW_BAR = 4096;
constexpr int CW_TICKET = 8192;
constexpr int CW_CVT = 8192 + 1024;
constexpr int CW_ATK = 12288;
constexpr int CW_CVD = 14336;
constexpr int CW_GBAR = 16384;
constexpr int NGROUP = 8, GROUP_WG = 32;

constexpr int RING_OFF = 0, RING_BYTES = 131072;
constexpr int LDSCTL_OFF = RING_BYTES, MISC_OFF = LDSCTL_OFF + 320;
constexpr int LDS_BYTES = 147456;
constexpr int NWAVES = 8;

#define RLX_AGENT __ATOMIC_RELAXED, __HIP_MEMORY_SCOPE_AGENT
#define LDS_WAIT() asm volatile("s_waitcnt lgkmcnt(0)" ::: "memory")
#define VM_WAIT() asm volatile("s_waitcnt vmcnt(0)" ::: "memory")
__device__ __forceinline__ unsigned f2bf(float f) { unsigned u = __builtin_bit_cast(unsigned, f); return (u + 0x7fffu + ((u >> 16) & 1u)) >> 16; }
typedef __bf16 bf16x2_hw __attribute__((ext_vector_type(2)));
__device__ __forceinline__ unsigned pk2(float lo, float hi) { const f32x2 v = {lo, hi}; const bf16x2_hw b = __builtin_convertvector(v, bf16x2_hw); return __builtin_bit_cast(unsigned, b); }
__device__ __forceinline__ float bflo(unsigned w) { return __builtin_bit_cast(float, w << 16); }
__device__ __forceinline__ float bfhi(unsigned w) { return __builtin_bit_cast(float, w & 0xffff0000u); }
__device__ __forceinline__ float bf2f(bf16 b) { return __builtin_bit_cast(float, ((unsigned)b) << 16); }
__device__ __forceinline__ float silu_f(float g) { return g * __builtin_amdgcn_rcpf(1.0f + __expf(-g)); }
__device__ __forceinline__ float sigm_f(float g) { return __builtin_amdgcn_rcpf(1.0f + __expf(-g)); }
__device__ __forceinline__ float wave_sum(float v) {
#pragma unroll
    for (int o = 1; o < 64; o <<= 1) v += __shfl_xor(v, o);
    return v;
}
__device__ __forceinline__ float wave_max(float v) {
#pragma unroll
    for (int o = 1; o < 64; o <<= 1) v = fmaxf(v, __shfl_xor(v, o));
    return v;
}
__device__ __forceinline__ unsigned sortable_key(float f) { const unsigned u = __builtin_bit_cast(unsigned, f); return (u & 0x80000000u) ? ~u : (u | 0x80000000u); }
__device__ __forceinline__ int t5_bucket_dev(int n) {
    if (n < 16) return n;
    const float v = logf((float)n / 16.0f) / 2.0794415416798357f * 16.0f;
    int large = 16 + (int)v; return large < 31 ? large : 31;
}
__device__ __forceinline__ int wave_sum_dpp(int v) {
    v += __builtin_amdgcn_update_dpp(0, v, 0xB1, 0xF, 0xF, true);
    v += __builtin_amdgcn_update_dpp(0, v, 0x4E, 0xF, 0xF, true);
    v += __builtin_amdgcn_update_dpp(0, v, 0x141, 0xF, 0xF, true);
    v += __builtin_amdgcn_update_dpp(0, v, 0x140, 0xF, 0xF, true);
    v += __builtin_amdgcn_update_dpp(0, v, 0x142, 0xA, 0xF, true);
    v += __builtin_amdgcn_update_dpp(0, v, 0x143, 0xC, 0xF, true);
    return __builtin_amdgcn_readlane(v, 63);
}
__device__ __forceinline__ int fresh_tid(int wave) { int w_ = wave; asm volatile("" : "+s"(w_)); unsigned m_ = ~0u; asm volatile("" : "+s"(m_)); const int l_ = (int)__builtin_amdgcn_mbcnt_hi(m_, __builtin_amdgcn_mbcnt_lo(m_, 0u));     return w_ * 64 + l_; }

namespace pg8 {
#define PG8_LAS __attribute__((address_space(3)))
typedef unsigned short bf16_t;
typedef short bf16x8 __attribute__((ext_vector_type(8)));
typedef float f32x4 __attribute__((ext_vector_type(4)));
typedef unsigned u32x4 __attribute__((ext_vector_type(4)));
constexpr int BM = 256, BK = 64, HALF = 128, HTB = HALF * BK * 2  , STAGE_BYTES = 8 * HTB, NXCD = 8, WGM = 8;

__host__ __device__ __forceinline__ int lds_byte(int r, int c) { const int st = (r >> 4) * 2 + (c >> 5), rr = r & 15, cc = c & 31, ob = rr * 64 + cc * 2; return st * 1024 + (ob ^ (((ob >> 9) & 1) << 5)); }
__host__ __device__ __forceinline__ void stage_rc(int b, int& R, int& C) { const int st = b / 1024, sb = b % 1024, swz = sb ^ (((sb >> 9) & 1) << 5); R = (st >> 1) * 16 + swz / 64; C = (st & 1) * 32 + (swz % 64) / 2; }
__host__ __device__ __forceinline__ int perm32(int rho) { const int n = rho >> 4, i = rho & 15; return 8 * (i >> 2) + 4 * n + (i & 3); }

struct Unit { int pm, pn; };
struct Gemm { const bf16_t* A; const bf16_t* Bt; int M, N, K, lda, wave; };

struct StaticOrder {
    int nM, nN, nwg, G, c;
    __host__ __device__ void init(int M, int N, int G_, int c_) { nM = M / BM; nN = N / BM; nwg = nM * nN; G = G_; c = c_; }
    __host__ __device__ bool next(int i, Unit& u) const {
        const long L = (long)i * G + c; if (L >= nwg) return false;
        int wgid = (int)L; { const int q = nwg / NXCD, r = nwg % NXCD, xcd = wgid % NXCD, off = wgid / NXCD; wgid = (xcd < r ? xcd * (q + 1) : r * (q + 1) + (xcd - r) * q) + off; }
        const int nig = WGM * nN, gid = wgid / nig, fm = gid * WGM, gsz = (nM - fm) < WGM ? (nM - fm) : WGM;
        u.pm = fm + ((wgid % nig) % gsz); u.pn = (wgid % nig) / gsz; return true;
    }
    __device__ __forceinline__ void a_ready(const Unit&) const {}
    __device__ __forceinline__ void done(const Unit&) const {}
};

__device__ __forceinline__ unsigned cvt_pk_bf16(float lo, float hi) { return pk2(lo, hi); }

__device__ __forceinline__ void rows_rstd(float (&rs)[2][4], const float* part, int row0, int fq) {
    f32x4 a[2][4], b[2][4];
#pragma unroll
    for (int ai = 0; ai < 2; ++ai)
#pragma unroll
        for (int m = 0; m < 4; ++m) { const float* p = part + (size_t)(row0 + ai * HALF + m * 16) * 32 + 8 * fq; a[ai][m] = *(const __attribute__((address_space(1))) f32x4*)p; b[ai][m] = *(const __attribute__((address_space(1))) f32x4*)(p + 4); }
#pragma unroll
    for (int ai = 0; ai < 2; ++ai)
#pragma unroll
        for (int m = 0; m < 4; ++m) { float s = ((a[ai][m][0] + a[ai][m][1]) + (a[ai][m][2] + a[ai][m][3])) + ((b[ai][m][0] + b[ai][m][1]) + (b[ai][m][2] + b[ai][m][3]));
            s += __shfl_xor(s, 16); s += __shfl_xor(s, 32); rs[ai][m] = 1.0f / sqrtf(s * (1.0f / 2048.0f) + 1e-6f); }
}
struct EpiBf16 {
    static constexpr bool PERM = true, AFTER_DRAIN = false;
    bf16_t* O; int ldc; const float* ssq; const PG8_LAS float* rtab; int pm0;
    __device__ __forceinline__ void operator()(const f32x4 (&acc)[2][2][4][2], const Unit& u, int wr, int wc, int fr, int fq) const {
        const int row0 = u.pm * BM + wr * 64 + fr; const int col0 = u.pn * BM + wc * 32 + 8 * fq;
#pragma unroll
        for (int ai = 0; ai < 2; ++ai)
#pragma unroll
            for (int m = 0; m < 4; ++m) { const int row = row0 + ai * HALF + m * 16; bf16_t* rowp = O + (size_t)row * ldc + col0;
                const float rs = rtab[wr * 64 + fr + ai * HALF + m * 16];
#pragma unroll
                for (int bj = 0; bj < 2; ++bj) { const f32x4 v0 = acc[ai][bj][m][0] * rs, v1 = acc[ai][bj][m][1] * rs;
                    u32x4 w; w.x = cvt_pk_bf16(v0[0], v0[1]); w.y = cvt_pk_bf16(v0[2], v0[3]); w.z = cvt_pk_bf16(v1[0], v1[1]); w.w = cvt_pk_bf16(v1[2], v1[3]);
                    *(__attribute__((address_space(1))) u32x4*)(rowp + bj * HALF) = w; } }
    }
};
struct EpiProj {
    static constexpr bool PERM = true, AFTER_DRAIN = false;
    bf16_t* O; int ldc; const PG8_LAS float* rtab; PG8_LAS float* tab2; const float* qg; const float* kg;
    __device__ __forceinline__ void operator()(const f32x4 (&acc)[2][2][4][2], const Unit& u, int wr, int wc, int fr, int fq) const {
        typedef __attribute__((address_space(1))) u32x4 gu4; typedef __attribute__((address_space(1))) const f32x4 gcf4;
        const int row0 = u.pm * BM + wr * 64 + fr; const int col0 = u.pn * BM + wc * 32 + 8 * fq;
        if (u.pn <= 8) {
#pragma unroll
            for (int ai = 0; ai < 2; ++ai)
#pragma unroll
                for (int m = 0; m < 4; ++m) { const int rl = wr * 64 + fr + ai * HALF + m * 16; const float rs = rtab[rl]; float s = 0.f;
#pragma unroll
                    for (int bj = 0; bj < 2; ++bj)
#pragma unroll
                        for (int n = 0; n < 2; ++n) { const f32x4 v = acc[ai][bj][m][n] * rs; s += (v[0] * v[0] + v[1] * v[1]) + (v[2] * v[2] + v[3] * v[3]); }
                    s += __shfl_xor(s, 16); s += __shfl_xor(s, 32);
                    if (fq == 0) tab2[rl * 4 + wc] = s; }
            asm volatile("s_waitcnt lgkmcnt(0)\n\ts_barrier" ::: "memory");
            const float* gp = (u.pn < 8 ? qg : kg) + wc * 32 + 8 * fq;
            const float qsc = (u.pn < 8) ? 0.0625f * 1.4426950408889634f : 1.0f;
            f32x4 gv[2][2];
#pragma unroll
            for (int bj = 0; bj < 2; ++bj)
#pragma unroll
                for (int n = 0; n < 2; ++n) gv[bj][n] = *(gcf4*)(gp + bj * HALF + 4 * n);
#pragma unroll
            for (int ai = 0; ai < 2; ++ai)
#pragma unroll
                for (int m = 0; m < 4; ++m) { const int rl = wr * 64 + fr + ai * HALF + m * 16; bf16_t* rowp = O + (size_t)(row0 + ai * HALF + m * 16) * ldc + col0;
                    const f32x4 t4 = *(const PG8_LAS f32x4*)(tab2 + rl * 4);
                    const float rs = qsc * rtab[rl] / sqrtf(((t4[0] + t4[1]) + (t4[2] + t4[3])) * (1.0f / 256.0f) + 1e-6f);
#pragma unroll
                    for (int bj = 0; bj < 2; ++bj) { const f32x4 v0 = acc[ai][bj][m][0] * rs * gv[bj][0], v1 = acc[ai][bj][m][1] * rs * gv[bj][1];
                        u32x4 w; w.x = cvt_pk_bf16(v0[0], v0[1]); w.y = cvt_pk_bf16(v0[2], v0[3]); w.z = cvt_pk_bf16(v1[0], v1[1]); w.w = cvt_pk_bf16(v1[2], v1[3]);
                        *(gu4*)(rowp + bj * HALF) = w; } }
            asm volatile("s_waitcnt lgkmcnt(0)\n\ts_barrier" ::: "memory");
        } else {
#pragma unroll
            for (int ai = 0; ai < 2; ++ai)
#pragma unroll
                for (int m = 0; m < 4; ++m) { bf16_t* rowp = O + (size_t)(row0 + ai * HALF + m * 16) * ldc + col0;
                    const float rs = rtab[wr * 64 + fr + ai * HALF + m * 16];
#pragma unroll
                    for (int bj = 0; bj < 2; ++bj) { const f32x4 v0 = acc[ai][bj][m][0] * rs, v1 = acc[ai][bj][m][1] * rs;
                        u32x4 w; w.x = cvt_pk_bf16(v0[0], v0[1]); w.y = cvt_pk_bf16(v0[2], v0[3]); w.z = cvt_pk_bf16(v1[0], v1[1]); w.w = cvt_pk_bf16(v1[2], v1[3]);
                        *(gu4*)(rowp + bj * HALF) = w; } }
        }
    }
};
struct EpiSwiGLU {
    static constexpr bool PERM = true, AFTER_DRAIN = false;
    bf16_t* O; int ldc; const float* ssq; const PG8_LAS float* rtab; int pm0;
    __device__ __forceinline__ void operator()(const f32x4 (&acc)[2][2][4][2], const Unit& u, int wr, int wc, int fr, int fq) const {
        const int row0 = u.pm * BM + wr * 64 + fr; const int col0 = u.pn * HALF + wc * 32 + 8 * fq;
#pragma unroll
        for (int ai = 0; ai < 2; ++ai)
#pragma unroll
            for (int m = 0; m < 4; ++m) { const int row = row0 + ai * HALF + m * 16; bf16_t* rowp = O + (size_t)row * ldc + col0;
                const float rs = rtab[wr * 64 + fr + ai * HALF + m * 16];
                f32x4 v0, v1;
                {
                    const float nrs_ = rs * -1.4426950408889634f, rsq_ = rs * rs; const f32x2 nrs2 = {nrs_, nrs_}, rsq2 = {rsq_, rsq_}, one2 = {1.0f, 1.0f};
#pragma unroll
                    for (int h = 0; h < 2; ++h) {
                        const f32x2 g0 = {acc[ai][0][m][0][2 * h], acc[ai][0][m][0][2 * h + 1]}, u0 = {acc[ai][1][m][0][2 * h], acc[ai][1][m][0][2 * h + 1]};
                        const f32x2 g1 = {acc[ai][0][m][1][2 * h], acc[ai][0][m][1][2 * h + 1]}, u1 = {acc[ai][1][m][1][2 * h], acc[ai][1][m][1][2 * h + 1]};
                        const f32x2 a0 = g0 * nrs2, a1 = g1 * nrs2; const f32x2 t0 = (g0 * u0) * rsq2, t1 = (g1 * u1) * rsq2;
                        const f32x2 e0 = {__builtin_amdgcn_exp2f(a0.x), __builtin_amdgcn_exp2f(a0.y)}, e1 = {__builtin_amdgcn_exp2f(a1.x), __builtin_amdgcn_exp2f(a1.y)};
                        const f32x2 d0 = e0 + one2, d1 = e1 + one2;
                        const f32x2 r0 = {__builtin_amdgcn_rcpf(d0.x), __builtin_amdgcn_rcpf(d0.y)}, r1 = {__builtin_amdgcn_rcpf(d1.x), __builtin_amdgcn_rcpf(d1.y)};
                        const f32x2 o0 = t0 * r0, o1 = t1 * r1;
                        v0[2 * h] = o0.x; v0[2 * h + 1] = o0.y; v1[2 * h] = o1.x; v1[2 * h + 1] = o1.y; } }
                u32x4 w; w.x = cvt_pk_bf16(v0[0], v0[1]); w.y = cvt_pk_bf16(v0[2], v0[3]); w.z = cvt_pk_bf16(v1[0], v1[1]); w.w = cvt_pk_bf16(v1[2], v1[3]);
                *(__attribute__((address_space(1))) u32x4*)(rowp) = w; }
    }
};
template <bool FINAL, int ALPHA2> struct EpiResid {
    static constexpr bool PERM = true, AFTER_DRAIN = false;
    bf16_t* H; int ldc; float* ssq; float* outf;
    __device__ __forceinline__ void operator()(const f32x4 (&acc)[2][2][4][2], const Unit& u, int wr, int wc, int fr, int fq) const {
        typedef __attribute__((address_space(1))) const u32x4 gcu4; typedef __attribute__((address_space(1))) f32x4 gf4; typedef __attribute__((address_space(1))) u32x4 gu4; typedef __attribute__((address_space(1))) float gf1;
        const int row0 = u.pm * BM + wr * 64 + fr, col0 = u.pn * BM + wc * 32 + 8 * fq;
#pragma unroll
        for (int ai = 0; ai < 2; ++ai) {
            u32x4 hb[4][2];
#pragma unroll
            for (int m = 0; m < 4; ++m)
#pragma unroll
                for (int bj = 0; bj < 2; ++bj) hb[m][bj] = *(gcu4*)(H + (size_t)(row0 + ai * HALF + m * 16) * ldc + col0 + bj * HALF);
#pragma unroll
            for (int m = 0; m < 4; ++m) { const size_t off = (size_t)(row0 + ai * HALF + m * 16) * ldc + col0; float s = 0.f;
#pragma unroll
                for (int bj = 0; bj < 2; ++bj) { const u32x4 h4 = hb[m][bj];
                    f32x4 v0, v1;
                    v0[0] = __builtin_bit_cast(float, h4.x << 16); v0[1] = __builtin_bit_cast(float, h4.x & 0xffff0000u); v0[2] = __builtin_bit_cast(float, h4.y << 16); v0[3] = __builtin_bit_cast(float, h4.y & 0xffff0000u);
                    v1[0] = __builtin_bit_cast(float, h4.z << 16); v1[1] = __builtin_bit_cast(float, h4.z & 0xffff0000u); v1[2] = __builtin_bit_cast(float, h4.w << 16); v1[3] = __builtin_bit_cast(float, h4.w & 0xffff0000u);
                    v0 = v0 + acc[ai][bj][m][0] * (0.5f * (float)ALPHA2); v1 = v1 + acc[ai][bj][m][1] * (0.5f * (float)ALPHA2);
                    if (FINAL) { *(gf4*)(outf + off + bj * HALF) = v0; *(gf4*)(outf + off + bj * HALF + 4) = v1; }
                    else { s += ((v0[0] * v0[0] + v0[1] * v0[1]) + (v0[2] * v0[2] + v0[3] * v0[3])) + ((v1[0] * v1[0] + v1[1] * v1[1]) + (v1[2] * v1[2] + v1[3] * v1[3]));
                        u32x4 w; w.x = cvt_pk_bf16(v0[0], v0[1]); w.y = cvt_pk_bf16(v0[2], v0[3]); w.z = cvt_pk_bf16(v1[0], v1[1]); w.w = cvt_pk_bf16(v1[2], v1[3]);
                        *(gu4*)(H + off + bj * HALF) = w; } }
                if (!FINAL) { s += __shfl_xor(s, 16); s += __shfl_xor(s, 32);
                    if (fq == 0) *(gf1*)(ssq + (size_t)(row0 + ai * HALF + m * 16) * 32 + u.pn * 4 + wc) = s; } }
        }
    }
};
template <int MODE> struct EpiGate {
    static constexpr bool PERM = true, AFTER_DRAIN = false;
    bf16_t* Y; int ldc; const bf16_t* gate; int ldg;
    __device__ __forceinline__ void operator()(const f32x4 (&acc)[2][2][4][2], const Unit& u, int wr, int wc, int fr, int fq) const {
        typedef __attribute__((address_space(1))) const u32x4 gcu4; typedef __attribute__((address_space(1))) u32x4 gu4;
        const int row0 = u.pm * BM + wr * 64 + fr; const int col0 = u.pn * BM + wc * 32 + 8 * fq;
#pragma unroll
        for (int ai = 0; ai < 2; ++ai) {
            u32x4 gw[4][2], yw[4][2];
#pragma unroll
            for (int m = 0; m < 4; ++m)
#pragma unroll
                for (int bj = 0; bj < 2; ++bj) { const int row = row0 + ai * HALF + m * 16; gw[m][bj] = *(gcu4*)(gate + (size_t)row * ldg + col0 + bj * HALF);
                    if (MODE == 1) yw[m][bj] = *(gcu4*)(Y + (size_t)row * ldc + col0 + bj * HALF); }
#pragma unroll
            for (int m = 0; m < 4; ++m) { const int row = row0 + ai * HALF + m * 16; bf16_t* rowp = Y + (size_t)row * ldc + col0;
#pragma unroll
                for (int bj = 0; bj < 2; ++bj) { const u32x4 g4 = gw[m][bj];
                    float gv[8]; gv[0] = __builtin_bit_cast(float, g4.x << 16); gv[1] = __builtin_bit_cast(float, g4.x & 0xffff0000u); gv[2] = __builtin_bit_cast(float, g4.y << 16); gv[3] = __builtin_bit_cast(float, g4.y & 0xffff0000u);
                    gv[4] = __builtin_bit_cast(float, g4.z << 16); gv[5] = __builtin_bit_cast(float, g4.z & 0xffff0000u); gv[6] = __builtin_bit_cast(float, g4.w << 16); gv[7] = __builtin_bit_cast(float, g4.w & 0xffff0000u);
                    float o[8];
#pragma unroll
                    for (int j = 0; j < 4; ++j) { o[j] = sigm_f(gv[j]) * acc[ai][bj][m][0][j]; o[4 + j] = sigm_f(gv[4 + j]) * acc[ai][bj][m][1][j]; }
                    if (MODE == 1) { const u32x4 y4 = yw[m][bj];
                        o[0] += __builtin_bit_cast(float, y4.x << 16); o[1] += __builtin_bit_cast(float, y4.x & 0xffff0000u); o[2] += __builtin_bit_cast(float, y4.y << 16); o[3] += __builtin_bit_cast(float, y4.y & 0xffff0000u);
                        o[4] += __builtin_bit_cast(float, y4.z << 16); o[5] += __builtin_bit_cast(float, y4.z & 0xffff0000u); o[6] += __builtin_bit_cast(float, y4.w << 16); o[7] += __builtin_bit_cast(float, y4.w & 0xffff0000u); }
                    u32x4 w; w.x = cvt_pk_bf16(o[0], o[1]); w.y = cvt_pk_bf16(o[2], o[3]); w.z = cvt_pk_bf16(o[4], o[5]); w.w = cvt_pk_bf16(o[6], o[7]);
                    *(gu4*)(rowp + bj * HALF) = w; } }
        }
    }
};

template <class Epi, class Sched, bool ALIGN_EPI = false, bool SP2 = false>
__device__ __forceinline__ void gemm_phase(PG8_LAS unsigned char* lds, const Gemm g, const Sched& S, const Epi& E) {
    const int tid_ = fresh_tid(g.wave);
    const int tid = tid_, wid = __builtin_amdgcn_readfirstlane(tid >> 6), lane = tid & 63, wr = wid >> 2, wc = wid & 3, fr = lane & 15, fq = lane >> 4;
    const int K = g.K, nt = K / BK;
    unsigned voffA[2], voffB[2];
#pragma unroll
    for (int i = 0; i < 2; ++i) { int R, C; stage_rc(tid * 16 + i * 8192, R, C); const int Rb = Epi::PERM ? ((R & ~31) + perm32(R & 31)) : R;
        voffA[i] = (unsigned)(R * g.lda + C) * 2u; voffB[i] = (unsigned)(Rb * K + C) * 2u; }
    const size_t kstep = (size_t)(BK * 2);
    const size_t hstepB = (size_t)HALF * K * 2, hstepA = (size_t)HALF * g.lda * 2;
    const size_t tstepB = 2 * hstepB, tstepA = 2 * hstepA;
    const unsigned ldsw = (unsigned)wid * 1024u;
    const int aoff = lds_byte(wr * 64 + fr, fq * 8), boff = lds_byte(wc * 32 + fr, fq * 8);
#define PG8_SA(b, h) (((b) * 2 + (h)) * HTB)
#define PG8_SB(b, h) ((4 + (b) * 2 + (h)) * HTB)
#define PG8_STAGE(bufoff, gbase, voff) do { _Pragma("unroll") for (int _i = 0; _i < 2; ++_i) \
        __builtin_amdgcn_global_load_lds((const unsigned*)((const char*)(gbase) + (voff)[_i]), (PG8_LAS unsigned*)(lds + (bufoff) + ldsw + _i * 8192), 16, 0, 0); } while (0)
#define PG8_LDA(dst, b, h) do { _Pragma("unroll") for (int m = 0; m < 4; ++m) _Pragma("unroll") for (int k = 0; k < 2; ++k) dst[m][k] = *(const PG8_LAS bf16x8*)(lds + PG8_SA(b, h) + aoff + m * 2048 + k * 1024); } while (0)
#define PG8_LDB(dst, b, h) do { _Pragma("unroll") for (int n = 0; n < 2; ++n) _Pragma("unroll") for (int k = 0; k < 2; ++k) dst[n][k] = *(const PG8_LAS bf16x8*)(lds + PG8_SB(b, h) + boff + n * 2048 + k * 1024); } while (0)
#define PG8_MMA(ai, bj, At, Bt) do { __builtin_amdgcn_s_setprio(1); _Pragma("unroll") for (int m = 0; m < 4; ++m) _Pragma("unroll") for (int n = 0; n < 2; ++n) _Pragma("unroll") for (int k = 0; k < 2; ++k) \
        acc[ai][bj][m][n] = __builtin_amdgcn_mfma_f32_16x16x32_bf16(Bt[n][k], At[m][k], acc[ai][bj][m][n], 0, 0, 0); __builtin_amdgcn_s_setprio(0); } while (0)
#define PG8_WAIT_V(n) asm volatile("s_waitcnt vmcnt(" #n ")" ::: "memory")
#define PG8_WAIT_L(n) asm volatile("s_waitcnt lgkmcnt(" #n ")" ::: "memory")
#define PG8_BAR __builtin_amdgcn_s_barrier()
#define PG8_SCHED __builtin_amdgcn_sched_barrier(0)
    Unit cur, nxt; int ui = 0;
    if (!S.next(0, cur)) return;
    f32x4 acc[2][2][4][2];
#pragma unroll
    for (int a = 0; a < 2; ++a)
#pragma unroll
        for (int b = 0; b < 2; ++b)
#pragma unroll
            for (int m = 0; m < 4; ++m)
#pragma unroll
                for (int n = 0; n < 2; ++n) acc[a][b][m][n] = (f32x4){0.f, 0.f, 0.f, 0.f};
    bf16x8 At[4][2], B0[2][2], B1[2][2];
    const char* cA = (const char*)g.A + (size_t)cur.pm * tstepA; const char* cB = (const char*)g.Bt + (size_t)cur.pn * tstepB;
    S.a_ready(cur);
    if constexpr (SP2) {
        PG8_STAGE(PG8_SB(0, 0), cB, voffB); PG8_STAGE(PG8_SB(0, 1), cB + hstepB, voffB); PG8_STAGE(PG8_SA(0, 0), cA, voffA); PG8_STAGE(PG8_SA(0, 1), cA + hstepA, voffA);
        if (wr == 1) PG8_BAR;
        PG8_WAIT_V(2); PG8_BAR;
        PG8_STAGE(PG8_SB(1, 0), cB + kstep, voffB); PG8_STAGE(PG8_SA(1, 0), cA + kstep, voffA); PG8_STAGE(PG8_SB(1, 1), cB + hstepB + kstep, voffB);
        PG8_WAIT_V(6); PG8_BAR;
    } else {
        PG8_STAGE(PG8_SB(0, 0), cB, voffB); PG8_STAGE(PG8_SA(0, 0), cA, voffA); PG8_STAGE(PG8_SB(0, 1), cB + hstepB, voffB); PG8_STAGE(PG8_SA(0, 1), cA + hstepA, voffA);
        if (wr == 1) PG8_BAR;
        PG8_WAIT_V(4); PG8_BAR;
        PG8_STAGE(PG8_SB(1, 0), cB + kstep, voffB); PG8_STAGE(PG8_SA(1, 0), cA + kstep, voffA); PG8_STAGE(PG8_SB(1, 1), cB + hstepB + kstep, voffB);
        PG8_WAIT_V(6); PG8_BAR;
    }
    for (;;) {
        const bool has_next = S.next(ui + 1, nxt);
        const char* nA = has_next ? (const char*)g.A + (size_t)nxt.pm * tstepA : cA; const char* nB = has_next ? (const char*)g.Bt + (size_t)nxt.pn * tstepB : cB;
        for (int t = 0; t < nt; t += 2) {
            const bool last = (t == nt - 2);
            const char* a1 = cA + (size_t)(t + 1) * kstep;
            const char* a2 = last ? nA : cA + (size_t)(t + 2) * kstep; const char* b2 = last ? nB : cB + (size_t)(t + 2) * kstep;
            const char* a3 = a2 + kstep; const char* b3 = b2 + kstep;
            if (last && has_next) S.a_ready(nxt);
            if constexpr (SP2) {
            PG8_LDB(B0, 0, 0); PG8_LDB(B1, 0, 1); PG8_SCHED; PG8_LDA(At, 0, 0); PG8_STAGE(PG8_SA(1, 1), a1 + hstepA, voffA);
            PG8_WAIT_V(8); PG8_WAIT_L(0); PG8_BAR; PG8_MMA(0, 0, At, B0); PG8_MMA(0, 1, At, B1); PG8_BAR; PG8_SCHED;
            PG8_LDA(At, 0, 1); PG8_STAGE(PG8_SB(0, 0), b2, voffB); PG8_STAGE(PG8_SB(0, 1), b2 + hstepB, voffB); PG8_STAGE(PG8_SA(0, 0), a2, voffA);
            PG8_WAIT_V(8); PG8_WAIT_L(0); PG8_BAR; PG8_MMA(1, 0, At, B0); PG8_MMA(1, 1, At, B1); PG8_BAR; PG8_SCHED;
            PG8_LDB(B0, 1, 0); PG8_LDB(B1, 1, 1); PG8_SCHED; PG8_LDA(At, 1, 0); PG8_STAGE(PG8_SA(0, 1), a2 + hstepA, voffA);
            PG8_WAIT_V(8); PG8_WAIT_L(0); PG8_BAR; PG8_MMA(0, 0, At, B0); PG8_MMA(0, 1, At, B1); PG8_BAR; PG8_SCHED;
            PG8_LDA(At, 1, 1); PG8_STAGE(PG8_SB(1, 0), b3, voffB); PG8_STAGE(PG8_SB(1, 1), b3 + hstepB, voffB); PG8_STAGE(PG8_SA(1, 0), a3, voffA);
            PG8_WAIT_V(8); PG8_WAIT_L(0); PG8_BAR; PG8_MMA(1, 0, At, B0); PG8_MMA(1, 1, At, B1); PG8_BAR; PG8_SCHED;
            } else {
            PG8_LDB(B0, 0, 0); PG8_SCHED; PG8_LDA(At, 0, 0); PG8_STAGE(PG8_SA(1, 1), a1 + hstepA, voffA);
            PG8_WAIT_L(8); PG8_BAR; PG8_WAIT_L(0); PG8_MMA(0, 0, At, B0); PG8_BAR; PG8_SCHED;
            PG8_LDB(B1, 0, 1); PG8_STAGE(PG8_SB(0, 0), b2, voffB);
            PG8_BAR; PG8_WAIT_L(0); PG8_MMA(0, 1, At, B1); PG8_BAR;
            PG8_LDA(At, 0, 1); PG8_STAGE(PG8_SA(0, 0), a2, voffA);
            PG8_BAR; PG8_WAIT_L(0); PG8_MMA(1, 0, At, B0); PG8_BAR; PG8_SCHED;
            PG8_STAGE(PG8_SB(0, 1), b2 + hstepB, voffB);
            PG8_WAIT_V(6); PG8_BAR; PG8_MMA(1, 1, At, B1); PG8_BAR;
            PG8_LDB(B0, 1, 0); PG8_SCHED; PG8_LDA(At, 1, 0); PG8_STAGE(PG8_SA(0, 1), a2 + hstepA, voffA);
            PG8_WAIT_L(8); PG8_BAR; PG8_WAIT_L(0); PG8_MMA(0, 0, At, B0); PG8_BAR; PG8_SCHED;
            PG8_LDB(B1, 1, 1); PG8_STAGE(PG8_SB(1, 0), b3, voffB);
            PG8_BAR; PG8_WAIT_L(0); PG8_MMA(0, 1, At, B1); PG8_BAR;
            PG8_LDA(At, 1, 1); PG8_STAGE(PG8_SA(1, 0), a3, voffA);
            PG8_BAR; PG8_WAIT_L(0); PG8_MMA(1, 0, At, B0); PG8_BAR; PG8_SCHED;
            PG8_STAGE(PG8_SB(1, 1), b3 + hstepB, voffB);
            PG8_WAIT_V(6); PG8_BAR; PG8_MMA(1, 1, At, B1); PG8_BAR;
            }
        }
        if constexpr (ALIGN_EPI) { if (wr == 0) PG8_BAR; }
        if constexpr (!Epi::AFTER_DRAIN) { E(acc, cur, wr, wc, fr, fq); S.done(cur); }
        if (!has_next) break;
#pragma unroll
        for (int a = 0; a < 2; ++a)
#pragma unroll
            for (int b = 0; b < 2; ++b)
#pragma unroll
                for (int m = 0; m < 4; ++m)
#pragma unroll
                    for (int n = 0; n < 2; ++n) acc[a][b][m][n] = (f32x4){0.f, 0.f, 0.f, 0.f};
        cur = nxt; cA = nA; cB = nB; ++ui;
        if constexpr (ALIGN_EPI) { if (wr == 1) PG8_BAR; }
    }
    PG8_WAIT_V(0);
    if constexpr (!ALIGN_EPI) { if (wr == 0) PG8_BAR; }
    PG8_BAR;
    if constexpr (Epi::AFTER_DRAIN) { E.fused(acc, cur, wr, wc, fr, fq, lds, wid, lane); S.done(cur); }
#undef PG8_SA
#undef PG8_SB
#undef PG8_STAGE
#undef PG8_LDA
#undef PG8_LDB
#undef PG8_MMA
#undef PG8_WAIT_V
#undef PG8_WAIT_L
#undef PG8_BAR
#undef PG8_SCHED
}
}


#define XB_TMO      128
#define XB_XCNT(j)  (256  + 64 * (j))
#define XB_XSUB(j)  (1280 + 64 * (j))
#define XB_XGEN(j)  (2304 + 64 * (j))
#define XB_TOP      3328
#define XB_TOPGEN   3392
#define XCD_BAR_WORDS 3456
#define XB_SPIN_CAP (1u << 18)

__device__ __forceinline__ unsigned xb_ld(unsigned* p)              { return __hip_atomic_load(p, __ATOMIC_RELAXED, __HIP_MEMORY_SCOPE_AGENT); }
__device__ __forceinline__ unsigned xb_add(unsigned* p, unsigned v) { return __hip_atomic_fetch_add(p, v, __ATOMIC_RELAXED, __HIP_MEMORY_SCOPE_AGENT); }
__device__ __forceinline__ unsigned xb_xcc_id() { return (unsigned)__builtin_amdgcn_s_getreg((3 << 11) | 20) & 0xFu; }
#define XB_SPIN(cond, bar) do { unsigned _sp = 0; while (cond) { __builtin_amdgcn_s_sleep(1); \
    if ((++_sp & 255u) == 0u) { if (xb_ld(&(bar)[XB_TMO])) break; if (_sp > XB_SPIN_CAP) { atomicAdd(&(bar)[XB_TMO], 1u); break; } } } } while (0)

struct XcdBarrier {
    unsigned* bar; unsigned x; unsigned G;
    volatile LAS unsigned* st;
};
__device__ __forceinline__ XcdBarrier xcd_barrier_post(unsigned* bar, volatile LAS unsigned* st, unsigned members) {
    XcdBarrier b; b.bar = bar; b.x = xb_xcc_id(); b.st = st; b.G = members;
    if (threadIdx.x == 0) (void)xb_add(&bar[XB_XCNT(b.x)], 1u);
    return b;
}
__device__ __forceinline__ void xcd_barrier_complete(unsigned* bar, unsigned x, unsigned G, unsigned& nloc, unsigned& nx) {
    unsigned sum, cnt, mine, sp = 0u;
    for (;;) {
        sum = 0u; cnt = 0u; mine = 0u;
#pragma unroll
        for (unsigned j = 0; j < 16; ++j) { const unsigned c = xb_ld(&bar[XB_XCNT(j)]); sum += c; cnt += (c > 0u) ? 1u : 0u; mine = (j == x) ? c : mine; }
        if (sum == G) break;
        __builtin_amdgcn_s_sleep(1);
        if ((++sp & 255u) == 0u) { if (xb_ld(&bar[XB_TMO])) break; if (sp > XB_SPIN_CAP) { atomicAdd(&bar[XB_TMO], 1u); break; } }
    }
    nloc = mine > 0u ? mine : 1u; nx = cnt > 0u ? cnt : 1u;
}
__device__ __forceinline__ void xcd_barrier(const XcdBarrier& b, int wave) {
    asm volatile("s_waitcnt vmcnt(0)" ::: "memory");
    __syncthreads();
    if (fresh_tid(wave) == 0) {
        unsigned* bar = b.bar; asm volatile("" : "+s"(bar));
        __builtin_amdgcn_s_waitcnt(0);
        unsigned nloc = b.st[0], nx = b.st[1];
        if (nloc == 0u) { xcd_barrier_complete(bar, b.x, b.G, nloc, nx); b.st[0] = nloc; b.st[1] = nx; }
        const unsigned old = xb_add(&bar[XB_XSUB(b.x)], 1u);
        const unsigned gen = old / nloc;
        if (old + 1u == (gen + 1u) * nloc) {
            __builtin_amdgcn_fence(__ATOMIC_RELEASE, "agent");
            asm volatile("s_waitcnt vmcnt(0)" ::: "memory");
            if (nx > 1u) {
            const unsigned og = xb_add(&bar[XB_TOP], 1u);
            const unsigned tg = og / nx;
            if (og + 1u == (tg + 1u) * nx) xb_add(&bar[XB_TOPGEN], 1u);
            else XB_SPIN(xb_ld(&bar[XB_TOPGEN]) == tg, bar);
            }
            xb_add(&bar[XB_XGEN(b.x)], 1u);
            __builtin_amdgcn_fence(__ATOMIC_ACQUIRE, "agent");
            asm volatile("s_waitcnt vmcnt(0)" ::: "memory");
        } else {
            XB_SPIN(xb_ld(&bar[XB_XGEN(b.x)]) == gen, bar);
            __builtin_amdgcn_fence(__ATOMIC_ACQUIRE, "agent");
            asm volatile("s_waitcnt vmcnt(0)" ::: "memory");
        }
    }
    __syncthreads();
}

struct Frame {
    LAS unsigned char* lds;
    volatile LAS unsigned* MISC;
    gu32* ctl;
    int tid, lane, wave;
    int vcu, G;
    unsigned char* ws;
    float* out;
};
struct Args { const float* in[20]; float* out; unsigned char* ws; int ph_lo, ph_hi; };
typedef const __attribute__((address_space(4))) Args* KArgs;
__device__ __forceinline__ KArgs kargs() { KArgs p = (KArgs)__builtin_amdgcn_kernarg_segment_ptr(); asm volatile("" : "+s"(p)); return p; }
enum { IN_X = 0, IN_RELB, IN_F1N, IN_F1GU, IN_F1DN, IN_MIXN, IN_WIN, IN_QN, IN_KVN, IN_CONVW, IN_CONVB, IN_IGB, IN_FGB, IN_MON, IN_WAO, IN_WMO, IN_WOUT, IN_F2N, IN_F2GU, IN_F2DN };

template <class SrcMap>
__device__ __forceinline__ void transpose_item(const float* W, int K, int Nsrc, bf16* WT, LAS unsigned* scr, int kb, int db, int lane, const SrcMap& src, const float* gk) {
    const int k0 = 64 * kb, d0 = 64 * db, nq = lane & 15, kq2 = lane >> 4; const int sc = src(d0 + 4 * nq);
    f32x4 v[16];
    const float* wp = W + (size_t)(k0 + 2 * kq2) * Nsrc + (sc >= 0 ? sc : 0);
#pragma unroll
    for (int i = 0; i < 8; ++i) { v[2 * i] = *(const GAS f32x4*)(wp + (size_t)(8 * i) * Nsrc); v[2 * i + 1] = *(const GAS f32x4*)(wp + (size_t)(8 * i + 1) * Nsrc); }
    if (sc < 0) {
#pragma unroll
        for (int i = 0; i < 16; ++i) v[i] = (f32x4){0.f, 0.f, 0.f, 0.f}; }
    if (gk) {
#pragma unroll
        for (int i = 0; i < 8; ++i) { const f32x2 g2 = *(const GAS f32x2*)(gk + k0 + 2 * kq2 + 8 * i); v[2 * i] = v[2 * i] * g2.x; v[2 * i + 1] = v[2 * i + 1] * g2.y; } }
#pragma unroll
    for (int i = 0; i < 8; ++i)
#pragma unroll
        for (int j = 0; j < 4; ++j) scr[(4 * nq + j) * 33 + 4 * i + kq2] = pk2(v[2 * i][j], v[2 * i + 1][j]);
    LDS_WAIT(); asm volatile("" ::: "memory");
    const int c = lane & 7;
#pragma unroll
    for (int r = 0; r < 8; ++r) { const int nn = 8 * r + (lane >> 3); const LAS unsigned* s = scr + nn * 33 + 4 * c;
        v4u o; o.x = s[0]; o.y = s[1]; o.z = s[2]; o.w = s[3];
        *(GAS v4u*)(WT + (size_t)(d0 + nn) * K + k0 + 8 * c) = o; }
    LDS_WAIT(); asm volatile("" ::: "memory");
}
struct SrcIdent { __device__ __forceinline__ int operator()(int d) const { return d; } };
struct SrcGU { __device__ __forceinline__ int operator()(int d) const { return gu_src_of_dest(d); } };
struct SrcWin { __device__ __forceinline__ int operator()(int d) const { return win_src_of_dest(d); } };

template <class SrcMap>
__device__ __forceinline__ void transpose_matrix(Frame& F, const float* W, int K, int Nsrc, int Ndst, bf16* WT, const SrcMap& src, const float* gk = nullptr) {
    const int lane_ = fresh_tid(F.wave) & 63;
    LAS unsigned* scr = (LAS unsigned*)(F.lds + RING_OFF + F.wave * 16384);
    const int gw = F.vcu * NWAVES + F.wave, NGW = F.G * NWAVES;
    const int nkb = K / 64, ndb = Ndst / 64, nit = nkb * ndb;
    for (int it = gw; it < nit; it += NGW) { const int kb = it / ndb, db = it % ndb; transpose_item(W, K, Nsrc, WT, scr, kb, db, lane_, src, gk); }
}
constexpr int CV_GU = (D / 64) * (FF2 / 64), CV_DN = (FF / 64) * (D / 64), CV_IN = (D / 64) * (DINP / 64), CV_AO = (D / 64) * (D / 64), CV_MO = (1024 / 64) * (D / 64), CV_WO = CV_AO;
constexpr int CV_ITEMS = 2 * CV_GU + 2 * CV_DN + CV_IN + CV_AO + CV_MO + CV_WO;
static_assert(CV_ITEMS % 8 == 0, "conversion items are dealt eight (one per wave) at a time");
__device__ __forceinline__ void convert_item(Frame& F, int l, int item, int lane) {
    LAS unsigned* scr = (LAS unsigned*)(F.lds + RING_OFF + F.wave * 16384);
    unsigned char* wl = F.ws + WS_W + (size_t)l * LAYER_W;
    int r = item;
    if (r < CV_GU) { constexpr int ndb = FF2 / 64; transpose_item(kargs()->in[IN_F1GU] + (size_t)l * D * FF2, D, FF2, (bf16*)(wl + OW_GU1), scr, r / ndb, r % ndb, lane, SrcGU(), kargs()->in[IN_F1N] + (size_t)l * D); return; } r -= CV_GU;
    if (r < CV_DN) { constexpr int ndb = D / 64; transpose_item(kargs()->in[IN_F1DN] + (size_t)l * FF * D, FF, D, (bf16*)(wl + OW_DN1), scr, r / ndb, r % ndb, lane, SrcIdent(), nullptr); return; } r -= CV_DN;
    if (r < CV_IN) { constexpr int ndb = DINP / 64; transpose_item(kargs()->in[IN_WIN] + (size_t)l * D * DIN, D, DIN, (bf16*)(wl + OW_IN), scr, r / ndb, r % ndb, lane, SrcWin(), kargs()->in[IN_MIXN] + (size_t)l * D); return; } r -= CV_IN;
    if (r < CV_AO) { constexpr int ndb = D / 64; transpose_item(kargs()->in[IN_WAO] + (size_t)l * D * D, D, D, (bf16*)(wl + OW_AO), scr, r / ndb, r % ndb, lane, SrcIdent(), nullptr); return; } r -= CV_AO;
    if (r < CV_MO) { constexpr int ndb = D / 64; transpose_item(kargs()->in[IN_WMO] + (size_t)l * 1024 * D, 1024, D, (bf16*)(wl + OW_MO), scr, r / ndb, r % ndb, lane, SrcIdent(), nullptr); return; } r -= CV_MO;
    if (r < CV_WO) { constexpr int ndb = D / 64; transpose_item(kargs()->in[IN_WOUT] + (size_t)l * D * D, D, D, (bf16*)(wl + OW_WO), scr, r / ndb, r % ndb, lane, SrcIdent(), nullptr); return; } r -= CV_WO;
    if (r < CV_GU) { constexpr int ndb = FF2 / 64; transpose_item(kargs()->in[IN_F2GU] + (size_t)l * D * FF2, D, FF2, (bf16*)(wl + OW_GU2), scr, r / ndb, r % ndb, lane, SrcGU(), kargs()->in[IN_F2N] + (size_t)l * D); return; } r -= CV_GU;
    { constexpr int ndb = D / 64; transpose_item(kargs()->in[IN_F2DN] + (size_t)l * FF * D, FF, D, (bf16*)(wl + OW_DN2), scr, r / ndb, r % ndb, lane, SrcIdent(), nullptr); }
}
struct CvItem { const float* wp; const float* gk; bf16* out; int Nsrc, K, sc; };
template <class SrcMap>
__device__ __forceinline__ CvItem cv_make(const float* W, int K, int Nsrc, bf16* WT, int kb, int db, int lane, const SrcMap& src, const float* gk) {
    const int k0 = 64 * kb, d0 = 64 * db, nq = lane & 15, kq2 = lane >> 4; const int sc = src(d0 + 4 * nq);
    CvItem it; it.wp = W + (size_t)(k0 + 2 * kq2) * Nsrc + (sc >= 0 ? sc : 0); it.gk = gk ? gk + k0 + 2 * kq2 : nullptr; it.out = WT + (size_t)d0 * K + k0; it.Nsrc = Nsrc; it.K = K; it.sc = sc; return it;
}
__device__ __forceinline__ CvItem cv_item(Frame& F, int l, int item, int lane) {
    unsigned char* wl = F.ws + WS_W + (size_t)l * LAYER_W;
    int r = item;
    if (r < CV_GU) { constexpr int ndb = FF2 / 64; return cv_make(kargs()->in[IN_F1GU] + (size_t)l * D * FF2, D, FF2, (bf16*)(wl + OW_GU1), r / ndb, r % ndb, lane, SrcGU(), kargs()->in[IN_F1N] + (size_t)l * D); } r -= CV_GU;
    if (r < CV_DN) { constexpr int ndb = D / 64; return cv_make(kargs()->in[IN_F1DN] + (size_t)l * FF * D, FF, D, (bf16*)(wl + OW_DN1), r / ndb, r % ndb, lane, SrcIdent(), nullptr); } r -= CV_DN;
    if (r < CV_IN) { constexpr int ndb = DINP / 64; return cv_make(kargs()->in[IN_WIN] + (size_t)l * D * DIN, D, DIN, (bf16*)(wl + OW_IN), r / ndb, r % ndb, lane, SrcWin(), kargs()->in[IN_MIXN] + (size_t)l * D); } r -= CV_IN;
    if (r < CV_AO) { constexpr int ndb = D / 64; return cv_make(kargs()->in[IN_WAO] + (size_t)l * D * D, D, D, (bf16*)(wl + OW_AO), r / ndb, r % ndb, lane, SrcIdent(), nullptr); } r -= CV_AO;
    if (r < CV_MO) { constexpr int ndb = D / 64; return cv_make(kargs()->in[IN_WMO] + (size_t)l * 1024 * D, 1024, D, (bf16*)(wl + OW_MO), r / ndb, r % ndb, lane, SrcIdent(), nullptr); } r -= CV_MO;
    if (r < CV_WO) { constexpr int ndb = D / 64; return cv_make(kargs()->in[IN_WOUT] + (size_t)l * D * D, D, D, (bf16*)(wl + OW_WO), r / ndb, r % ndb, lane, SrcIdent(), nullptr); } r -= CV_WO;
    if (r < CV_GU) { constexpr int ndb = FF2 / 64; return cv_make(kargs()->in[IN_F2GU] + (size_t)l * D * FF2, D, FF2, (bf16*)(wl + OW_GU2), r / ndb, r % ndb, lane, SrcGU(), kargs()->in[IN_F2N] + (size_t)l * D); } r -= CV_GU;
    { constexpr int ndb = D / 64; return cv_make(kargs()->in[IN_F2DN] + (size_t)l * FF * D, FF, D, (bf16*)(wl + OW_DN2), r / ndb, r % ndb, lane, SrcIdent(), nullptr); }
}
__device__ __forceinline__ void cv_load(const CvItem& it, f32x4 (&v)[16]) {
#pragma unroll
    for (int i = 0; i < 8; ++i) { v[2 * i] = *(const GAS f32x4*)(it.wp + (size_t)(8 * i) * it.Nsrc); v[2 * i + 1] = *(const GAS f32x4*)(it.wp + (size_t)(8 * i + 1) * it.Nsrc); }
}
__device__ __forceinline__ void cv_finish(const CvItem& it, f32x4 (&v)[16], LAS unsigned* scr, int lane) {
    const int nq = lane & 15, kq2 = lane >> 4;
    if (it.sc < 0) {
#pragma unroll
        for (int i = 0; i < 16; ++i) v[i] = (f32x4){0.f, 0.f, 0.f, 0.f}; }
    if (it.gk) {
#pragma unroll
        for (int i = 0; i < 8; ++i) { const f32x2 g2 = *(const GAS f32x2*)(it.gk + 8 * i); v[2 * i] = v[2 * i] * g2.x; v[2 * i + 1] = v[2 * i + 1] * g2.y; } }
#pragma unroll
    for (int i = 0; i < 8; ++i)
#pragma unroll
        for (int j = 0; j < 4; ++j) scr[(4 * nq + j) * 33 + 4 * i + kq2] = pk2(v[2 * i][j], v[2 * i + 1][j]);
    LDS_WAIT(); asm volatile("" ::: "memory");
    const int c = lane & 7;
#pragma unroll
    for (int r = 0; r < 8; ++r) { const int nn = 8 * r + (lane >> 3); const LAS unsigned* s = scr + nn * 33 + 4 * c;
        v4u o; o.x = s[0]; o.y = s[1]; o.z = s[2]; o.w = s[3];
        *(GAS v4u*)(it.out + (size_t)nn * it.K + 8 * c) = o; }
    LDS_WAIT(); asm volatile("" ::: "memory");
}
__device__ __forceinline__ void p_prologue(Frame& F) {
    const int lane_ = fresh_tid(F.wave) & 63;
    const int gw = F.vcu * NWAVES + F.wave, NGW = F.G * NWAVES;
    for (int it = gw; it < CV_ITEMS; it += NGW) convert_item(F, 0, it, lane_);
}

__device__ __forceinline__ void p_xprep(Frame& F_, const float* h, bf16* hb, float* ssq) {
    Frame F = F_; F.lane = fresh_tid(F.wave) & 63;
    const int gw = F.vcu * NWAVES + F.wave, NGW = F.G * NWAVES;
    for (int m = gw; m < M; m += NGW) {
        const GAS f32x4* xr = (const GAS f32x4*)(h + (size_t)m * D) + F.lane;
        f32x4 v[8]; float s = 0.f;
#pragma unroll
        for (int j = 0; j < 8; ++j) { v[j] = xr[64 * j]; s += (v[j].x * v[j].x + v[j].y * v[j].y) + (v[j].z * v[j].z + v[j].w * v[j].w); }
        s = wave_sum(s); if (F.lane < 32) ssq[(size_t)m * 32 + F.lane] = (F.lane == 0) ? s : 0.f;
        GAS v2u* o8 = (GAS v2u*)(hb + (size_t)m * D) + F.lane;
#pragma unroll
        for (int j = 0; j < 8; ++j) { v2u o; o.x = pk2(v[j].x, v[j].y); o.y = pk2(v[j].z, v[j].w); o8[64 * j] = o; }
    }
}

__device__ __forceinline__ void p_prep(Frame& F, int l) {
    const int lane = fresh_tid(F.wave) & 63;
    const int gw = F.vcu * NWAVES + F.wave, NGW = F.G * NWAVES;
    bf16* proj = (bf16*)(F.ws + WS_PROJ); bf16* mqk = (bf16*)(F.ws + WS_MQK);
    const float* qg = kargs()->in[IN_QN] + l * RK; const float* kg = kargs()->in[IN_KVN] + l * RK;
    const float* cw = kargs()->in[IN_CONVW] + (size_t)l * 4 * 1024; const float* cb = kargs()->in[IN_CONVB] + (size_t)l * 1024;
    const f32x4 qgv = *((const GAS f32x4*)qg + lane), kgv = *((const GAS f32x4*)kg + lane);
    float w[4][16], cbv[16];
#pragma unroll
    for (int k = 0; k < 4; ++k)
#pragma unroll
        for (int q = 0; q < 4; ++q) { const f32x4 t = *((const GAS f32x4*)(cw + k * 1024 + 16 * lane) + q); w[k][4 * q] = t.x; w[k][4 * q + 1] = t.y; w[k][4 * q + 2] = t.z; w[k][4 * q + 3] = t.w; }
#pragma unroll
    for (int q = 0; q < 4; ++q) { const f32x4 t = *((const GAS f32x4*)(cb + 16 * lane) + q); cbv[4 * q] = t.x; cbv[4 * q + 1] = t.y; cbv[4 * q + 2] = t.z; cbv[4 * q + 3] = t.w; }
    const float kscale = (lane >= 32) ? 0.08838834764831845f : 1.0f;
    for (int j8 = 0; j8 < 8; ++j8) { const int m = (gw >> 8) * SEQ + (gw & 255) + 256 * j8;
        bf16* row = proj + (size_t)m * DINP;
        const int t = m % SEQ;
        float acc[16];
#pragma unroll
        for (int i = 0; i < 16; ++i) acc[i] = cbv[i];
#pragma unroll
        for (int k = 0; k < 4; ++k) { const int tt = t - 3 + k;
            if (tt >= 0) { const GAS v4u* p = (const GAS v4u*)(proj + (size_t)(m - 3 + k) * DINP + P_MQK + 16 * lane); const v4u x0 = p[0], x1 = p[1];
                const unsigned xs[8] = {x0.x, x0.y, x0.z, x0.w, x1.x, x1.y, x1.z, x1.w};
#pragma unroll
                for (int i = 0; i < 8; ++i) { acc[2 * i] += w[k][2 * i] * bflo(xs[i]); acc[2 * i + 1] += w[k][2 * i + 1] * bfhi(xs[i]); } } }
        v4u o0, o1;
#pragma unroll
        for (int i = 0; i < 16; ++i) acc[i] = silu_f(acc[i]) * kscale;
        o0.x = pk2(acc[0], acc[1]); o0.y = pk2(acc[2], acc[3]); o0.z = pk2(acc[4], acc[5]); o0.w = pk2(acc[6], acc[7]);
        o1.x = pk2(acc[8], acc[9]); o1.y = pk2(acc[10], acc[11]); o1.z = pk2(acc[12], acc[13]); o1.w = pk2(acc[14], acc[15]);
        GAS v4u* po = (GAS v4u*)(mqk + (size_t)m * 1024 + 16 * lane); po[0] = o0; po[1] = o1;
    }
}

__device__ __forceinline__ void p_mpost(Frame& F, int l) {
    const int lane = fresh_tid(F.wave) & 63;
    const int gw = F.vcu * NWAVES + F.wave, NGW = F.G * NWAVES;
    const bf16* proj = (const bf16*)(F.ws + WS_PROJ); const bf16* hraw = (const bf16*)(F.ws + WS_HRAW); bf16* hm = (bf16*)(F.ws + WS_HM);
    const float* gn = kargs()->in[IN_MON] + (size_t)l * MH * DV;
    for (int j8 = 0; j8 < 8; ++j8) { const int m = (gw >> 8) * SEQ + (gw & 255) + 256 * j8;
#pragma unroll
        for (int hh = 0; hh < MH; ++hh) {
            const v2u x = *((const GAS v2u*)(hraw + (size_t)m * 1024 + hh * DV) + lane);
            const v2u og = *((const GAS v2u*)(proj + (size_t)m * DINP + P_MO + hh * DV) + lane);
            const f32x4 g = *((const GAS f32x4*)(gn + hh * DV) + lane);
            const float a = bflo(x.x), b = bfhi(x.x), c = bflo(x.y), d = bfhi(x.y);
            const float rstd = 1.0f / sqrtf(wave_sum(a * a + b * b + c * c + d * d) * (1.f / DV) + EPS);
            v2u o; o.x = pk2(a * rstd * g.x * sigm_f(bflo(og.x)), b * rstd * g.y * sigm_f(bfhi(og.x))); o.y = pk2(c * rstd * g.z * sigm_f(bflo(og.y)), d * rstd * g.w * sigm_f(bfhi(og.y)));
            *((GAS v2u*)(hm + (size_t)m * 1024 + hh * DV) + lane) = o;
        }
    }
}

#ifndef ATPROBE
#define ATPROBE 0
#endif
#ifndef ATDSEL
#define ATDSEL 7
#endif
#ifndef ATNT1
#define ATNT1 0
#endif
#ifndef ATNODMA
#define ATNODMA 0
#endif
#ifndef ATNOBAR
#define ATNOBAR 0
#endif
#ifndef ATP1
#define ATP1 1
#endif
#ifndef ATP1B
#define ATP1B 1
#endif
#ifndef ATP2
#define ATP2 1
#endif
constexpr int AT_SC = 0, AT_KV = 0, AT_KVBUF = 16384, AT_NBUF = 8;
constexpr int AT_MASK = 131072 + 512, AT_BIAS = AT_MASK + 4096, AT_THR = AT_BIAS + 4160;
static_assert(AT_THR + 256 <= LDS_BYTES, "attention LDS");
typedef short v4i16_t __attribute__((ext_vector_type(4)));
__device__ __forceinline__ bf16x8 lds_rd128(const LAS unsigned char* p) { return *(const LAS bf16x8*)p; }
__device__ __forceinline__ v4i16_t lds_tr64(const LAS unsigned char* p) { return __builtin_amdgcn_ds_read_tr16_b64_v4i16((LAS v4i16_t*)p); }
#define MFMA16(a, b, c) __builtin_amdgcn_mfma_f32_16x16x32_bf16((a), (b), (c), 0, 0, 0)

#define AT_CNT4(n_, c_, k0_, k1_, k2_, k3_) do { unsigned long long t0_, t1_, t2_, t3_; \
    asm volatile("v_cmp_le_u32_e64 %1, %5, %6\n\tv_cmp_le_u32_e64 %2, %5, %7\n\tv_cmp_le_u32_e64 %3, %5, %8\n\tv_cmp_le_u32_e64 %4, %5, %9\n\t" \
                 "v_addc_co_u32_e64 %0, %1, 0, %0, %1\n\tv_addc_co_u32_e64 %0, %2, 0, %0, %2\n\tv_addc_co_u32_e64 %0, %3, 0, %0, %3\n\tv_addc_co_u32_e64 %0, %4, 0, %0, %4" \
                 : "+v"(n_), "=&s"(t0_), "=&s"(t1_), "=&s"(t2_), "=&s"(t3_) : "s"(c_), "v"(k0_), "v"(k1_), "v"(k2_), "v"(k3_)); } while (0)
template <bool DUMMY> __device__ __forceinline__ void attn_unit(Frame& F, int b, int qb, int tid_in) {
    int tid = tid_in; asm volatile("" : "+v"(tid));
    int lane = tid & 63, w = __builtin_amdgcn_readfirstlane(tid >> 6), g = lane >> 4, n = lane & 15;
    bf16* proj = (bf16*)(F.ws + WS_PROJ);
    const int t0 = qb * 16; const size_t rowb = (size_t)b * SEQ;
    LAS unsigned char* L = F.lds;
    LAS unsigned* SC = (LAS unsigned*)(L + AT_SC); LAS unsigned* MASK = (LAS unsigned*)(L + AT_MASK); const LAS float* BIAS = (const LAS float*)(L + AT_BIAS);
    if (!DUMMY || (ATDSEL & 1)) {
        bf16x8 Aq[4][2][2];
#pragma unroll
        for (int p = 0; p < 4; ++p)
#pragma unroll
            for (int j = 0; j < 2; ++j)
#pragma unroll
                for (int ks = 0; ks < 2; ++ks) { const int q = 4 * p + (n >> 2), head = 4 * j + (n & 3);
                    Aq[p][j][ks] = *(const GAS bf16x8*)(proj + (rowb + t0 + q) * DINP + P_IQ + head * 64 + 32 * ks + 8 * g); }
        float wq[4][8];
#pragma unroll
        for (int p = 0; p < 4; ++p) { const v4u x = *(const GAS v4u*)(proj + (rowb + t0 + 4 * p + g) * DINP + P_IW); const unsigned xs[4] = {x.x, x.y, x.z, x.w};
#pragma unroll
          for (int i = 0; i < 4; ++i) { wq[p][2 * i] = bflo(xs[i]) * 0.044194173824159216f; wq[p][2 * i + 1] = bfhi(xs[i]) * 0.044194173824159216f; } }
        const bf16* kbase = proj + rowb * DINP + P_IK + 8 * g;
        bf16x8 Bc[4][2];
#define AT_LDB(dst, i0_) do { _Pragma("unroll") for (int k_ = 0; k_ < 4; ++k_) { int i_ = (i0_) + 8 * k_; i_ = i_ > qb ? qb : i_; \
            const GAS bf16x8* kp_ = (const GAS bf16x8*)(kbase + (size_t)(16 * i_ + n) * DINP); dst[k_][0] = kp_[0]; dst[k_][1] = kp_[4]; } } while (0)
        for (int i0 = w; i0 <= qb; i0 += 32) {
            AT_LDB(Bc, i0);
#pragma unroll
            for (int k = 0; k < 4; ++k) { const int i = i0 + 8 * k;
                if (i <= qb) {
                    const int key = 16 * i + n;
#pragma unroll
                    for (int p = 0; p < 4; ++p) {
                        f32x4 a0 = (f32x4){0.f, 0.f, 0.f, 0.f}, a1 = (f32x4){0.f, 0.f, 0.f, 0.f};
                        a0 = MFMA16(Aq[p][0][0], Bc[k][0], a0); a0 = MFMA16(Aq[p][0][1], Bc[k][1], a0);
                        a1 = MFMA16(Aq[p][1][0], Bc[k][0], a1); a1 = MFMA16(Aq[p][1][1], Bc[k][1], a1);
                        float sc = 0.f;
#pragma unroll
                        for (int e = 0; e < 4; ++e) { sc += wq[p][e] * fmaxf(a0[e], 0.f); sc += wq[p][4 + e] * fmaxf(a1[e], 0.f); }
                        SC[(4 * p + g) * 2048 + key] = (key <= t0 + 4 * p + g) ? sortable_key(sc + 0.0f) : 0u;
                    }
                } }
        }
#undef AT_LDB
    }
    LDS_WAIT(); __syncthreads();
    asm volatile("" : "+v"(tid)); lane = tid & 63; g = lane >> 4; n = lane & 15;
    bf16x8 Qf[8]; const bf16* lsrc; unsigned ldsw0;
    const int nt32 = (DUMMY && ATNT1) ? 1 : (qb >> 1) + 1;
#define AT_GLDS(gsrc_, dst_) do { unsigned keep_; asm volatile("s_mov_b32 %0, m0\n\ts_mov_b32 m0, %2\n\ts_nop 0\n\tglobal_load_lds_dwordx4 %1, off\n\ts_mov_b32 m0, %0" : "=&s"(keep_) : "v"(gsrc_), "s"(dst_) : "memory"); } while (0)
#define AT_LOAD(it_, buf_) do { const bf16* s_ = lsrc + (size_t)(it_) * 32 * DINP; const unsigned d_ = (unsigned)__builtin_amdgcn_readfirstlane(ldsw0 + (unsigned)(buf_) * AT_KVBUF); \
        AT_GLDS(s_, d_); AT_GLDS(s_ + 128, d_ + 8192u); } while (0)
#define AT_TILE(i_) ((i_) < nt32 ? (i_) : nt32 - 1)
#define AT_RING_START() do { { const bf16* qr_ = proj + (rowb + t0 + 2 * w + (n >> 3)) * DINP + P_AQ + (n & 7) * RK; _Pragma("unroll") for (int ks = 0; ks < 8; ++ks) Qf[ks] = *(const GAS bf16x8*)(qr_ + 32 * ks + 8 * g); } \
        const int lrow_ = 8 * (w >> 1) + ((lane >> 2) & 7), lch_ = 4 * (((w & 1) << 1) | (lane >> 5)) + ((lane & 3) ^ ((lrow_ >> 2) & 3)); \
        lsrc = proj + (rowb + lrow_) * DINP + P_CKV + lch_ * 8; ldsw0 = (unsigned)(size_t)(L + AT_KV) + (unsigned)w * 1024u; \
        _Pragma("unroll") for (int i = 0; i < 7; ++i) if (!(DUMMY && ATNODMA)) AT_LOAD(AT_TILE(i), i); } while (0)
    if (!DUMMY || (ATDSEL & 2)) {
        const bool all = (t0 + 16 <= TOPK);
        const unsigned long long lt_mask = (lane == 0) ? 0ull : (~0ull >> (64 - lane));
        const int jn = (t0 + 16 + 63) >> 6;
        const int qa = 2 * w, ta = t0 + qa, tb_ = ta + 1;
        unsigned ka[32], kb2[32];
#pragma unroll
        for (int j = 0; j < 32; ++j) { const int s = lane + 64 * j; ka[j] = (j < jn && s <= ta) ? SC[qa * 2048 + s] : 0u; kb2[j] = (j < jn && s <= tb_) ? SC[(qa + 1) * 2048 + s] : 0u; }
        LDS_WAIT(); __syncthreads();
        if (!DUMMY || (ATDSEL & 4)) AT_RING_START();
        unsigned Ta = 0u, Tb = 0u; bool exa = false, exb = false;
        if (!all) {
            for (int bit = 31; bit >= 0 && !(exa && exb); --bit) {
                const unsigned ca = Ta | (1u << bit), cb = Tb | (1u << bit); int na = 0, nb = 0;
#pragma unroll
                for (int c8 = 0; c8 < 4; ++c8) if (8 * c8 < jn) {
#pragma unroll
                    for (int j = 8 * c8; j < 8 * c8 + 8; j += 4) { AT_CNT4(na, ca, ka[j], ka[j + 1], ka[j + 2], ka[j + 3]); AT_CNT4(nb, cb, kb2[j], kb2[j + 1], kb2[j + 2], kb2[j + 3]); } }
                na = wave_sum_dpp(na); nb = wave_sum_dpp(nb);
                if (!exa) { if (na >= TOPK) Ta = ca; exa = (na == TOPK); }
                if (!exb) { if (nb >= TOPK) Tb = cb; exb = (nb == TOPK); }
            }
        }
#pragma unroll
        for (int qq = 0; qq < 2; ++qq) {
            const int q = qa + qq, t = t0 + q; const unsigned T = qq ? Tb : Ta; const bool ex = qq ? exb : exa;
            int need_eq = 0;
            if (!all && !ex) { int cg = 0;
#pragma unroll
                for (int j = 0; j < 32; ++j) cg += ((qq ? kb2[j] : ka[j]) > T) ? 1 : 0;
                need_eq = TOPK - wave_sum_dpp(cg); }
            int eq_seen = 0;
#pragma unroll
            for (int j = 0; j < 32; ++j) {
                const int s = lane + 64 * j; const unsigned kk = qq ? kb2[j] : ka[j]; bool sel;
                if (all) sel = (s <= t);
                else if (ex) sel = (kk >= T);
                else { const bool eq = (kk == T); const unsigned long long em = __ballot(eq); const int rank = eq_seen + __popcll(em & lt_mask); sel = (kk > T) || (eq && rank < need_eq); eq_seen += __popcll(em); }
                const unsigned long long sm = __ballot(sel);
                if (lane == 0) { MASK[q * 64 + 2 * j] = (unsigned)sm; MASK[q * 64 + 2 * j + 1] = (unsigned)(sm >> 32); }
            }
        }
    }
    LDS_WAIT(); __syncthreads();
    asm volatile("" : "+v"(tid)); lane = tid & 63; g = lane >> 4; n = lane & 15;
    if (!DUMMY || (ATDSEL & 4)) {
        const int q = 2 * w + (n >> 3), hh = n & 7, t = t0 + q;
        bf16* qrow = proj + (rowb + t) * DINP + P_AQ + hh * RK;
        if (DUMMY && !(ATDSEL & 2)) AT_RING_START();
        f32x4 O[16]; f32x4 OL = (f32x4){0.f, 0.f, 0.f, 0.f};
        const float b31 = BIAS[128 * 8 + hh];
        int rbase[2], tbase[2][2];
#pragma unroll
        for (int tt = 0; tt < 2; ++tt) { const int row = 8 * (n >> 2) + 4 * tt + (n & 3); rbase[tt] = 2048 * (row >> 3) + 64 * (row & 7) + 16 * (g ^ ((row >> 2) & 3)); }
#pragma unroll
        for (int tt = 0; tt < 2; ++tt)
#pragma unroll
            for (int od = 0; od < 2; ++od) { const int qq = n >> 2, p = n & 3; const int x = (((od ^ (g & 1)) << 1) | ((p >> 1) ^ tt));
                tbase[tt][od] = 2048 * g + 64 * (4 * tt + qq) + 16 * x + 8 * (p & 1); }
        {
#pragma unroll
        for (int mt = 0; mt < 16; ++mt) O[mt] = (f32x4){0.f, 0.f, 0.f, 0.f};
        asm volatile("s_waitcnt vmcnt(12)" ::: "memory"); __syncthreads();
        bf16x8 fa[2][8]; f32x4 sa[2], cin[2]; v4i16_t va[8][2], vb[8][2]; unsigned bitsw; bf16x8 Pf;
        const bf16x8 ONES = (bf16x8){0x3F80, 0x3F80, 0x3F80, 0x3F80, 0x3F80, 0x3F80, 0x3F80, 0x3F80};
        const unsigned b31u = __builtin_bit_cast(unsigned, b31);
#define AT_CINIT(i_) do { const unsigned bits_ = bitsw >> (8 * g); \
            if ((t0 - (32 * (i_) + 31)) >= 128) { \
                _Pragma("unroll") for (int j = 0; j < 8; ++j) { const unsigned m_ = (unsigned)__builtin_amdgcn_sbfe((int)bits_, j, 1); cin[j >> 2][j & 3] = __builtin_bit_cast(float, (m_ & b31u) | (~m_ & 0xF149F2CAu)); } \
            } else { const int kb = 32 * (i_) + 8 * g; \
                _Pragma("unroll") for (int j = 0; j < 8; ++j) { int dist = t - (kb + j); dist = dist < 0 ? 0 : (dist > 128 ? 128 : dist); const unsigned bv_ = __builtin_bit_cast(unsigned, BIAS[dist * 8 + hh]); \
                    const unsigned m_ = (unsigned)__builtin_amdgcn_sbfe((int)bits_, j, 1); cin[j >> 2][j & 3] = __builtin_bit_cast(float, (m_ & bv_) | (~m_ & 0xF149F2CAu)); } } } while (0)
#define AT_FA(tt_, b_) do { _Pragma("unroll") for (int ks = 0; ks < 8; ++ks) fa[tt_][ks] = lds_rd128((b_) + rbase[tt_] + (ks >> 2) * 8192 + 512 * (ks & 3)); } while (0)
#define AT_S(tt_) do { asm volatile("" : "+v"(fa[tt_][0]), "+v"(fa[tt_][1]), "+v"(fa[tt_][2]), "+v"(fa[tt_][3]), "+v"(fa[tt_][4]), "+v"(fa[tt_][5]), "+v"(fa[tt_][6]), "+v"(fa[tt_][7]));        \
            sa[tt_] = cin[tt_]; _Pragma("unroll") for (int ks = 0; ks < 8; ++ks) sa[tt_] = MFMA16(fa[tt_][ks], Qf[ks], sa[tt_]); } while (0)
#define AT_IL(nm_, nd_) do { _Pragma("unroll") for (int q_ = 0; q_ < (nm_); ++q_) { __builtin_amdgcn_sched_group_barrier(0x008, 1, 0); __builtin_amdgcn_sched_group_barrier(0x100, (nd_), 0); } } while (0)
#define AT_SC(tt_) asm volatile("" : "+v"(fa[tt_][0]), "+v"(fa[tt_][1]), "+v"(fa[tt_][2]), "+v"(fa[tt_][3]), "+v"(fa[tt_][4]), "+v"(fa[tt_][5]), "+v"(fa[tt_][6]), "+v"(fa[tt_][7]))
#define AT_SM(tt_) do { sa[tt_] = cin[tt_]; _Pragma("unroll") for (int ks = 0; ks < 8; ++ks) sa[tt_] = MFMA16(fa[tt_][ks], Qf[ks], sa[tt_]); } while (0)
#define AT_TRA(b_) do { _Pragma("unroll") for (int mt = 0; mt < 8; ++mt) { const int off = 512 * (mt >> 1); va[mt][0] = lds_tr64((b_) + tbase[0][mt & 1] + off); va[mt][1] = lds_tr64((b_) + tbase[1][mt & 1] + off); } } while (0)
#define AT_TRB(b_) do { _Pragma("unroll") for (int mt = 0; mt < 8; ++mt) { const int off = 8192 + 512 * (mt >> 1); vb[mt][0] = lds_tr64((b_) + tbase[0][mt & 1] + off); vb[mt][1] = lds_tr64((b_) + tbase[1][mt & 1] + off); } } while (0)
#define AT_TR(b_) do { _Pragma("unroll") for (int mt = 0; mt < 8; ++mt) { const int off = 512 * (mt >> 1); va[mt][0] = lds_tr64((b_) + tbase[0][mt & 1] + off); va[mt][1] = lds_tr64((b_) + tbase[1][mt & 1] + off); } \
            _Pragma("unroll") for (int mt = 0; mt < 8; ++mt) { const int off = 8192 + 512 * (mt >> 1); vb[mt][0] = lds_tr64((b_) + tbase[0][mt & 1] + off); vb[mt][1] = lds_tr64((b_) + tbase[1][mt & 1] + off); } } while (0)
#define AT_SOFTMAX(i_) do { v4u pw; pw.x = pk2(__builtin_amdgcn_exp2f(sa[0][0]), __builtin_amdgcn_exp2f(sa[0][1])); pw.y = pk2(__builtin_amdgcn_exp2f(sa[0][2]), __builtin_amdgcn_exp2f(sa[0][3])); \
            pw.z = pk2(__builtin_amdgcn_exp2f(sa[1][0]), __builtin_amdgcn_exp2f(sa[1][1])); pw.w = pk2(__builtin_amdgcn_exp2f(sa[1][2]), __builtin_amdgcn_exp2f(sa[1][3])); Pf = __builtin_bit_cast(bf16x8, pw); } while (0)
#define AT_PV(vx_, o0_) do { _Pragma("unroll") for (int mt = 0; mt < 8; ++mt) { const bf16x8 a = (bf16x8){vx_[mt][0][0], vx_[mt][0][1], vx_[mt][0][2], vx_[mt][0][3], vx_[mt][1][0], vx_[mt][1][1], vx_[mt][1][2], vx_[mt][1][3]}; \
            O[(o0_) + mt] = MFMA16(a, Pf, O[(o0_) + mt]); } } while (0)
#define AT_SB() __builtin_amdgcn_sched_barrier(0)
#define AT_LOOP(ROT_) do { AT_FA(0, L + AT_KV); AT_FA(1, L + AT_KV); bitsw = MASK[q * 64]; AT_SB(); AT_CINIT(0); AT_S(0); AT_S(1); AT_SB(); AT_TR(L + AT_KV); AT_SB(); if (!(ROT_)) { AT_SOFTMAX(0); AT_SB(); } \
        for (int it = 0; it < nt32; ++it) { \
            const LAS unsigned char* nbuf = L + AT_KV + ((it + 1) & 7) * AT_KVBUF; \
              \
            if (DUMMY && ATNOBAR) asm volatile("s_waitcnt vmcnt(10)" ::: "memory"); else if (ROT_) asm volatile("s_waitcnt vmcnt(10)\n\ts_barrier" ::: "memory"); else asm volatile("s_waitcnt vmcnt(10) lgkmcnt(0)\n\ts_barrier" ::: "memory"); \
            if (ROT_) { AT_SOFTMAX(it); AT_SB(); } \
            { const unsigned mw_ = MASK[q * 64 + it + 1]; bitsw = (it + 1 < nt32) ? mw_ : 0u; }        \
            if (!(DUMMY && ATNODMA)) AT_LOAD(AT_TILE(it + 7), (it + 7) & 7); \
              \
            AT_SB(); AT_FA(0, nbuf); AT_PV(va, 0); OL = MFMA16(ONES, Pf, OL); AT_IL(9, 1); AT_SB(); \
            AT_CINIT(it + 1); AT_SB(); \
            AT_SC(0); AT_FA(1, nbuf); AT_SM(0); AT_IL(8, 1); AT_SB(); \
            AT_TRA(nbuf); AT_PV(vb, 8); AT_IL(8, 2); AT_SB(); \
            AT_SC(1); AT_TRB(nbuf); AT_SM(1); AT_IL(8, 2); AT_SB(); \
            if (!(ROT_)) { AT_SOFTMAX(it + 1); AT_SB(); } \
        } } while (0)
        if (w < 4) { asm volatile("; order A" ::: "memory"); AT_LOOP(false); } else { asm volatile("; order B" ::: "memory"); AT_LOOP(true); }
#undef AT_LOOP
#undef AT_FA
#undef AT_S
#undef AT_TR
#undef AT_TRA
#undef AT_TRB
#undef AT_IL
#undef AT_SC
#undef AT_SM
#undef AT_SOFTMAX
#undef AT_CINIT
#undef AT_PV
#undef AT_SB
        asm volatile("s_waitcnt vmcnt(0)" ::: "memory"); __syncthreads();
        }
#undef AT_LOAD
#undef AT_GLDS
#undef AT_TILE
        const float inv = 1.0f / OL[0];
#pragma unroll
        for (int k = 0; k < 8; ++k) {
            unsigned ax = pk2(O[2 * k][0] * inv, O[2 * k][1] * inv), ay = pk2(O[2 * k][2] * inv, O[2 * k][3] * inv);
            unsigned bx = pk2(O[2 * k + 1][0] * inv, O[2 * k + 1][1] * inv), by = pk2(O[2 * k + 1][2] * inv, O[2 * k + 1][3] * inv);
            { const auto r_ = __builtin_amdgcn_permlane16_swap(ax, bx, false, false); ax = r_[0]; bx = r_[1]; }
            { const auto r_ = __builtin_amdgcn_permlane16_swap(ay, by, false, false); ay = r_[0]; by = r_[1]; }
            const v4u o = {ax, ay, bx, by};
            const int d0 = (g & 1) ? 32 * k + 16 + 4 * (g - 1) : 32 * k + 4 * g;
            if (DUMMY) *(GAS v4u*)((bf16*)(F.ws + WS_HM) + (rowb + t) * D + hh * RK + d0) = o; else *(GAS v4u*)(qrow + d0) = o; }
    }
    __syncthreads();
}
template <bool DUMMY> __device__ __forceinline__ void p_attn(Frame& F_, const float* relb) {
    Frame F = F_; const int tid = fresh_tid(F.wave);
    LAS float* BIAS = (LAS float*)(F.lds + AT_BIAS);
    for (int i = tid; i < 129 * 8; i += NWAVES * 64) { const int nn = i >> 3, hh = i & 7; BIAS[i] = relb[t5_bucket_dev(nn) * AH + hh] * 1.4426950408889634f; }
    __syncthreads();
    for (int k = 0; k < 4; ++k) { const int pi = 2 * F.vcu + (k >> 1); if (pi >= BATCH * 64) break; const int b = pi >> 6, x = pi & 63; attn_unit<DUMMY>(F, b, (k & 1) ? (127 - x) : x, tid); }
}

constexpr int ML_Q = 0, ML_K = 16384, ML_V = 32768, ML_VW = 49152, ML_P = 65536, ML_PSTR = 144, ML_BC = ML_P + 64 * ML_PSTR, ML_AV = ML_BC + 8192, ML_PM = ML_AV + 8192,
              ML_MST = ML_PM + 8192, ML_NV = ML_MST + 256, ML_DINV = ML_NV + 512, ML_END = ML_DINV + 256;
static_assert(ML_END <= RING_BYTES, "mLSTM LDS");
__device__ __forceinline__ int img_off(int row, int ch) { const int r = row & 31; return 8192 * (row >> 5) + 2048 * (r >> 3) + 512 * (ch >> 2) + 64 * (r & 7) + 16 * ((ch & 3) ^ ((r >> 2) & 3)); }

__device__ __forceinline__ void mlstm_unit(Frame& F, const float* igb_, const float* fgb_, int l, int b, int hh, int half, int tid) {
    const int lane = tid & 63, w = __builtin_amdgcn_readfirstlane(tid >> 6), g = lane >> 4, n = lane & 15;
    const bf16* proj = (const bf16*)(F.ws + WS_PROJ); const bf16* mqk = (const bf16*)(F.ws + WS_MQK); bf16* hraw = (bf16*)(F.ws + WS_HRAW);
    LAS unsigned char* L = F.lds;
    LAS float* BC = (LAS float*)(L + ML_BC); LAS float* AV = (LAS float*)(L + ML_AV); LAS float* PM = (LAS float*)(L + ML_PM); LAS float* MST = (LAS float*)(L + ML_MST);
    LAS float* NV = (LAS float*)(L + ML_NV); LAS float* DINV = (LAS float*)(L + ML_DINV);
    const size_t rowb = (size_t)b * SEQ;
    {
        const float igb = igb_[l * MH + hh], fgb = fgb_[l * MH + hh];
        for (int cc = 0; cc < 4; ++cc) { const int tok = (4 * w + cc) * 64 + lane;
            const float ig = bf2f(proj[(rowb + tok) * DINP + P_MI + hh]) + igb;
            const float fp = bf2f(proj[(rowb + tok) * DINP + P_MF + hh]) + fgb;
            const float lf = fminf(fp, 0.f) - log1pf(__expf(-fabsf(fp)));
            float bc = lf;
#pragma unroll
            for (int o = 1; o < 64; o <<= 1) { const float v = __shfl_up(bc, o); if (lane >= o) bc += v; }
            const float a = ig - bc; float pm = a;
#pragma unroll
            for (int o = 1; o < 64; o <<= 1) { const float v = __shfl_up(pm, o); if (lane >= o) pm = fmaxf(pm, v); }
            BC[tok] = bc; AV[tok] = a; PM[tok] = pm; }
        if (tid < 128) NV[tid] = 0.f;
        for (int i = tid; i < 64 * ML_PSTR / 4; i += 512) ((LAS unsigned*)(L + ML_P))[i] = 0u;
    }
    LDS_WAIT(); __syncthreads();
    if (tid == 0) { float m = 0.f; MST[0] = 0.f; for (int c = 0; c < NCHUNK; ++c) { m = BC[64 * c + 63] + fmaxf(m, PM[64 * c + 63]); MST[c + 1] = m; } }
    int ld_off[2]; const bf16* ld_q[2]; const bf16* ld_v[2];
#pragma unroll
    for (int i = 0; i < 2; ++i) { const int idx = tid + 512 * i, r = idx >> 4, ch = idx & 15; ld_off[i] = img_off(r, ch);
        ld_q[i] = mqk + (rowb + r) * 1024 + hh * DK + ch * 8; ld_v[i] = proj + (rowb + r) * DINP + P_MV + hh * DV + half * 128 + ch * 8; }
    const int rr_base = img_off(n, g);
    int tb[2][2];
#pragma unroll
    for (int tt = 0; tt < 2; ++tt)
#pragma unroll
        for (int od = 0; od < 2; ++od) { const int qq = n >> 2, p = n & 3; const int x = (((od ^ (g & 1)) << 1) | ((p >> 1) ^ tt)); tb[tt][od] = 2048 * g + 64 * (4 * tt + qq) + 16 * x + 8 * (p & 1); }
#define ML_TR(img, ks, c, tt) lds_tr64(L + (img) + 8192 * (ks) + 512 * ((c) >> 1) + tb[tt][(c) & 1])
    f32x4 Cacc[8];
#pragma unroll
    for (int mt = 0; mt < 8; ++mt) Cacc[mt] = (f32x4){0.f, 0.f, 0.f, 0.f};
    v4u rq[2], rk[2], rv[2];
#pragma unroll
    for (int i = 0; i < 2; ++i) { rq[i] = *(const GAS v4u*)(ld_q[i]); rk[i] = *(const GAS v4u*)(ld_q[i] + 512); rv[i] = *(const GAS v4u*)(ld_v[i]); }
    __syncthreads();
    for (int c = 0; c < NCHUNK; ++c) {
        const float mst = MST[c], mnew = MST[c + 1], blast = BC[64 * c + 63];
#pragma unroll
        for (int i = 0; i < 2; ++i) { const int idx = tid + 512 * i, r = idx >> 4;
            *(LAS v4u*)(L + ML_Q + ld_off[i]) = rq[i]; *(LAS v4u*)(L + ML_K + ld_off[i]) = rk[i]; *(LAS v4u*)(L + ML_V + ld_off[i]) = rv[i];
            const float wk = __expf(blast + AV[64 * c + r] - mnew);
            v4u vw; vw.x = pk2(bflo(rv[i].x) * wk, bfhi(rv[i].x) * wk); vw.y = pk2(bflo(rv[i].y) * wk, bfhi(rv[i].y) * wk); vw.z = pk2(bflo(rv[i].z) * wk, bfhi(rv[i].z) * wk); vw.w = pk2(bflo(rv[i].w) * wk, bfhi(rv[i].w) * wk);
            *(LAS v4u*)(L + ML_VW + ld_off[i]) = vw; }
        LDS_WAIT(); __syncthreads();
        if (c + 1 < NCHUNK) {
#pragma unroll
            for (int i = 0; i < 2; ++i) { const size_t adv = (size_t)(c + 1) * 64; rq[i] = *(const GAS v4u*)(ld_q[i] + adv * 1024); rk[i] = *(const GAS v4u*)(ld_q[i] + adv * 1024 + 512); rv[i] = *(const GAS v4u*)(ld_v[i] + adv * DINP); } }
        for (int ti = w; ti < 10; ti += 8) {
            const int kt = (int)((0x3221110000ull >> (4 * ti)) & 15ull), nt = (int)((0x3323213210ull >> (4 * ti)) & 15ull);
            bf16x8 fa[4], fb[4];
#pragma unroll
            for (int ks = 0; ks < 4; ++ks) { fa[ks] = lds_rd128(L + ML_K + img_off(16 * kt + n, 4 * ks + g)); fb[ks] = lds_rd128(L + ML_Q + img_off(16 * nt + n, 4 * ks + g)); }
            const int j = 16 * nt + n; const float pmj = PM[64 * c + j];
            const f32x4 av = *(const LAS f32x4*)(AV + 64 * c + 16 * kt + 4 * g);
            __builtin_amdgcn_sched_barrier(0);
            f32x4 s = (f32x4){0.f, 0.f, 0.f, 0.f};
#pragma unroll
            for (int ks = 0; ks < 4; ++ks) s = MFMA16(fa[ks], fb[ks], s);
            const float mx = fmaxf(mst, pmj);
            float pv[4];
#pragma unroll
            for (int e = 0; e < 4; ++e) { const int sk = 16 * kt + 4 * g + e; pv[e] = (sk <= j) ? s[e] * __expf(av[e] - mx) : 0.f; }
            v2u pw; pw.x = pk2(pv[0], pv[1]); pw.y = pk2(pv[2], pv[3]);
            *(LAS v2u*)(L + ML_P + j * ML_PSTR + (16 * kt + 4 * g) * 2) = pw;
        }
        f32x4 dacc = (f32x4){0.f, 0.f, 0.f, 0.f};
        if (w < 4) {
            f32x4 n0[4], n1[4]; bf16x8 bqd[4];
#pragma unroll
            for (int ks = 0; ks < 4; ++ks) { n0[ks] = *(const LAS f32x4*)(NV + 32 * ks + 8 * g); n1[ks] = *(const LAS f32x4*)(NV + 32 * ks + 8 * g + 4); bqd[ks] = lds_rd128(L + ML_Q + img_off(16 * w + n, 4 * ks + g)); }
            __builtin_amdgcn_sched_barrier(0);
#pragma unroll
            for (int ks = 0; ks < 4; ++ks) {
                v4u aw; aw.x = pk2(n0[ks][0], n0[ks][1]); aw.y = pk2(n0[ks][2], n0[ks][3]); aw.z = pk2(n1[ks][0], n1[ks][1]); aw.w = pk2(n1[ks][2], n1[ks][3]);
                if (n != 0) { aw.x = 0u; aw.y = 0u; aw.z = 0u; aw.w = 0u; }
                dacc = MFMA16(__builtin_bit_cast(bf16x8, aw), bqd[ks], dacc); }
        }
        LDS_WAIT(); __syncthreads();
        const float mxw = fmaxf(mst, PM[64 * c + 16 * (w & 3) + n]);
        bf16x8 bpd[2];
        if (w < 4) {
#pragma unroll
            for (int ks = 0; ks < 2; ++ks) bpd[ks] = lds_rd128(L + ML_P + (16 * w + n) * ML_PSTR + (32 * ks + 8 * g) * 2);
        }
        f32x4 avn[2][2]; v4i16_t klo[2], khi[2];
#pragma unroll
        for (int ks = 0; ks < 2; ++ks) { avn[ks][0] = *(const LAS f32x4*)(AV + 64 * c + 32 * ks + 8 * g); avn[ks][1] = *(const LAS f32x4*)(AV + 64 * c + 32 * ks + 8 * g + 4); klo[ks] = ML_TR(ML_K, ks, w, 0); khi[ks] = ML_TR(ML_K, ks, w, 1); }
        v2u qb0[4][4], qb1[4][4]; float pmn[4];
#pragma unroll
        for (int nt = 0; nt < 4; ++nt) { const int row = 16 * nt + n; pmn[nt] = PM[64 * c + row];
#pragma unroll
            for (int s4 = 0; s4 < 4; ++s4) { qb0[nt][s4] = *(const LAS v2u*)(L + ML_Q + img_off(row, 4 * s4 + (g >> 1)) + 8 * (g & 1)); qb1[nt][s4] = *(const LAS v2u*)(L + ML_Q + img_off(row, 4 * s4 + 2 + (g >> 1)) + 8 * (g & 1)); } }
        const float nvold = (g == 0) ? NV[16 * w + n] : 0.f;
        __builtin_amdgcn_sched_barrier(0);
        if (w < 4) {
            const float wint = __expf(mst - mxw);
            dacc = dacc * wint;
            v4u ow; ow.x = (n == 0) ? 0x3f803f80u : 0u; ow.y = ow.x; ow.z = ow.x; ow.w = ow.x;
#pragma unroll
            for (int ks = 0; ks < 2; ++ks) dacc = MFMA16(__builtin_bit_cast(bf16x8, ow), bpd[ks], dacc);
            if (g == 0) { const float den = dacc[0]; const float mrow = BC[64 * c + 16 * w + n] + mxw; DINV[16 * w + n] = 1.0f / fmaxf(fabsf(den), __expf(-mrow)); }
        }
        {
            f32x4 nacc = (f32x4){0.f, 0.f, 0.f, 0.f};
#pragma unroll
            for (int ks = 0; ks < 2; ++ks) {
                float wkv[8];
#pragma unroll
                for (int jj = 0; jj < 8; ++jj) wkv[jj] = __expf(blast + avn[ks][jj >> 2][jj & 3] - mnew);
                v4u aw; aw.x = pk2(wkv[0], wkv[1]); aw.y = pk2(wkv[2], wkv[3]); aw.z = pk2(wkv[4], wkv[5]); aw.w = pk2(wkv[6], wkv[7]);
                if (n != 0) { aw.x = 0u; aw.y = 0u; aw.z = 0u; aw.w = 0u; }
                const bf16x8 bk = (bf16x8){klo[ks][0], klo[ks][1], klo[ks][2], klo[ks][3], khi[ks][0], khi[ks][1], khi[ks][2], khi[ks][3]};
                nacc = MFMA16(__builtin_bit_cast(bf16x8, aw), bk, nacc); }
            if (g == 0) { const float decay = __expf(blast + mst - mnew); NV[16 * w + n] = decay * nvold + nacc[0]; }
        }
        f32x4 Hacc[4];
        {
            v4u awc[4];
#pragma unroll
            for (int s4 = 0; s4 < 4; ++s4) { awc[s4].x = pk2(Cacc[2 * s4][0], Cacc[2 * s4][1]); awc[s4].y = pk2(Cacc[2 * s4][2], Cacc[2 * s4][3]); awc[s4].z = pk2(Cacc[2 * s4 + 1][0], Cacc[2 * s4 + 1][1]); awc[s4].w = pk2(Cacc[2 * s4 + 1][2], Cacc[2 * s4 + 1][3]); }
#pragma unroll
            for (int nt = 0; nt < 4; ++nt) {
                f32x4 h = (f32x4){0.f, 0.f, 0.f, 0.f};
#pragma unroll
                for (int s4 = 0; s4 < 4; ++s4) { v4u bw; bw.x = qb0[nt][s4].x; bw.y = qb0[nt][s4].y; bw.z = qb1[nt][s4].x; bw.w = qb1[nt][s4].y;
                    h = MFMA16(__builtin_bit_cast(bf16x8, awc[s4]), __builtin_bit_cast(bf16x8, bw), h); }
                const float wint = __expf(mst - fmaxf(mst, pmn[nt]));
                Hacc[nt] = h * wint;
            }
        }
        __builtin_amdgcn_sched_barrier(0);
        v4i16_t vlo2[2], vhi2[2], wlo2[2], whi2[2]; bf16x8 bpp[2][4]; v4i16_t alo[2][8], ahi[2][8];
#pragma unroll
        for (int ks = 0; ks < 2; ++ks) { vlo2[ks] = ML_TR(ML_V, ks, w, 0); vhi2[ks] = ML_TR(ML_V, ks, w, 1);
#pragma unroll
            for (int nt = 0; nt < 4; ++nt) bpp[ks][nt] = lds_rd128(L + ML_P + (16 * nt + n) * ML_PSTR + (32 * ks + 8 * g) * 2); }
#define ML_STATE_READS(ks_) do { wlo2[ks_] = ML_TR(ML_VW, ks_, w, 0); whi2[ks_] = ML_TR(ML_VW, ks_, w, 1); \
            _Pragma("unroll") for (int mt = 0; mt < 8; ++mt) { alo[ks_][mt] = ML_TR(ML_K, ks_, mt, 0); ahi[ks_][mt] = ML_TR(ML_K, ks_, mt, 1); } } while (0)
#define ML_STATE_MMA(ks_) do { const bf16x8 bv = (bf16x8){wlo2[ks_][0], wlo2[ks_][1], wlo2[ks_][2], wlo2[ks_][3], whi2[ks_][0], whi2[ks_][1], whi2[ks_][2], whi2[ks_][3]}; \
            _Pragma("unroll") for (int mt = 0; mt < 8; ++mt) { const bf16x8 ak = (bf16x8){alo[ks_][mt][0], alo[ks_][mt][1], alo[ks_][mt][2], alo[ks_][mt][3], ahi[ks_][mt][0], ahi[ks_][mt][1], ahi[ks_][mt][2], ahi[ks_][mt][3]}; \
                Cacc[mt] = MFMA16(ak, bv, Cacc[mt]); } } while (0)
        ML_STATE_READS(0);
        __builtin_amdgcn_sched_barrier(0);
#pragma unroll
        for (int ks = 0; ks < 2; ++ks) {
            const bf16x8 av = (bf16x8){vlo2[ks][0], vlo2[ks][1], vlo2[ks][2], vlo2[ks][3], vhi2[ks][0], vhi2[ks][1], vhi2[ks][2], vhi2[ks][3]};
#pragma unroll
            for (int nt = 0; nt < 4; ++nt) Hacc[nt] = MFMA16(av, bpp[ks][nt], Hacc[nt]);
        }
        __builtin_amdgcn_sched_barrier(0);
        ML_STATE_READS(1);
        __builtin_amdgcn_sched_barrier(0);
        {
            const float decay = __expf(blast + mst - mnew);
#pragma unroll
            for (int mt = 0; mt < 8; ++mt) Cacc[mt] = Cacc[mt] * decay;
            ML_STATE_MMA(0); ML_STATE_MMA(1);
        }
#undef ML_STATE_READS
#undef ML_STATE_MMA
        LDS_WAIT(); __syncthreads();
#pragma unroll
        for (int nt = 0; nt < 4; ++nt) { const int j = 16 * nt + n; const float di = DINV[j];
            v2u o; o.x = pk2(Hacc[nt][0] * di, Hacc[nt][1] * di); o.y = pk2(Hacc[nt][2] * di, Hacc[nt][3] * di);
            *(GAS v2u*)(hraw + (rowb + 64 * c + j) * 1024 + hh * DV + half * 128 + 16 * w + 4 * g) = o; }
    }
#undef ML_TR
    __syncthreads();
}
#ifndef CVPROBE
#define CVPROBE 0
#endif
#if CVPROBE
#define CVPROBE_DUP(k_) convert_item(F, l + 1, ((int)ct_ * 4 + (k_)) * 8 + F.wave, fresh_tid(F.wave) & 63);
#else
#define CVPROBE_DUP(k_)
#endif
#ifndef MIX_NCONV
#define MIX_NCONV 96
#endif
constexpr int MIX_CONV0 = 64;
static_assert(CV_ITEMS % 32 == 0, "conversion tickets are four workgroup items");
__device__ __forceinline__ void p_mix(Frame& F_, const float* relb, const float* igb_, const float* fgb_, int l) {
    Frame F = F_; const int tid = fresh_tid(F.wave);
    LAS float* BIAS = (LAS float*)(F.lds + AT_BIAS);
    for (int i = tid; i < 129 * 8; i += NWAVES * 64) { const int nn = i >> 3, hh = i & 7; BIAS[i] = relb[t5_bucket_dev(nn) * AH + hh] * 1.4426950408889634f; }
    __syncthreads();
    int bid_ = (int)blockIdx.x; asm volatile("" : "+s"(bid_));
    const int grp_ = bid_ & 7, rank_ = bid_ >> 3;
    if (rank_ < MH * 2) mlstm_unit(F, igb_, fgb_, l, grp_, rank_ >> 1, rank_ & 1, tid);
    const int tid2 = fresh_tid(F.wave);
    unsigned* ctr = (unsigned*)(F.ctl + CW_ATK + 64 * (8 * l + grp_));
    unsigned* ctrc = (unsigned*)(F.ctl + CW_CVT + 64 * l);
    volatile LAS unsigned* tk = F.MISC + 20;
    const bool has_conv = (l + 1 < DEPTH);
    const bool conv_first = has_conv && bid_ >= MIX_CONV0 && bid_ < MIX_CONV0 + MIX_NCONV;
#define MIX_CONVERT() do { for (;;) { if (tid2 == 0) tk[0] = __hip_atomic_fetch_add(ctrc, 1u, __ATOMIC_RELAXED, __HIP_MEMORY_SCOPE_AGENT); __syncthreads(); const unsigned ct_ = tk[0]; __syncthreads(); \
        if (ct_ >= (unsigned)(CV_ITEMS / 32)) break; \
        { const int ln_ = fresh_tid(F.wave) & 63; LAS unsigned* scr_ = (LAS unsigned*)(F.lds + RING_OFF + F.wave * 16384); f32x4 va_[16], vb_[16]; \
          CvItem ia_ = cv_item(F, l + 1, ((int)ct_ * 4 + 0) * 8 + F.wave, ln_); cv_load(ia_, va_); \
          CvItem ib_ = cv_item(F, l + 1, ((int)ct_ * 4 + 1) * 8 + F.wave, ln_); cv_load(ib_, vb_); cv_finish(ia_, va_, scr_, ln_); \
          ia_ = cv_item(F, l + 1, ((int)ct_ * 4 + 2) * 8 + F.wave, ln_); cv_load(ia_, va_); cv_finish(ib_, vb_, scr_, ln_); \
          ib_ = cv_item(F, l + 1, ((int)ct_ * 4 + 3) * 8 + F.wave, ln_); cv_load(ib_, vb_); cv_finish(ia_, va_, scr_, ln_); cv_finish(ib_, vb_, scr_, ln_); } } } while (0)
    if (conv_first) MIX_CONVERT();
    unsigned mine = 0u;
    if (tid2 == 0) mine = __hip_atomic_fetch_add(ctr, 1u, __ATOMIC_RELAXED, __HIP_MEMORY_SCOPE_AGENT);
    for (;;) {
        if (tid2 == 0) tk[0] = mine;
        __syncthreads();
        const unsigned ticket = tk[0];
        __syncthreads();
        if (ticket >= 128u) break;
        if (tid2 == 0) mine = __hip_atomic_fetch_add(ctr, 1u, __ATOMIC_RELAXED, __HIP_MEMORY_SCOPE_AGENT);
        attn_unit<false>(F, grp_, 127 - (int)ticket, tid2);
#if ATPROBE
        attn_unit<true>(F, grp_, 127 - (int)ticket, tid2);
#endif
    }
    if (has_conv && !conv_first) MIX_CONVERT();
#undef MIX_CONVERT
}

constexpr int PH_PER_LAYER = 12, N_PHASES = 1 + DEPTH * PH_PER_LAYER;
__global__ void __launch_bounds__(NWAVES * 64, 2) trunk_fwd(const Args A) {
    extern __shared__ __attribute__((aligned(16))) unsigned char lds[];
    Frame F;
    F.lds = (LAS unsigned char*)lds;
    F.MISC = (volatile LAS unsigned*)(F.lds + MISC_OFF);
    F.tid = threadIdx.x; F.lane = F.tid & 63; F.wave = __builtin_amdgcn_readfirstlane(F.tid >> 6);
    F.G = gridDim.x; { const int bx = blockIdx.x; F.vcu = (F.G % 8 == 0) ? (bx % 8) * (F.G / 8) + bx / 8 : bx; }
    F.ws = kargs()->ws; F.ctl = (gu32*)(kargs()->ws + WS_CTL); F.out = kargs()->out;
    for (int u = F.tid; u < (LDS_BYTES - LDSCTL_OFF) / 4; u += NWAVES * 64) ((LAS unsigned*)(F.lds + LDSCTL_OFF))[u] = 0u;
    __syncthreads();
    const int lo = kargs()->ph_lo, hi = kargs()->ph_hi;
    const bool multi = (hi - lo) > 1;
    XcdBarrier bar; bar.bar = (unsigned*)(F.ctl + CW_BAR); bar.x = 0; bar.st = nullptr;
    if (multi) bar = xcd_barrier_post((unsigned*)(F.ctl + CW_BAR), F.MISC + 8, (unsigned)gridDim.x);
    const int grp = (int)blockIdx.x & 7;
    XcdBarrier gbar; gbar.bar = (unsigned*)(F.ctl + CW_GBAR + 4096 * grp); gbar.x = 0; gbar.st = nullptr; gbar.G = GROUP_WG;
    if (multi) gbar = xcd_barrier_post((unsigned*)(F.ctl + CW_GBAR + 4096 * grp), F.MISC + 12, GROUP_WG);
#define IN(k) (lo <= (k) && (k) < hi)
    auto lbid = []() { int b_ = (int)blockIdx.x; asm volatile("" : "+s"(b_)); return b_; };
    const LAS float* RTAB = (const LAS float*)(F.lds + AT_MASK);
#define RSTD_TABLE(S_, pm0_) do { const int c_ = lbid(); pm0_ = 8 * (c_ & 7) + ((c_ >> 3) & 7);        \
        const int t_ = fresh_tid(F.wave); if (t_ < 256) { const float* p_ = SSQ + (size_t)(pm0_ * 256 + t_) * 32; float s_ = 0.f; \
        _Pragma("unroll") for (int i_ = 0; i_ < 8; ++i_) { const f32x4 a_ = *(const GAS f32x4*)(p_ + 4 * i_); s_ += (a_.x + a_.y) + (a_.z + a_.w); } \
        ((LAS float*)(F.lds + AT_MASK))[t_] = 1.0f / sqrtf(s_ * (1.0f / 2048.0f) + 1e-6f); } __syncthreads(); } while (0)
#define SEAM(k) do { if (IN(k) && IN((k) + 1)) xcd_barrier(gbar, F.wave); } while (0)
    if (IN(0)) { p_prologue(F); p_xprep(F, kargs()->in[IN_X], (bf16*)(F.ws + WS_XN), (float*)(F.ws + WS_PART)); if (IN(1)) xcd_barrier(bar, F.wave); }
#pragma unroll 1
    for (int l = 0; l < DEPTH; ++l) {
        const int pb = 1 + l * PH_PER_LAYER;
        { unsigned char* ws_ = kargs()->ws; float* out_ = kargs()->out; unsigned ldsb_ = 0u; asm volatile("" : "+s"(ws_), "+s"(out_), "+s"(ldsb_));
          F.ws = ws_; F.out = out_; F.ctl = (gu32*)(ws_ + WS_CTL); F.lds = (LAS unsigned char*)lds + ldsb_;
          }
        bf16* XN = (bf16*)(F.ws + WS_XN); bf16* PROJ = (bf16*)(F.ws + WS_PROJ); bf16* HMB = (bf16*)(F.ws + WS_HM); bf16* YB = (bf16*)(F.ws + WS_Y);
        float* SSQ = (float*)(F.ws + WS_PART);
        unsigned char* wl = F.ws + WS_W + (size_t)l * LAYER_W;
        if (l > 0 && multi) { if (fresh_tid(F.wave) == 0) { unsigned* cvd = (unsigned*)(F.ctl + CW_CVD + 64 * (l - 1)); unsigned sp_ = 0u;
                while (__hip_atomic_load(cvd, __ATOMIC_RELAXED, __HIP_MEMORY_SCOPE_AGENT) < (unsigned)NGROUP) { __builtin_amdgcn_s_sleep(2); if (++sp_ > (1u << 24)) break; }
                __builtin_amdgcn_fence(__ATOMIC_ACQUIRE, "agent"); }
            __syncthreads(); }
        if (IN(pb + 0)) { pg8::Gemm g{XN, (const bf16*)(wl + OW_GU1), M, FF2, D, D, F.wave}; pg8::StaticOrder S; S.init(M, FF2, F.G, lbid());
            int pm0; RSTD_TABLE(S, pm0); pg8::EpiSwiGLU E{PROJ, DINP, SSQ, RTAB, pm0}; pg8::gemm_phase<pg8::EpiSwiGLU, pg8::StaticOrder, true, true>(F.lds + RING_OFF, g, S, E); SEAM(pb + 0); }
        if (IN(pb + 1)) { pg8::Gemm g{PROJ, (const bf16*)(wl + OW_DN1), M, D, FF, DINP, F.wave}; pg8::StaticOrder S; S.init(M, D, F.G, lbid());
            pg8::EpiResid<false, 1> E{XN, D, SSQ, nullptr}; pg8::gemm_phase<pg8::EpiResid<false, 1>, pg8::StaticOrder, true, true>(F.lds + RING_OFF, g, S, E); SEAM(pb + 1); }
        if (IN(pb + 2)) { pg8::Gemm g{XN, (const bf16*)(wl + OW_IN), M, DINP, D, D, F.wave}; pg8::StaticOrder S; S.init(M, DINP, F.G, lbid());
            int pm0; RSTD_TABLE(S, pm0); pg8::EpiProj E{PROJ, DINP, RTAB, (LAS float*)(F.lds + AT_MASK + 1024), kargs()->in[IN_QN] + l * RK, kargs()->in[IN_KVN] + l * RK}; pg8::gemm_phase<pg8::EpiProj, pg8::StaticOrder, true, true>(F.lds + RING_OFF, g, S, E); SEAM(pb + 2); }
        if (IN(pb + 3)) { p_prep(F, l); SEAM(pb + 3); }
        if (IN(pb + 4)) { p_mix(F, kargs()->in[IN_RELB], kargs()->in[IN_IGB], kargs()->in[IN_FGB], l); if (IN(pb + 6)) xcd_barrier(gbar, F.wave);
            if (l + 1 < DEPTH && ((int)blockIdx.x >> 3) == 0 && fresh_tid(F.wave) == 0) __hip_atomic_fetch_add((unsigned*)(F.ctl + CW_CVD + 64 * l), 1u, __ATOMIC_RELAXED, __HIP_MEMORY_SCOPE_AGENT); }
        if (IN(pb + 6)) { p_mpost(F, l); SEAM(pb + 6); }
        if (IN(pb + 7)) { pg8::Gemm g{PROJ + P_AQ, (const bf16*)(wl + OW_AO), M, D, D, DINP, F.wave}; pg8::StaticOrder S; S.init(M, D, F.G, lbid());
            pg8::EpiGate<0> E{YB, D, PROJ + P_GA, DINP}; pg8::gemm_phase<pg8::EpiGate<0>, pg8::StaticOrder, true, true>(F.lds + RING_OFF, g, S, E); if (!IN(pb + 8)) {} else __syncthreads(); }
        if (IN(pb + 8)) { pg8::Gemm g{HMB, (const bf16*)(wl + OW_MO), M, D, 1024, 1024, F.wave}; pg8::StaticOrder S; S.init(M, D, F.G, lbid());
            pg8::EpiGate<1> E{YB, D, PROJ + P_GM, DINP}; pg8::gemm_phase<pg8::EpiGate<1>, pg8::StaticOrder, true, true>(F.lds + RING_OFF, g, S, E); SEAM(pb + 8); }
        if (IN(pb + 9)) { pg8::Gemm g{YB, (const bf16*)(wl + OW_WO), M, D, D, D, F.wave}; pg8::StaticOrder S; S.init(M, D, F.G, lbid());
            pg8::EpiResid<false, 2> E{XN, D, SSQ, nullptr}; pg8::gemm_phase<pg8::EpiResid<false, 2>, pg8::StaticOrder, true, true>(F.lds + RING_OFF, g, S, E); SEAM(pb + 9); }
        if (IN(pb + 10)) { pg8::Gemm g{XN, (const bf16*)(wl + OW_GU2), M, FF2, D, D, F.wave}; pg8::StaticOrder S; S.init(M, FF2, F.G, lbid());
            int pm0; RSTD_TABLE(S, pm0); pg8::EpiSwiGLU E{PROJ, DINP, SSQ, RTAB, pm0}; pg8::gemm_phase<pg8::EpiSwiGLU, pg8::StaticOrder, true, true>(F.lds + RING_OFF, g, S, E); SEAM(pb + 10); }
        if (IN(pb + 11)) { pg8::Gemm g{PROJ, (const bf16*)(wl + OW_DN2), M, D, FF, DINP, F.wave}; pg8::StaticOrder S; S.init(M, D, F.G, lbid());
            if (l + 1 < DEPTH) { pg8::EpiResid<false, 1> E{XN, D, SSQ, nullptr}; pg8::gemm_phase<pg8::EpiResid<false, 1>, pg8::StaticOrder, true, true>(F.lds + RING_OFF, g, S, E); }
            else { pg8::EpiResid<true, 1> E{XN, D, SSQ, F.out}; pg8::gemm_phase<pg8::EpiResid<true, 1>, pg8::StaticOrder, true, true>(F.lds + RING_OFF, g, S, E); }
            SEAM(pb + 11); }
    }
#undef IN
#undef SEAM
}

#ifndef N_LAUNCH_MODE
#define N_LAUNCH_MODE 1
#endif
extern "C" void kernel_launch(void* const* d_in, const int* in_sizes, int n_in, void* d_out, int out_size, void* d_ws, size_t ws_size, hipStream_t stream) {
    static int grid = 0;
    if (grid == 0) {
        if (n_in != 20 || in_sizes[0] != M * D || out_size != M * D || ws_size < WS_END) { fprintf(stderr, "kernel_launch: unexpected shapes / workspace (n_in %d, ws %zu, need %zu)\n", n_in, ws_size, (size_t)WS_END); grid = -1; return; }
        int dev = 0, cus = 0, per_cu = 0;
        if (hipGetDevice(&dev) != hipSuccess || hipDeviceGetAttribute(&cus, hipDeviceAttributeMultiprocessorCount, dev) != hipSuccess) { grid = -1; return; }
        if (hipFuncSetAttribute((const void*)trunk_fwd, hipFuncAttributeMaxDynamicSharedMemorySize, LDS_BYTES) != hipSuccess) { fprintf(stderr, "kernel_launch: hipFuncSetAttribute failed\n"); grid = -1; return; }
        if (hipOccupancyMaxActiveBlocksPerMultiprocessor(&per_cu, (const void*)trunk_fwd, NWAVES * 64, LDS_BYTES) != hipSuccess || per_cu < 1)
            fprintf(stderr, "kernel_launch: note: occupancy query reports %d workgroups per CU\n", per_cu);
        (void)hipGetLastError();
        grid = cus;
    }
    if (grid < 0) return;
    if (hipMemsetAsync((char*)d_ws + WS_CTL, 0, CTL_ZERO_BYTES, stream) != hipSuccess) return;
    Args a{};
    for (int i = 0; i < 20; ++i) a.in[i] = (const float*)d_in[i];
    a.out = (float*)d_out; a.ws = (unsigned char*)d_ws;
    if (N_LAUNCH_MODE == 1) {
        a.ph_lo = 0; a.ph_hi = N_PHASES;
        hipLaunchKernelGGL(trunk_fwd, dim3(grid), dim3(NWAVES * 64), LDS_BYTES, stream, a);
    } else {
        for (int p = 0; p < N_PHASES; ++p) {
            a.ph_lo = p; a.ph_hi = p + 1; hipLaunchKernelGGL(trunk_fwd, dim3(grid), dim3(NWAVES * 64), LDS_BYTES, stream, a); }
    }
}
```
